# Optimizing an MI355X kernel written in HIP

```python
import jax, jax.numpy as jnp
from jax import lax
import numpy as np

D_MODEL = 1024
BATCH = 8
SEQ = 2048
DEPTH = 1
DEC_BATCH = 128
DEC_SEQ = 8
PAST_LEN = 16384
PAGE_SIZE = 128

D_A = D_MODEL
D_B = D_MODEL
K_A = 3
K_B = 31
PLE_DIM = 256
EPS = 1e-6
LN_EPS = 1e-5
SPLITS = [D_A, 2 * D_A, 3 * D_A, 4 * D_A,
          4 * D_A + D_B, 4 * D_A + 2 * D_B, 4 * D_A + 3 * D_B,
          4 * D_A + 3 * D_B + D_MODEL]
D_IN = 4 * D_A + 3 * D_B + 2 * D_MODEL

kernel_name = "hybrid_shortconv_conformer_conv_decoder_step"


def _rmsnorm(x, g):
    xf = x.astype(jnp.float32)
    y = xf * lax.rsqrt(jnp.mean(xf * xf, axis=-1, keepdims=True) + EPS)
    return (y * g.astype(jnp.float32)).astype(x.dtype)


def _layernorm(x, g, b):
    xf = x.astype(jnp.float32)
    mu = jnp.mean(xf, axis=-1, keepdims=True)
    xc = xf - mu
    var = jnp.mean(xc * xc, axis=-1, keepdims=True)
    y = xc * lax.rsqrt(var + LN_EPS) * g.astype(jnp.float32) + b.astype(jnp.float32)
    return y.astype(x.dtype)


def _causal_dwconv(x_ext, w):
    c = x_ext.shape[-1]
    return lax.conv_general_dilated(
        x_ext, w[:, None, :].astype(x_ext.dtype), window_strides=(1,), padding='VALID',
        dimension_numbers=('NWC', 'WIO', 'NWC'), feature_group_count=c)


def _layer(h, p, buf_a, buf_b, g_mix, w_in, w_conv_a, w_out_a, w_conv_b, b_conv_b,
           ln_g, ln_b, w_out_b, w_o, w_pe, g_ple, w_pg):
    u = _rmsnorm(h, g_mix)
    proj = jnp.einsum('ntd,de->nte', u, w_in)
    a_b, a_c, a_h, a_z, b_v, b_g, b_z, gate_a, gate_b = jnp.split(proj, SPLITS, axis=-1)

    s = a_c * a_h
    ext_a = jnp.concatenate([buf_a.astype(s.dtype), s], axis=1)
    ya = a_b * _causal_dwconv(ext_a, w_conv_a) * jax.nn.silu(a_z)
    ya = jnp.einsum('ntc,cd->ntd', ya, w_out_a)
    new_buf_a = ext_a[:, -(K_A - 1):]

    v = b_v * jax.nn.sigmoid(b_g)
    ext_b = jnp.concatenate([buf_b.astype(v.dtype), v], axis=1)
    c = _causal_dwconv(ext_b, w_conv_b) + b_conv_b
    yb = jax.nn.silu(_layernorm(c, ln_g, ln_b)) * jax.nn.silu(b_z)
    yb = jnp.einsum('ntc,cd->ntd', yb, w_out_b)
    new_buf_b = ext_b[:, -(K_B - 1):]

    m = jax.nn.sigmoid(gate_a) * ya + jax.nn.sigmoid(gate_b) * yb
    h = h + jnp.einsum('ntd,de->nte', m, w_o)

    pe = jnp.einsum('ntp,pd->ntd', p.astype(h.dtype), w_pe)
    pg = jax.nn.sigmoid(jnp.einsum('ntd,de->nte', _rmsnorm(h, g_ple), w_pg))
    h = h + pg * pe
    return h, new_buf_a, new_buf_b


def setup_inputs(seed: int = 0) -> dict:
    key = jax.random.key(seed)
    ks = jax.random.split(key, 24)
    f32 = jnp.float32

    def nrm(k, shape, scale):
        return jax.random.normal(k, shape, f32) * scale

    return {
        "x_prompt": nrm(ks[0], (BATCH, SEQ, D_MODEL), 1.0),
        "x_sample": nrm(ks[1], (DEC_BATCH, DEC_SEQ, D_MODEL), 1.0),
        "state_conv_a": nrm(ks[2], (DEPTH, DEC_BATCH, K_A - 1, D_A), 1.0),
        "state_conv_b": nrm(ks[3], (DEPTH, DEC_BATCH, K_B - 1, D_B), 0.5),
        "p_prompt": nrm(ks[4], (DEPTH, BATCH, SEQ, PLE_DIM), 1.0),
        "p_sample": nrm(ks[5], (DEPTH, DEC_BATCH, DEC_SEQ, PLE_DIM), 1.0),
        "g_mix": 1.0 + nrm(ks[6], (DEPTH, D_MODEL), 0.02),
        "w_in": nrm(ks[7], (DEPTH, D_MODEL, D_IN), D_MODEL ** -0.5),
        "w_conv_a": nrm(ks[8], (DEPTH, K_A, D_A), K_A ** -0.5),
        "w_out_a": nrm(ks[9], (DEPTH, D_A, D_MODEL), D_A ** -0.5),
        "w_conv_b": nrm(ks[10], (DEPTH, K_B, D_B), K_B ** -0.5),
        "b_conv_b": nrm(ks[11], (DEPTH, D_B), 0.02),
        "ln_g": 1.0 + nrm(ks[12], (DEPTH, D_B), 0.02),
        "ln_b": nrm(ks[13], (DEPTH, D_B), 0.02),
        "w_out_b": nrm(ks[14], (DEPTH, D_B, D_MODEL), D_B ** -0.5),
        "w_o": nrm(ks[15], (DEPTH, D_MODEL, D_MODEL), D_MODEL ** -0.5),
        "w_pe": nrm(ks[16], (DEPTH, PLE_DIM, D_MODEL), PLE_DIM ** -0.5),
        "g_ple": 1.0 + nrm(ks[17], (DEPTH, D_MODEL), 0.02),
        "w_pg": nrm(ks[18], (DEPTH, D_MODEL, D_MODEL), D_MODEL ** -0.5),
        "g_final": 1.0 + nrm(ks[19], (D_MODEL,), 0.02),
    }


def reference(x_prompt, x_sample, state_conv_a, state_conv_b, p_prompt, p_sample,
              g_mix, w_in, w_conv_a, w_out_a, w_conv_b, b_conv_b, ln_g, ln_b,
              w_out_b, w_o, w_pe, g_ple, w_pg, g_final):
    n_p = x_prompt.shape[0]
    hp, hs = x_prompt, x_sample
    na_p, nb_p, na_s, nb_s = [], [], [], []
    for i in range(DEPTH):
        lw = (g_mix[i], w_in[i], w_conv_a[i], w_out_a[i], w_conv_b[i], b_conv_b[i],
              ln_g[i], ln_b[i], w_out_b[i], w_o[i], w_pe[i], g_ple[i], w_pg[i])
        za = jnp.zeros((n_p, K_A - 1, D_A), hp.dtype)
        zb = jnp.zeros((n_p, K_B - 1, D_B), hp.dtype)
        hp, ba, bb = _layer(hp, p_prompt[i], za, zb, *lw)
        na_p.append(ba)
        nb_p.append(bb)
        hs, sa, sb = _layer(hs, p_sample[i], state_conv_a[i], state_conv_b[i], *lw)
        na_s.append(sa)
        nb_s.append(sb)
    y_prompt = _rmsnorm(hp, g_final)
    y_sample = _rmsnorm(hs, g_final)
    return (y_prompt, y_sample, jnp.stack(na_p), jnp.stack(nb_p), jnp.stack(na_s), jnp.stack(nb_s))
```

```cpp
#include <hip/hip_runtime.h>
#include <cstdio>
#include <cstdint>

#ifndef MK_PER_PHASE
#define MK_PER_PHASE 1
#endif

namespace pg8 {
#define PG8_LAS __attribute__((address_space(3)))
typedef unsigned short bf16_t;
typedef short bf16x8 __attribute__((ext_vector_type(8)));
typedef float f32x4 __attribute__((ext_vector_type(4)));
typedef unsigned u32x4 __attribute__((ext_vector_type(4)));
typedef unsigned u32x2 __attribute__((ext_vector_type(2)));
constexpr int BM = 256, BK = 64, HALF = 128, HTB = HALF * BK * 2, STAGE_BYTES = 8 * HTB, NXCD = 8, WGM = 8;

__host__ __device__ __forceinline__ int lds_byte(int r, int c) { const int st = (r >> 4) * 2 + (c >> 5), rr = r & 15, cc = c & 31, ob = rr * 64 + cc * 2; return st * 1024 + (ob ^ (((ob >> 9) & 1) << 5)); }
__host__ __device__ __forceinline__ void stage_rc(int b, int& R, int& C) { const int st = b / 1024, sb = b % 1024, swz = sb ^ (((sb >> 9) & 1) << 5); R = (st >> 1) * 16 + swz / 64; C = (st & 1) * 32 + (swz % 64) / 2; }
__host__ __device__ __forceinline__ int perm32(int rho) { const int n = rho >> 4, i = rho & 15; return 8 * (i >> 2) + 4 * n + (i & 3); }

struct Unit { int pm, pn; };
struct Gemm { const bf16_t* A; const bf16_t* Bt; int M, N, K; };

struct StaticOrder {
    int nM, nN, nwg, G, c;
    __host__ __device__ void init(int M, int N, int G_, int c_) { nM = M / BM; nN = N / BM; nwg = nM * nN; G = G_; c = c_; }
    __host__ __device__ bool next(int i, Unit& u) const {
        const long L = (long)i * G + c; if (L >= nwg) return false;
        int wgid = (int)L; { const int q = nwg / NXCD, r = nwg % NXCD, xcd = wgid % NXCD, off = wgid / NXCD; wgid = (xcd < r ? xcd * (q + 1) : r * (q + 1) + (xcd - r) * q) + off; }
        const int nig = WGM * nN, gid = wgid / nig, fm = gid * WGM, gsz = (nM - fm) < WGM ? (nM - fm) : WGM;
        u.pm = fm + ((wgid % nig) % gsz); u.pn = (wgid % nig) / gsz; return true;
    }
    __device__ __forceinline__ void a_ready(const Unit&) const {}
    __device__ __forceinline__ void done(const Unit&) const {}
};

__device__ __forceinline__ unsigned cvt_pk_bf16(float lo, float hi) { unsigned r; asm volatile("v_cvt_pk_bf16_f32 %0, %1, %2" : "=v"(r) : "v"(lo), "v"(hi)); return r; }
__device__ __forceinline__ float bf_lo(unsigned u) { return __uint_as_float(u << 16); }
__device__ __forceinline__ float bf_hi(unsigned u) { return __uint_as_float(u & 0xffff0000u); }
__device__ __forceinline__ float sigmoidf_(float x) { return __builtin_amdgcn_rcpf(1.0f + __expf(-x)); }
__device__ __forceinline__ u32x4 pack8(const f32x4 a, const f32x4 b) { u32x4 w; w.x = cvt_pk_bf16(a[0], a[1]); w.y = cvt_pk_bf16(a[2], a[3]); w.z = cvt_pk_bf16(b[0], b[1]); w.w = cvt_pk_bf16(b[2], b[3]); return w; }
__device__ __forceinline__ void unpack8(const u32x4 w, f32x4& a, f32x4& b) { a[0] = bf_lo(w.x); a[1] = bf_hi(w.x); a[2] = bf_lo(w.y); a[3] = bf_hi(w.y); b[0] = bf_lo(w.z); b[1] = bf_hi(w.z); b[2] = bf_lo(w.w); b[3] = bf_hi(w.w); }


typedef __amdgpu_buffer_rsrc_t rsrc_t;
__device__ __forceinline__ rsrc_t mkrsrc(const void* p) { return __builtin_amdgcn_make_buffer_rsrc(const_cast<void*>(p), 0, 0x7fffffff, 0x00020000); }
__device__ __forceinline__ u32x4 bld16(rsrc_t r, unsigned voff, unsigned soff) { return __builtin_amdgcn_raw_buffer_load_b128(r, (int)voff, (int)soff, 0); }
__device__ __forceinline__ void bst16(rsrc_t r, unsigned voff, unsigned soff, u32x4 v) { unsigned vo = voff + soff; asm volatile("" : "+v"(vo)); __builtin_amdgcn_raw_buffer_store_b128(v, r, (int)vo, 0, 0); }
__device__ __forceinline__ f32x4 as_f(u32x4 v) { return __builtin_bit_cast(f32x4, v); }
__device__ __forceinline__ u32x4 as_u(f32x4 v) { return __builtin_bit_cast(u32x4, v); }

struct EpiInProj {
    static constexpr bool PERM = true, AFTER_DRAIN = false, MID = false;
    bf16_t *QZ, *S, *V, *GA, *GB;
    __device__ __forceinline__ void mid(f32x4 (&)[2][2][4][2], const Unit&, int, int, int, int) const {}
    template <int TYPE> __device__ __forceinline__ void pair(const f32x4 (&acc)[2][2][4][2], rsrc_t r, unsigned sbase, unsigned voff, unsigned ldb) const {
#pragma unroll
        for (int ai = 0; ai < 2; ++ai)
#pragma unroll
            for (int m = 0; m < 4; ++m) {
                f32x4 o[2];
#pragma unroll
                for (int bj = 0; bj < 2; ++bj) { const f32x4 X = acc[ai][bj][m][0], Y = acc[ai][bj][m][1];
#pragma unroll
                    for (int j = 0; j < 4; ++j) { if (TYPE == 1) o[bj][j] = X[j] * Y[j]; else { const float sg = sigmoidf_(Y[j]); o[bj][j] = TYPE == 0 ? X[j] * Y[j] * sg : X[j] * sg; } } }
                bst16(r, voff, sbase + (unsigned)(ai * HALF + m * 16) * ldb, pack8(o[0], o[1]));
            }
    }
    template <int TYPE> __device__ __forceinline__ void single(const f32x4 (&acc)[2][2][4][2], rsrc_t r, unsigned sbase, unsigned voff, unsigned ldb) const {
#pragma unroll
        for (int ai = 0; ai < 2; ++ai)
#pragma unroll
            for (int m = 0; m < 4; ++m)
#pragma unroll
                for (int bj = 0; bj < 2; ++bj) { f32x4 v0 = acc[ai][bj][m][0], v1 = acc[ai][bj][m][1];
#pragma unroll
                    for (int j = 0; j < 4; ++j) { const float s0 = sigmoidf_(v0[j]), s1 = sigmoidf_(v1[j]); v0[j] = TYPE == 0 ? v0[j] * s0 : s0; v1[j] = TYPE == 0 ? v1[j] * s1 : s1; }
                    bst16(r, voff, sbase + (unsigned)(ai * HALF + m * 16) * ldb + bj * (HALF * 2), pack8(v0, v1)); }
    }
    __device__ __forceinline__ void operator()(const f32x4 (&acc)[2][2][4][2], const Unit& u, int wr, int wc, int fr, int fq) const {
        const unsigned urow = u.pm * BM + wr * 64, pn = u.pn;
        if (pn < 24) {
            const unsigned type = pn >> 3, ucb = (pn & 7) * 128 + 32 * wc;
            if (type == 0) pair<0>(acc, mkrsrc(QZ), (urow * 2048 + ucb) * 2, (unsigned)(fr * 2048 + 8 * fq) * 2u, 4096);
#if !defined(DBG_ONLYQZ)
            else if (type == 1) pair<1>(acc, mkrsrc(S), (urow * 1024 + ucb) * 2, (unsigned)(fr * 1024 + 8 * fq) * 2u, 2048);
            else pair<2>(acc, mkrsrc(V), (urow * 1024 + ucb) * 2, (unsigned)(fr * 1024 + 8 * fq) * 2u, 2048);
#endif
        } else {
            const unsigned t = (pn - 24) >> 2, ucb = ((pn - 24) & 3) * 256 + wc * 32;
            if (t == 0) single<0>(acc, mkrsrc(QZ), (urow * 2048 + 1024 + ucb) * 2, (unsigned)(fr * 2048 + 8 * fq) * 2u, 4096);
#if !defined(DBG_ONLYQZ)
            else if (t == 1) single<1>(acc, mkrsrc(GA), (urow * 1024 + ucb) * 2, (unsigned)(fr * 1024 + 8 * fq) * 2u, 2048);
            else single<1>(acc, mkrsrc(GB), (urow * 1024 + ucb) * 2, (unsigned)(fr * 1024 + 8 * fq) * 2u, 2048);
#endif
        }
    }
};
struct EpiPlain {
    static constexpr bool PERM = true, AFTER_DRAIN = false, MID = false;
    bf16_t* O; int ldc;
    __device__ __forceinline__ void mid(f32x4 (&)[2][2][4][2], const Unit&, int, int, int, int) const {}
    __device__ __forceinline__ void operator()(const f32x4 (&acc)[2][2][4][2], const Unit& u, int wr, int wc, int fr, int fq) const {
#if defined(DBG_DUMP) && DBG_DUMP == 2
        if (u.pn >= 8) return;
#endif
        const rsrc_t r = mkrsrc(O); const unsigned sb = ((unsigned)(u.pm * BM + wr * 64) * ldc + u.pn * BM + wc * 32) * 2, voff = (unsigned)(fr * ldc + 8 * fq) * 2u;
#pragma unroll
        for (int ai = 0; ai < 2; ++ai)
#pragma unroll
            for (int m = 0; m < 4; ++m)
#pragma unroll
                for (int bj = 0; bj < 2; ++bj) bst16(r, voff, sb + (unsigned)(ai * HALF + m * 16) * ldc * 2 + bj * (HALF * 2), pack8(acc[ai][bj][m][0], acc[ai][bj][m][1]));
    }
};
struct EpiOutGate {
    static constexpr bool PERM = true, AFTER_DRAIN = false, MID = true;
    const bf16_t *GA, *GB; bf16_t* Mo;
    __device__ __forceinline__ void mid(f32x4 (&acc)[2][2][4][2], const Unit& u, int wr, int wc, int fr, int fq) const {
        const rsrc_t ra = mkrsrc(GA), rb = mkrsrc(GB);
        const unsigned sb = ((unsigned)(u.pm * BM + wr * 64) * 1024 + u.pn * BM + wc * 32) * 2, voff = (unsigned)(fr * 1024 + 8 * fq) * 2u;
#pragma unroll
        for (int ai = 0; ai < 2; ++ai)
#pragma unroll
            for (int m = 0; m < 4; ++m) {
#pragma unroll
                for (int bj = 0; bj < 2; ++bj) { const unsigned so = sb + (unsigned)(ai * HALF + m * 16) * 2048 + bj * 256;
                    const u32x4 ga = bld16(ra, voff, so), gb = bld16(rb, voff, so); f32x4 a0, a1, b0, b1; unpack8(ga, a0, a1); unpack8(gb, b0, b1);
#pragma unroll
                    for (int j = 0; j < 4; ++j) { acc[ai][bj][m][0][j] *= a0[j] * __builtin_amdgcn_rcpf(fmaxf(b0[j], 1e-30f)); acc[ai][bj][m][1][j] *= a1[j] * __builtin_amdgcn_rcpf(fmaxf(b1[j], 1e-30f)); } }
                asm volatile("" ::: "memory"); }
    }
    __device__ __forceinline__ void operator()(const f32x4 (&acc)[2][2][4][2], const Unit& u, int wr, int wc, int fr, int fq) const {
        const rsrc_t rb = mkrsrc(GB), ro = mkrsrc(Mo);
        const unsigned sb = ((unsigned)(u.pm * BM + wr * 64) * 1024 + u.pn * BM + wc * 32) * 2, voff = (unsigned)(fr * 1024 + 8 * fq) * 2u;
#pragma unroll
        for (int ai = 0; ai < 2; ++ai)
#pragma unroll
            for (int m = 0; m < 4; ++m) {
#pragma unroll
                for (int bj = 0; bj < 2; ++bj) { const unsigned so = sb + (unsigned)(ai * HALF + m * 16) * 2048 + bj * 256;
                    const u32x4 gb = bld16(rb, voff, so); f32x4 b0, b1; unpack8(gb, b0, b1);
                    bst16(ro, voff, so, pack8(acc[ai][bj][m][0] * b0, acc[ai][bj][m][1] * b1)); }
                asm volatile("" ::: "memory"); }
    }
};
struct EpiWo {
    static constexpr bool PERM = true, AFTER_DRAIN = false, MID = false;
    const float *xp, *xs; float* H; bf16_t* HB; float* ssq;
    __device__ __forceinline__ void mid(f32x4 (&)[2][2][4][2], const Unit&, int, int, int, int) const {}
    __device__ __forceinline__ void operator()(const f32x4 (&acc)[2][2][4][2], const Unit& u, int wr, int wc, int fr, int fq) const {
        const unsigned urow = u.pm * BM + wr * 64, ucol = u.pn * BM + wc * 32;
        const bool smp = u.pm >= 64;
        const rsrc_t rx = mkrsrc(smp ? xs : xp), rh = mkrsrc(H), rb = mkrsrc(HB);
        const unsigned ue = urow * 1024 + ucol, uex = (smp ? urow - 16384u : urow) * 1024 + ucol, ve = (unsigned)(fr * 1024 + 8 * fq);
        float* sq = ssq + urow + fr;
#pragma unroll
        for (int ai = 0; ai < 2; ++ai)
#pragma unroll
            for (int m = 0; m < 4; ++m) { const unsigned ro = (unsigned)(ai * HALF + m * 16) * 1024; float ss = 0.f;
#pragma unroll
                for (int bj = 0; bj < 2; ++bj) {
                    const f32x4 h0 = as_f(bld16(rx, ve * 4u, (uex + ro) * 4u + bj * 512)) + acc[ai][bj][m][0], h1 = as_f(bld16(rx, ve * 4u, (uex + ro) * 4u + bj * 512 + 16)) + acc[ai][bj][m][1];
                    bst16(rh, ve * 4u, (ue + ro) * 4u + bj * 512, as_u(h0)); bst16(rh, ve * 4u, (ue + ro) * 4u + bj * 512 + 16, as_u(h1)); bst16(rb, ve * 2u, (ue + ro) * 2u + bj * 256, pack8(h0, h1));
                    ss += (h0[0] * h0[0] + h0[1] * h0[1]) + (h0[2] * h0[2] + h0[3] * h0[3]) + (h1[0] * h1[0] + h1[1] * h1[1]) + (h1[2] * h1[2] + h1[3] * h1[3]);
                    asm volatile("" ::: "memory"); }
                ss += __shfl_xor(ss, 16); ss += __shfl_xor(ss, 32);
                if (fq == 0) atomicAdd(sq + ai * HALF + m * 16, ss);
                asm volatile("" ::: "memory"); }
    }
};
struct EpiPg {
    static constexpr bool PERM = true, AFTER_DRAIN = false, MID = false;
    float* H; const bf16_t* PE; const float* ssq; float* ssq2;
    __device__ __forceinline__ void mid(f32x4 (&)[2][2][4][2], const Unit&, int, int, int, int) const {}
    __device__ __forceinline__ void operator()(const f32x4 (&acc)[2][2][4][2], const Unit& u, int wr, int wc, int fr, int fq) const {
        const unsigned urow = u.pm * BM + wr * 64, ucol = u.pn * BM + wc * 32;
        const rsrc_t rh = mkrsrc(H), rp = mkrsrc(PE);
        const unsigned ue = urow * 1024 + ucol, ve = (unsigned)(fr * 1024 + 8 * fq);
        const float* sq = ssq + urow + fr; float* sq2 = ssq2 + urow + fr;
#pragma unroll
        for (int ai = 0; ai < 2; ++ai)
#pragma unroll
            for (int m = 0; m < 4; ++m) { const unsigned ro = (unsigned)(ai * HALF + m * 16) * 1024; float ss = 0.f;
                const float rstd = 1.0f / sqrtf(sq[ai * HALF + m * 16] * (1.0f / 1024.0f) + 1e-6f);
#pragma unroll
                for (int bj = 0; bj < 2; ++bj) {
                    f32x4 h0 = as_f(bld16(rh, ve * 4u, (ue + ro) * 4u + bj * 512)), h1 = as_f(bld16(rh, ve * 4u, (ue + ro) * 4u + bj * 512 + 16)); const u32x4 pe = bld16(rp, ve * 2u, (ue + ro) * 2u + bj * 256); f32x4 p0, p1; unpack8(pe, p0, p1);
#pragma unroll
                    for (int j = 0; j < 4; ++j) { h0[j] += sigmoidf_(acc[ai][bj][m][0][j] * rstd) * p0[j]; h1[j] += sigmoidf_(acc[ai][bj][m][1][j] * rstd) * p1[j]; }
                    bst16(rh, ve * 4u, (ue + ro) * 4u + bj * 512, as_u(h0)); bst16(rh, ve * 4u, (ue + ro) * 4u + bj * 512 + 16, as_u(h1));
                    ss += (h0[0] * h0[0] + h0[1] * h0[1]) + (h0[2] * h0[2] + h0[3] * h0[3]) + (h1[0] * h1[0] + h1[1] * h1[1]) + (h1[2] * h1[2] + h1[3] * h1[3]); }
                ss += __shfl_xor(ss, 16); ss += __shfl_xor(ss, 32);
                if (fq == 0) atomicAdd(sq2 + ai * HALF + m * 16, ss);
                asm volatile("" ::: "memory"); }
    }
};

template <class Epi, class Sched, bool ALIGN_EPI = false, bool SP2 = false>
__device__ __forceinline__ void gemm_phase(PG8_LAS unsigned char* lds, const Gemm g, const Sched& S, const Epi& E) {
    const int tid = threadIdx.x, wid = __builtin_amdgcn_readfirstlane(tid >> 6), lane = tid & 63, wr = wid >> 2, wc = wid & 3, fr = lane & 15, fq = lane >> 4;
    const int K = g.K, nt = K / BK;
    unsigned voffA[2], voffB[2];
#pragma unroll
    for (int i = 0; i < 2; ++i) { int R, C; stage_rc(tid * 16 + i * 8192, R, C); const int Rb = Epi::PERM ? ((R & ~31) + perm32(R & 31)) : R;
        voffA[i] = (unsigned)(R * K + C) * 2u; voffB[i] = (unsigned)(Rb * K + C) * 2u; }
    const size_t kstep = (size_t)(BK * 2);
    const size_t hstep = (size_t)HALF * K * 2;
    const size_t tstep = 2 * hstep;
    const unsigned ldsw = (unsigned)wid * 1024u;
    const int aoff = lds_byte(wr * 64 + fr, fq * 8), boff = lds_byte(wc * 32 + fr, fq * 8);
#define PG8_SA(b, h) (((b) * 2 + (h)) * HTB)
#define PG8_SB(b, h) ((4 + (b) * 2 + (h)) * HTB)
#define PG8_STAGE(bufoff, gbase, voff) do { _Pragma("unroll") for (int _i = 0; _i < 2; ++_i) \
        __builtin_amdgcn_global_load_lds((const unsigned*)((const char*)(gbase) + (voff)[_i]), (PG8_LAS unsigned*)(lds + (bufoff) + ldsw + _i * 8192), 16, 0, 0); } while (0)
#define PG8_LDA(dst, b, h) do { _Pragma("unroll") for (int m = 0; m < 4; ++m) _Pragma("unroll") for (int k = 0; k < 2; ++k) dst[m][k] = *(const PG8_LAS bf16x8*)(lds + PG8_SA(b, h) + aoff + m * 2048 + k * 1024); } while (0)
#define PG8_LDB(dst, b, h) do { _Pragma("unroll") for (int n = 0; n < 2; ++n) _Pragma("unroll") for (int k = 0; k < 2; ++k) dst[n][k] = *(const PG8_LAS bf16x8*)(lds + PG8_SB(b, h) + boff + n * 2048 + k * 1024); } while (0)
#define PG8_MMA(ai, bj, At, Bt) do { __builtin_amdgcn_s_setprio(1); _Pragma("unroll") for (int m = 0; m < 4; ++m) _Pragma("unroll") for (int n = 0; n < 2; ++n) _Pragma("unroll") for (int k = 0; k < 2; ++k) \
        acc[ai][bj][m][n] = __builtin_amdgcn_mfma_f32_16x16x32_bf16(Bt[n][k], At[m][k], acc[ai][bj][m][n], 0, 0, 0); __builtin_amdgcn_s_setprio(0); } while (0)
#define PG8_WAIT_V(n) asm volatile("s_waitcnt vmcnt(" #n ")" ::: "memory")
#define PG8_WAIT_L(n) asm volatile("s_waitcnt lgkmcnt(" #n ")" ::: "memory")
#define PG8_BAR __builtin_amdgcn_s_barrier()
#define PG8_SCHED __builtin_amdgcn_sched_barrier(0)
    Unit cur, nxt; int ui = 0;
    if (!S.next(0, cur)) return;
    f32x4 acc[2][2][4][2];
#pragma unroll
    for (int a = 0; a < 2; ++a)
#pragma unroll
        for (int b = 0; b < 2; ++b)
#pragma unroll
            for (int m = 0; m < 4; ++m)
#pragma unroll
                for (int n = 0; n < 2; ++n) acc[a][b][m][n] = (f32x4){0.f, 0.f, 0.f, 0.f};
    bf16x8 At[4][2], B0[2][2], B1[2][2];
    const char* cA = (const char*)g.A + (size_t)cur.pm * tstep; const char* cB = (const char*)g.Bt + (size_t)cur.pn * tstep;
    S.a_ready(cur);
    if constexpr (SP2) {
        PG8_STAGE(PG8_SB(0, 0), cB, voffB); PG8_STAGE(PG8_SB(0, 1), cB + hstep, voffB); PG8_STAGE(PG8_SA(0, 0), cA, voffA); PG8_STAGE(PG8_SA(0, 1), cA + hstep, voffA);
        if (wr == 1) PG8_BAR;
        PG8_WAIT_V(2); PG8_BAR;
        PG8_STAGE(PG8_SB(1, 0), cB + kstep, voffB); PG8_STAGE(PG8_SA(1, 0), cA + kstep, voffA); PG8_STAGE(PG8_SB(1, 1), cB + hstep + kstep, voffB);
        PG8_WAIT_V(6); PG8_BAR;
    } else {
        PG8_STAGE(PG8_SB(0, 0), cB, voffB); PG8_STAGE(PG8_SA(0, 0), cA, voffA); PG8_STAGE(PG8_SB(0, 1), cB + hstep, voffB); PG8_STAGE(PG8_SA(0, 1), cA + hstep, voffA);
        if (wr == 1) PG8_BAR;
        PG8_WAIT_V(4); PG8_BAR;
        PG8_STAGE(PG8_SB(1, 0), cB + kstep, voffB); PG8_STAGE(PG8_SA(1, 0), cA + kstep, voffA); PG8_STAGE(PG8_SB(1, 1), cB + hstep + kstep, voffB);
        PG8_WAIT_V(6); PG8_BAR;
    }
    for (;;) {
        const bool has_next = S.next(ui + 1, nxt);
        const char* nA = has_next ? (const char*)g.A + (size_t)nxt.pm * tstep : cA; const char* nB = has_next ? (const char*)g.Bt + (size_t)nxt.pn * tstep : cB;
        for (int th = 0; th < (Epi::MID ? 2 : 1); ++th) {
        if constexpr (Epi::MID) { if (th == 1) E.mid(acc, cur, wr, wc, fr, fq); }
        const int t_lo = Epi::MID ? th * (nt >> 1) : 0, t_hi = Epi::MID ? (th + 1) * (nt >> 1) : nt;
#pragma unroll 1
        for (int t = t_lo; t < t_hi; t += 2) {
            const bool last = (t == nt - 2);
            const char* a1 = cA + (size_t)(t + 1) * kstep;
            const char* a2 = last ? nA : cA + (size_t)(t + 2) * kstep; const char* b2 = last ? nB : cB + (size_t)(t + 2) * kstep;
            const char* a3 = a2 + kstep; const char* b3 = b2 + kstep;
            if (last && has_next) S.a_ready(nxt);
            if constexpr (SP2) {
            PG8_LDB(B0, 0, 0); PG8_LDB(B1, 0, 1); PG8_SCHED; PG8_LDA(At, 0, 0); PG8_STAGE(PG8_SA(1, 1), a1 + hstep, voffA);
            PG8_WAIT_V(8); PG8_WAIT_L(0); PG8_BAR; PG8_MMA(0, 0, At, B0); PG8_MMA(0, 1, At, B1); PG8_BAR; PG8_SCHED;
            PG8_LDA(At, 0, 1); PG8_STAGE(PG8_SB(0, 0), b2, voffB); PG8_STAGE(PG8_SB(0, 1), b2 + hstep, voffB); PG8_STAGE(PG8_SA(0, 0), a2, voffA);
            PG8_WAIT_V(8); PG8_WAIT_L(0); PG8_BAR; PG8_MMA(1, 0, At, B0); PG8_MMA(1, 1, At, B1); PG8_BAR; PG8_SCHED;
            PG8_LDB(B0, 1, 0); PG8_LDB(B1, 1, 1); PG8_SCHED; PG8_LDA(At, 1, 0); PG8_STAGE(PG8_SA(0, 1), a2 + hstep, voffA);
            PG8_WAIT_V(8); PG8_WAIT_L(0); PG8_BAR; PG8_MMA(0, 0, At, B0); PG8_MMA(0, 1, At, B1); PG8_BAR; PG8_SCHED;
            PG8_LDA(At, 1, 1); PG8_STAGE(PG8_SB(1, 0), b3, voffB); PG8_STAGE(PG8_SB(1, 1), b3 + hstep, voffB); PG8_STAGE(PG8_SA(1, 0), a3, voffA);
            PG8_WAIT_V(8); PG8_WAIT_L(0); PG8_BAR; PG8_MMA(1, 0, At, B0); PG8_MMA(1, 1, At, B1); PG8_BAR; PG8_SCHED;
            } else {
            PG8_LDB(B0, 0, 0); PG8_SCHED; PG8_LDA(At, 0, 0); PG8_STAGE(PG8_SA(1, 1), a1 + hstep, voffA);
            PG8_WAIT_L(8); PG8_BAR; PG8_WAIT_L(0); PG8_MMA(0, 0, At, B0); PG8_BAR; PG8_SCHED;
            PG8_LDB(B1, 0, 1); PG8_STAGE(PG8_SB(0, 0), b2, voffB);
            PG8_BAR; PG8_WAIT_L(0); PG8_MMA(0, 1, At, B1); PG8_BAR;
            PG8_LDA(At, 0, 1); PG8_STAGE(PG8_SA(0, 0), a2, voffA);
            PG8_BAR; PG8_WAIT_L(0); PG8_MMA(1, 0, At, B0); PG8_BAR; PG8_SCHED;
            PG8_STAGE(PG8_SB(0, 1), b2 + hstep, voffB);
            PG8_WAIT_V(6); PG8_BAR; PG8_MMA(1, 1, At, B1); PG8_BAR;
            PG8_LDB(B0, 1, 0); PG8_SCHED; PG8_LDA(At, 1, 0); PG8_STAGE(PG8_SA(0, 1), a2 + hstep, voffA);
            PG8_WAIT_L(8); PG8_BAR; PG8_WAIT_L(0); PG8_MMA(0, 0, At, B0); PG8_BAR; PG8_SCHED;
            PG8_LDB(B1, 1, 1); PG8_STAGE(PG8_SB(1, 0), b3, voffB);
            PG8_BAR; PG8_WAIT_L(0); PG8_MMA(0, 1, At, B1); PG8_BAR;
            PG8_LDA(At, 1, 1); PG8_STAGE(PG8_SA(1, 0), a3, voffA);
            PG8_BAR; PG8_WAIT_L(0); PG8_MMA(1, 0, At, B0); PG8_BAR; PG8_SCHED;
            PG8_STAGE(PG8_SB(1, 1), b3 + hstep, voffB);
            PG8_WAIT_V(6); PG8_BAR; PG8_MMA(1, 1, At, B1); PG8_BAR;
            }
        }
        }
        if constexpr (ALIGN_EPI) { if (wr == 0) PG8_BAR; }
        if constexpr (!Epi::AFTER_DRAIN) { E(acc, cur, wr, wc, fr, fq); S.done(cur); }
        if (!has_next) break;
#pragma unroll
        for (int a = 0; a < 2; ++a)
#pragma unroll
            for (int b = 0; b < 2; ++b)
#pragma unroll
                for (int m = 0; m < 4; ++m)
#pragma unroll
                    for (int n = 0; n < 2; ++n) acc[a][b][m][n] = (f32x4){0.f, 0.f, 0.f, 0.f};
        cur = nxt; cA = nA; cB = nB; ++ui;
        if constexpr (ALIGN_EPI) { if (wr == 1) PG8_BAR; }
    }
    PG8_WAIT_V(0);
    if constexpr (!ALIGN_EPI) { if (wr == 0) PG8_BAR; }
    PG8_BAR;
#undef PG8_SA
#undef PG8_SB
#undef PG8_STAGE
#undef PG8_LDA
#undef PG8_LDB
#undef PG8_MMA
#undef PG8_WAIT_V
#undef PG8_WAIT_L
#undef PG8_BAR
#undef PG8_SCHED
}
}

#ifndef PG8_SP2
#define PG8_SP2 true
#endif
#ifndef PG8_ALIGN
#define PG8_ALIGN true
#endif

constexpr int NWAVES = 8;
constexpr int DM = 1024, NP = 16384, NS = 1024, T = NP + NS, SEQ = 2048, DSEQ = 8, DIN = 9216, PLE = 256;
constexpr float EPS = 1e-6f, LN_EPS = 1e-5f;
constexpr size_t OFF_NAP = (size_t)T * DM, OFF_NBP = OFF_NAP + 8 * 2 * 1024, OFF_NAS = OFF_NBP + 8 * 30 * 1024, OFF_NBS = OFF_NAS + 128 * 2 * 1024;
constexpr size_t MiB = 1u << 20;
constexpr size_t WS_CTL = 0, CTL_ZERO_BYTES = 2 * MiB;
constexpr size_t WS_SSQ = 1 * MiB, WS_SSQ2 = 1 * MiB + 256 * 1024;
constexpr size_t WS_WIN = 2 * MiB, WS_WAB = 20 * MiB, WS_WO = 24 * MiB, WS_WPG = 26 * MiB, WS_WPE = 28 * MiB;
constexpr size_t WS_PB = 29 * MiB;
constexpr size_t WS_XB = 38 * MiB;
constexpr size_t WS_QZ = 72 * MiB;
constexpr size_t WS_S = 140 * MiB;
constexpr size_t WS_V = 174 * MiB;
constexpr size_t WS_END = 208 * MiB;
constexpr int CW_BAR = 4096;
constexpr int RING_BYTES = 131072, LDSCTL_OFF = RING_BYTES, MISC_OFF = LDSCTL_OFF + 320, LDS_BYTES = 147456;

#define GAS __attribute__((address_space(1)))
#define LAS __attribute__((address_space(3)))
typedef unsigned short bf16;
typedef unsigned v4u __attribute__((ext_vector_type(4)));
typedef unsigned v2u __attribute__((ext_vector_type(2)));
typedef float f32x4 __attribute__((ext_vector_type(4)));
typedef float f32x2 __attribute__((ext_vector_type(2)));
#define LDS_WAIT() asm volatile("s_waitcnt lgkmcnt(0)" ::: "memory")
using pg8::cvt_pk_bf16; using pg8::bf_lo; using pg8::bf_hi; using pg8::sigmoidf_;

#define XB_TMO      128
#define XB_XCNT(j)  (256  + 64 * (j))
#define XB_XSUB(j)  (1280 + 64 * (j))
#define XB_XGEN(j)  (2304 + 64 * (j))
#define XB_TOP      3328
#define XB_TOPGEN   3392
#define XCD_BAR_WORDS 3456
#define XB_SPIN_CAP (1u << 18)
__device__ __forceinline__ unsigned xb_ld(unsigned* p)              { return __hip_atomic_load(p, __ATOMIC_RELAXED, __HIP_MEMORY_SCOPE_AGENT); }
__device__ __forceinline__ unsigned xb_add(unsigned* p, unsigned v) { return __hip_atomic_fetch_add(p, v, __ATOMIC_RELAXED, __HIP_MEMORY_SCOPE_AGENT); }
__device__ __forceinline__ unsigned xb_xcc_id() { return (unsigned)__builtin_amdgcn_s_getreg((3 << 11) | 20) & 0xFu; }
#define XB_SPIN(cond, bar) do { unsigned _sp = 0; while (cond) { __builtin_amdgcn_s_sleep(1); \
    if ((++_sp & 255u) == 0u) { if (xb_ld(&(bar)[XB_TMO])) break; if (_sp > XB_SPIN_CAP) { atomicAdd(&(bar)[XB_TMO], 1u); break; } } } } while (0)
struct XcdBarrier { unsigned* bar; unsigned x; volatile LAS unsigned* st; };
__device__ __forceinline__ XcdBarrier xcd_barrier_post(unsigned* bar, volatile LAS unsigned* st) {
    XcdBarrier b; b.bar = bar; b.x = xb_xcc_id(); b.st = st;
    if (threadIdx.x == 0) (void)xb_add(&bar[XB_XCNT(b.x)], 1u);
    return b;
}
__device__ __forceinline__ void xcd_barrier_complete(unsigned* bar, unsigned x, unsigned& nloc, unsigned& nx) {
    const unsigned G = gridDim.x * gridDim.y * gridDim.z;
    unsigned sum, cnt, mine, sp = 0u;
    for (;;) {
        sum = 0u; cnt = 0u; mine = 0u;
#pragma unroll
        for (unsigned j = 0; j < 16; ++j) { const unsigned c = xb_ld(&bar[XB_XCNT(j)]); sum += c; cnt += (c > 0u) ? 1u : 0u; mine = (j == x) ? c : mine; }
        if (sum == G) break;
        __builtin_amdgcn_s_sleep(1);
        if ((++sp & 255u) == 0u) { if (xb_ld(&bar[XB_TMO])) break; if (sp > XB_SPIN_CAP) { atomicAdd(&bar[XB_TMO], 1u); break; } }
    }
    nloc = mine > 0u ? mine : 1u; nx = cnt > 0u ? cnt : 1u;
}
__device__ __forceinline__ void xcd_barrier(const XcdBarrier& b) {
    asm volatile("s_waitcnt vmcnt(0)" ::: "memory");
    __syncthreads();
    if (threadIdx.x == 0) {
        unsigned* bar = b.bar;
        __builtin_amdgcn_s_waitcnt(0);
        unsigned nloc = b.st[0], nx = b.st[1];
        if (nloc == 0u) { xcd_barrier_complete(bar, b.x, nloc, nx); b.st[0] = nloc; b.st[1] = nx; }
        const unsigned old = xb_add(&bar[XB_XSUB(b.x)], 1u);
        const unsigned gen = old / nloc;
        if (old + 1u == (gen + 1u) * nloc) {
            __builtin_amdgcn_fence(__ATOMIC_RELEASE, "agent");
            asm volatile("s_waitcnt vmcnt(0)" ::: "memory");
            const unsigned og = xb_add(&bar[XB_TOP], 1u);
            const unsigned tg = og / nx;
            if (og + 1u == (tg + 1u) * nx) xb_add(&bar[XB_TOPGEN], 1u);
            else XB_SPIN(xb_ld(&bar[XB_TOPGEN]) == tg, bar);
            __builtin_amdgcn_fence(__ATOMIC_ACQUIRE, "agent");
            xb_add(&bar[XB_XGEN(b.x)], 1u);
            asm volatile("s_waitcnt vmcnt(0)" ::: "memory");
        } else {
            XB_SPIN(xb_ld(&bar[XB_XGEN(b.x)]) == gen, bar);
            __builtin_amdgcn_fence(__ATOMIC_ACQUIRE, "agent");
            asm volatile("s_waitcnt vmcnt(0)" ::: "memory");
        }
    }
    __syncthreads();
}

__device__ __forceinline__ float wave_sum(float v) {
#pragma unroll
    for (int o = 1; o < 64; o <<= 1) v += __shfl_xor(v, o);
    return v;
}

template <class RowMap>
__device__ __forceinline__ void p0_transpose_item(const float* W, int N, bf16* WT, int ldk, int koff, const float* gk, RowMap rm, LAS float* scr, int item, int lane) {
    const int nblk = N / 32, kb = item / nblk, nb = item % nblk, k0 = 64 * kb, n0 = 32 * nb;
#pragma unroll 8
    for (int i = 0; i < 32; ++i) { const int kk = 2 * i + (lane >> 5); float w = W[(size_t)(k0 + kk) * N + n0 + (lane & 31)]; if (gk) w *= gk[k0 + kk]; scr[kk * 33 + (lane & 31)] = w; }
    LDS_WAIT(); asm volatile("" ::: "memory");
    const int c = lane & 7;
#pragma unroll
    for (int j = 0; j < 4; ++j) { const int n = (lane >> 3) + 8 * j; const LAS float* s = scr + (8 * c) * 33 + n;
        v4u o; o.x = cvt_pk_bf16(s[0 * 33], s[1 * 33]); o.y = cvt_pk_bf16(s[2 * 33], s[3 * 33]); o.z = cvt_pk_bf16(s[4 * 33], s[5 * 33]); o.w = cvt_pk_bf16(s[6 * 33], s[7 * 33]);
        *(GAS v4u*)(WT + (size_t)rm(n0 + n) * ldk + koff + k0 + 8 * c) = o; }
    LDS_WAIT(); asm volatile("" ::: "memory");
}
struct RowId { __device__ __forceinline__ int operator()(int n) const { return n; } };
struct RowInProj { __device__ __forceinline__ int operator()(int sc) const {
    const int g = sc >> 10, ch = sc & 1023;
    if (g >= 6) return 256 * (24 + 4 * (g - 6) + (ch >> 8)) + (ch & 255);
    int base, isY;
    switch (g) { case 0: base = 0; isY = 0; break; case 3: base = 0; isY = 1; break; case 1: base = 8; isY = 0; break; case 2: base = 8; isY = 1; break; case 4: base = 16; isY = 0; break; default: base = 16; isY = 1; break; }
    const int cl = ch & 127, grp = cl >> 3, r8 = cl & 7, bj = r8 >> 2, j = r8 & 3;
    return 256 * (base + (ch >> 7)) + 128 * bj + 8 * grp + 4 * isY + j; } };

struct Ptrs {
    const float *x_p, *x_s, *st_a, *st_b, *p_p, *p_s, *g_mix, *w_in, *w_conv_a, *w_out_a, *w_conv_b, *b_conv_b, *ln_g, *ln_b, *w_out_b, *w_o, *w_pe, *g_ple, *w_pg, *g_final;
    float* out; unsigned char* ws;
};

typedef const __attribute__((address_space(4))) Ptrs* KPtrsT;
__device__ __forceinline__ Ptrs load_ptrs(KPtrsT k) {
    Ptrs P;
    P.x_p = k->x_p; P.x_s = k->x_s; P.st_a = k->st_a; P.st_b = k->st_b; P.p_p = k->p_p; P.p_s = k->p_s; P.g_mix = k->g_mix; P.w_in = k->w_in; P.w_conv_a = k->w_conv_a; P.w_out_a = k->w_out_a;
    P.w_conv_b = k->w_conv_b; P.b_conv_b = k->b_conv_b; P.ln_g = k->ln_g; P.ln_b = k->ln_b; P.w_out_b = k->w_out_b; P.w_o = k->w_o; P.w_pe = k->w_pe; P.g_ple = k->g_ple; P.w_pg = k->w_pg; P.g_final = k->g_final;
    P.out = k->out; P.ws = k->ws; return P;
}
__device__ __forceinline__ void p0_prologue(const Ptrs& P, LAS unsigned char* lds, int gw, int NGW, int lane, int wave) {
    LAS float* scr = (LAS float*)(lds + wave * 16384);
    bf16* Wt_in = (bf16*)(P.ws + WS_WIN); bf16* Wt_ab = (bf16*)(P.ws + WS_WAB); bf16* Wt_o = (bf16*)(P.ws + WS_WO); bf16* Wt_pg = (bf16*)(P.ws + WS_WPG); bf16* Wt_pe = (bf16*)(P.ws + WS_WPE);
    constexpr int I_IN = (DM / 64) * (DIN / 32), I_SQ = (DM / 64) * (DM / 32), I_PE = (PLE / 64) * (DM / 32);
    constexpr int NITEMS = I_IN + 4 * I_SQ + I_PE;
    for (int it = gw; it < NITEMS; it += NGW) {
        int r = it;
        if (r < I_IN) { p0_transpose_item(P.w_in, DIN, Wt_in, DM, 0, P.g_mix, RowInProj(), scr, r, lane); continue; } r -= I_IN;
        if (r < I_SQ) { p0_transpose_item(P.w_out_a, DM, Wt_ab, 2 * DM, 0, nullptr, RowId(), scr, r, lane); continue; } r -= I_SQ;
        if (r < I_SQ) { p0_transpose_item(P.w_out_b, DM, Wt_ab, 2 * DM, DM, nullptr, RowId(), scr, r, lane); continue; } r -= I_SQ;
        if (r < I_SQ) { p0_transpose_item(P.w_o, DM, Wt_o, DM, 0, nullptr, RowId(), scr, r, lane); continue; } r -= I_SQ;
        if (r < I_SQ) { p0_transpose_item(P.w_pg, DM, Wt_pg, DM, 0, P.g_ple, RowId(), scr, r, lane); continue; } r -= I_SQ;
        p0_transpose_item(P.w_pe, DM, Wt_pe, PLE, 0, nullptr, RowId(), scr, r, lane);
    }
    bf16* XB = (bf16*)(P.ws + WS_XB); bf16* PB = (bf16*)(P.ws + WS_PB);
    for (int m = gw; m < T; m += NGW) {
        const float* xrow = m < NP ? P.x_p + (size_t)m * DM : P.x_s + (size_t)(m - NP) * DM;
        const GAS f32x4* xr = (const GAS f32x4*)xrow + lane;
        f32x4 v[4]; float s = 0.f;
#pragma unroll
        for (int j = 0; j < 4; ++j) { v[j] = xr[64 * j]; s += (v[j].x * v[j].x + v[j].y * v[j].y) + (v[j].z * v[j].z + v[j].w * v[j].w); }
        const float rstd = 1.0f / sqrtf(wave_sum(s) * (1.0f / DM) + EPS);
        GAS v2u* o8 = (GAS v2u*)(XB + (size_t)m * DM) + lane;
#pragma unroll
        for (int j = 0; j < 4; ++j) { v2u w; w.x = cvt_pk_bf16(v[j].x * rstd, v[j].y * rstd); w.y = cvt_pk_bf16(v[j].z * rstd, v[j].w * rstd); o8[64 * j] = w; }
        const float* prow = m < NP ? P.p_p + (size_t)m * PLE : P.p_s + (size_t)(m - NP) * PLE;
        const f32x4 pv = ((const GAS f32x4*)prow)[lane];
        v2u w; w.x = cvt_pk_bf16(pv.x, pv.y); w.y = cvt_pk_bf16(pv.z, pv.w);
        ((GAS v2u*)(PB + (size_t)m * PLE))[lane] = w;
    }
}

using pg8::rsrc_t; using pg8::mkrsrc;
__device__ __forceinline__ unsigned bld4(rsrc_t r, unsigned voff, unsigned soff) { return __builtin_amdgcn_raw_buffer_load_b32(r, (int)voff, (int)soff, 0); }
__device__ __forceinline__ void bst4(rsrc_t r, unsigned voff, unsigned soff, unsigned v) { __builtin_amdgcn_raw_buffer_store_b32(v, r, (int)voff, (int)soff, 0); }
__device__ __forceinline__ f32x2 bld8f(rsrc_t r, unsigned voff, unsigned soff) { return __builtin_bit_cast(f32x2, __builtin_amdgcn_raw_buffer_load_b64(r, (int)voff, (int)soff, 0)); }
__device__ __forceinline__ void bst8f(rsrc_t r, unsigned voff, unsigned soff, f32x2 v) { __builtin_amdgcn_raw_buffer_store_b64(__builtin_bit_cast(v2u, v), r, (int)voff, (int)soff, 0); }
__device__ __forceinline__ f32x2 up2(unsigned u) { return (f32x2){bf_lo(u), bf_hi(u)}; }
template <bool SAMPLE>
__device__ __forceinline__ void p2_tile(const Ptrs& P, LAS unsigned char* lds, int tile, int tid, int lane, int wave) {
    const rsrc_t rQZ = mkrsrc(P.ws + WS_QZ), rS = mkrsrc(P.ws + WS_S), rV = mkrsrc(P.ws + WS_V), rWb = mkrsrc(P.w_conv_b), rOut = mkrsrc(P.out);
    const unsigned v4 = (unsigned)tid * 4u, v8 = (unsigned)tid * 8u;
    LAS f32x2* cl2 = (LAS f32x2*)lds;
    const f32x2 wA0 = *(const f32x2*)(P.w_conv_a + 2 * tid), wA1 = *(const f32x2*)(P.w_conv_a + 1024 + 2 * tid), wA2 = *(const f32x2*)(P.w_conv_a + 2048 + 2 * tid);
    const f32x2 bias = *(const f32x2*)(P.b_conv_b + 2 * tid);
    unsigned R0;
    if constexpr (!SAMPLE) {
        const unsigned b = tile >> 6, t0 = (tile & 63) * 32; R0 = b * SEQ + t0;
        const bool lastt = (t0 == SEQ - 32), first = (t0 == 0);
        {
            f32x2 sw[34];
#pragma unroll
            for (int i = 0; i < 34; ++i) { const bool neg = first && i < 2; unsigned u = bld4(rS, v4, neg ? 0u : (R0 - 2 + i) * 2048u); u = neg ? 0u : u; sw[i] = up2(u); }
#pragma unroll
            for (int i = 0; i < 32; ++i) { const f32x2 q = up2(bld4(rQZ, v4, (R0 + i) * 4096u));
                const f32x2 cv = wA0 * sw[i] + wA1 * sw[i + 1] + wA2 * sw[i + 2]; const f32x2 ya = q * cv; bst4(rQZ, v4, (R0 + i) * 4096u, cvt_pk_bf16(ya.x, ya.y)); }
            if (lastt) {
#pragma unroll
                for (int j = 0; j < 2; ++j) bst8f(rOut, v8, (unsigned)(OFF_NAP + (size_t)(b * 2 + j) * 1024) * 4u, sw[32 + j]); }
        }
        {
            f32x2 win[62];
#pragma unroll
            for (int i = 0; i < 62; ++i) { const bool neg = first && i < 30; unsigned u = bld4(rV, v4, neg ? 0u : (R0 - 30 + i) * 2048u); u = neg ? 0u : u; win[i] = up2(u); }
#pragma unroll
            for (int hh = 0; hh < 2; ++hh) {
                f32x2 c[16];
#pragma unroll
                for (int i = 0; i < 16; ++i) c[i] = bias;
#pragma unroll
                for (int k = 0; k < 31; ++k) { const f32x2 w = bld8f(rWb, v8, k * 4096u);
#pragma unroll
                    for (int i = 0; i < 16; ++i) c[i] += w * win[hh * 16 + i + k]; }
#pragma unroll
                for (int i = 0; i < 16; ++i) cl2[(hh * 16 + i) * 512 + tid] = c[i];
            }
            if (lastt) {
#pragma unroll
                for (int j = 0; j < 30; ++j) bst8f(rOut, v8, (unsigned)(OFF_NBP + (size_t)(b * 30 + j) * 1024) * 4u, win[32 + j]); }
        }
    } else {
        R0 = NP + tile * 32;
        const rsrc_t rSa = mkrsrc(P.st_a), rSb = mkrsrc(P.st_b);
#pragma unroll 1
        for (int e = 0; e < 4; ++e) {
            const unsigned n = tile * 4 + e, r0 = NP + n * DSEQ;
            {
                f32x2 sw[10];
#pragma unroll
                for (int i = 0; i < 2; ++i) sw[i] = bld8f(rSa, v8, (n * 2 + i) * 4096u);
#pragma unroll
                for (int i = 0; i < 8; ++i) sw[2 + i] = up2(bld4(rS, v4, (r0 + i) * 2048u));
#pragma unroll
                for (int i = 0; i < 8; ++i) { const f32x2 q = up2(bld4(rQZ, v4, (r0 + i) * 4096u));
                    const f32x2 cv = wA0 * sw[i] + wA1 * sw[i + 1] + wA2 * sw[i + 2]; const f32x2 ya = q * cv; bst4(rQZ, v4, (r0 + i) * 4096u, cvt_pk_bf16(ya.x, ya.y)); }
#pragma unroll
                for (int j = 0; j < 2; ++j) bst8f(rOut, v8, (unsigned)(OFF_NAS + (size_t)(n * 2 + j) * 1024) * 4u, sw[8 + j]);
            }
            {
                f32x2 win[38];
#pragma unroll
                for (int i = 0; i < 30; ++i) win[i] = bld8f(rSb, v8, (n * 30 + i) * 4096u);
#pragma unroll
                for (int i = 0; i < 8; ++i) win[30 + i] = up2(bld4(rV, v4, (r0 + i) * 2048u));
                f32x2 c[8];
#pragma unroll
                for (int i = 0; i < 8; ++i) c[i] = bias;
#pragma unroll
                for (int k = 0; k < 31; ++k) { const f32x2 w = bld8f(rWb, v8, k * 4096u);
#pragma unroll
                    for (int i = 0; i < 8; ++i) c[i] += w * win[i + k]; }
#pragma unroll
                for (int i = 0; i < 8; ++i) cl2[(e * 8 + i) * 512 + tid] = c[i];
#pragma unroll
                for (int j = 0; j < 30; ++j) bst8f(rOut, v8, (unsigned)(OFF_NBS + (size_t)(n * 30 + j) * 1024) * 4u, win[8 + j]);
            }
        }
    }
    __syncthreads();
    {
        f32x4 lg[4], lb[4];
#pragma unroll
        for (int j = 0; j < 4; ++j) { lg[j] = *(const f32x4*)(P.ln_g + j * 256 + lane * 4); lb[j] = *(const f32x4*)(P.ln_b + j * 256 + lane * 4); }
        const LAS f32x4* cl4 = (const LAS f32x4*)lds;
        const unsigned vz = (unsigned)lane * 8u;
#pragma unroll 1
        for (int ii = 0; ii < 4; ++ii) { const int i = wave * 4 + ii;
            f32x4 x[4]; float s = 0.f;
#pragma unroll
            for (int j = 0; j < 4; ++j) { x[j] = cl4[i * 256 + j * 64 + lane]; s += (x[j].x + x[j].y) + (x[j].z + x[j].w); }
            const float mean = wave_sum(s) * (1.0f / 1024.0f); float q = 0.f;
#pragma unroll
            for (int j = 0; j < 4; ++j) { x[j] = x[j] - mean; q += (x[j].x * x[j].x + x[j].y * x[j].y) + (x[j].z * x[j].z + x[j].w * x[j].w); }
            const float rstd = 1.0f / sqrtf(wave_sum(q) * (1.0f / 1024.0f) + LN_EPS);
            const unsigned so = (R0 + i) * 4096u + 2048u;
#pragma unroll
            for (int j = 0; j < 4; ++j) { const v2u z = __builtin_amdgcn_raw_buffer_load_b64(rQZ, (int)vz, (int)(so + j * 512), 0); const f32x4 y = x[j] * rstd * lg[j] + lb[j];
                f32x4 o; o.x = y.x * sigmoidf_(y.x) * bf_lo(z.x); o.y = y.y * sigmoidf_(y.y) * bf_hi(z.x); o.z = y.z * sigmoidf_(y.z) * bf_lo(z.y); o.w = y.w * sigmoidf_(y.w) * bf_hi(z.y);
                v2u w; w.x = cvt_pk_bf16(o.x, o.y); w.y = cvt_pk_bf16(o.z, o.w); __builtin_amdgcn_raw_buffer_store_b64(w, rQZ, (int)vz, (int)(so + j * 512), 0); }
        }
    }
    __syncthreads();
}

struct Args { Ptrs p; int ph_lo, ph_hi; };
constexpr int NPHASE = 7;

__global__ void __launch_bounds__(NWAVES * 64, 2) fwd_megakernel(Args args) {
    extern __shared__ __attribute__((aligned(16))) unsigned char lds_raw[];
    LAS unsigned char* lds = (LAS unsigned char*)lds_raw;
    typedef const __attribute__((address_space(4))) Ptrs* KPtrs;
    const KPtrs Pk = (KPtrs)__builtin_amdgcn_kernarg_segment_ptr();
#define PHASE_PTRS() KPtrs Pq_ = Pk; asm volatile("" : "+s"(Pq_)); const Ptrs P = load_ptrs(Pq_); int tid = threadIdx.x; asm volatile("" : "+v"(tid)); const int lane = tid & 63; (void)lane
    const int tid0 = threadIdx.x, wave = __builtin_amdgcn_readfirstlane(tid0 >> 6);
    const int G = gridDim.x, bx = blockIdx.x;
    const int gw = bx * NWAVES + wave, NGW = G * NWAVES;
    volatile LAS unsigned* MISC = (volatile LAS unsigned*)(lds + MISC_OFF);
    for (int u = tid0; u < (LDS_BYTES - LDSCTL_OFF) / 4; u += NWAVES * 64) ((LAS unsigned*)(lds + LDSCTL_OFF))[u] = 0u;
    __syncthreads();
    unsigned* ctl;
    { PHASE_PTRS(); ctl = (unsigned*)(P.ws + WS_CTL); }
    XcdBarrier bar; bar.bar = ctl + CW_BAR; bar.x = 0; bar.st = nullptr;
#if !MK_PER_PHASE
    bar = xcd_barrier_post(ctl + CW_BAR, MISC + 8);
#endif
    const int lo = args.ph_lo, hi = args.ph_hi;
#ifdef PH_MASK
#define IN(k) ((((PH_MASK) >> (k)) & 1) && lo <= (k) && (k) < hi)
#else
#define IN(k) (lo <= (k) && (k) < hi)
#endif
#define SEAM(k) do { if (IN(k) && IN((k) + 1)) xcd_barrier(bar); } while (0)
#define WSP(off) ((pg8::bf16_t*)(P.ws + (off)))

    if (IN(0)) { PHASE_PTRS(); p0_prologue(P, lds, gw, NGW, lane, wave); }
    SEAM(0);
    if (IN(1)) { PHASE_PTRS();
        pg8::Gemm g{WSP(WS_XB), WSP(WS_WIN), T, DIN, DM}; pg8::StaticOrder S; S.init(T, DIN, G, bx);
#if defined(DBG_DUMP) && DBG_DUMP == 22
        pg8::EpiPlain E{WSP(WS_QZ), 2048};
        pg8::gemm_phase<pg8::EpiPlain, pg8::StaticOrder, PG8_ALIGN, PG8_SP2>(lds, g, S, E);
#else
        pg8::EpiInProj E{WSP(WS_QZ), WSP(WS_S), WSP(WS_V), (pg8::bf16_t*)P.out, (pg8::bf16_t*)P.out + (size_t)T * DM};
        pg8::gemm_phase<pg8::EpiInProj, pg8::StaticOrder, PG8_ALIGN, PG8_SP2>(lds, g, S, E);
#endif
    }
    SEAM(1);
    if (IN(2)) { PHASE_PTRS();
        for (int tile = bx; tile < 544; tile += G) { if (tile < 512) p2_tile<false>(P, lds, tile, tid, lane, wave); else p2_tile<true>(P, lds, tile - 512, tid, lane, wave); }
    }
    SEAM(2);
    if (IN(3)) { PHASE_PTRS();
        pg8::Gemm g{WSP(WS_QZ), WSP(WS_WAB), T, DM, 2 * DM}; pg8::StaticOrder S; S.init(T, DM, G, bx);
        pg8::EpiOutGate E{(const pg8::bf16_t*)P.out, (const pg8::bf16_t*)P.out + (size_t)T * DM, WSP(WS_S)};
        pg8::gemm_phase<pg8::EpiOutGate, pg8::StaticOrder, PG8_ALIGN, PG8_SP2>(lds, g, S, E);
    }
    SEAM(3);
    if (IN(4)) {
        { PHASE_PTRS(); pg8::Gemm g{WSP(WS_S), WSP(WS_WO), T, DM, DM}; pg8::StaticOrder S; S.init(T, DM, G, bx);
          pg8::EpiWo E{P.x_p, P.x_s, P.out, WSP(WS_V), (float*)(P.ws + WS_SSQ)};
          pg8::gemm_phase<pg8::EpiWo, pg8::StaticOrder, PG8_ALIGN, PG8_SP2>(lds, g, S, E); }
        { PHASE_PTRS(); pg8::Gemm g{WSP(WS_PB), WSP(WS_WPE), T, DM, PLE}; pg8::StaticOrder S; S.init(T, DM, G, bx);
          pg8::EpiPlain E{WSP(WS_XB), DM};
          pg8::gemm_phase<pg8::EpiPlain, pg8::StaticOrder, PG8_ALIGN, PG8_SP2>(lds, g, S, E); }
    }
    SEAM(4);
    if (IN(5)) { PHASE_PTRS();
        pg8::Gemm g{WSP(WS_V), WSP(WS_WPG), T, DM, DM}; pg8::StaticOrder S; S.init(T, DM, G, bx);
        pg8::EpiPg E{P.out, WSP(WS_XB), (const float*)(P.ws + WS_SSQ), (float*)(P.ws + WS_SSQ2)};
        pg8::gemm_phase<pg8::EpiPg, pg8::StaticOrder, PG8_ALIGN, PG8_SP2>(lds, g, S, E);
    }
    SEAM(5);
#ifdef DBG_DUMP
    if (lo == 6) { PHASE_PTRS();
        const unsigned* QZu = (const unsigned*)(P.ws + WS_QZ); const unsigned* Su = (const unsigned*)(P.ws + WS_S); const unsigned* Vu = (const unsigned*)(P.ws + WS_V);
        float* H = P.out;
        if (DBG_DUMP == 0) { for (int m = gw; m < T; m += NGW) { const float* xr = m < NP ? P.x_p + (size_t)m * DM : P.x_s + (size_t)(m - NP) * DM; for (int j = 0; j < 16; ++j) H[(size_t)m * DM + j * 64 + lane] = xr[j * 64 + lane]; } }
        else if (DBG_DUMP == 1) { const unsigned short* XBs = (const unsigned short*)(P.ws + WS_XB); const unsigned short* Ws = (const unsigned short*)(P.ws + WS_WIN); const unsigned short* PBs = (const unsigned short*)(P.ws + WS_PB);
            const unsigned short* W2 = (const unsigned short*)(P.ws + WS_WAB);
            for (int m = gw; m < T; m += NGW) { for (int j = 0; j < 16; ++j) { const int c = j * 64 + lane; H[(size_t)m * DM + c] = bf_lo(XBs[(size_t)m * DM + c]) + bf_lo(Ws[(size_t)(m % DIN) * DM + c]) + bf_lo(PBs[(size_t)m * PLE + (c & 255)]) + bf_lo(W2[(size_t)(m % 5376) * DM + c]); } } }
        else
        for (int m = gw; m < T; m += NGW) {
            float acc8[16];
#pragma unroll
            for (int j = 0; j < 8; ++j) { const int c2 = j * 64 + lane;
                const unsigned a = QZu[(size_t)m * 1024 + c2], b = QZu[(size_t)m * 1024 + 512 + c2], c = Su[(size_t)m * 512 + c2], d = Vu[(size_t)m * 512 + c2];
                acc8[2 * j] = bf_lo(a) + bf_lo(b) + (DBG_DUMP >= 3 ? bf_lo(c) : 0.f) + (DBG_DUMP >= 4 ? bf_lo(d) : 0.f); acc8[2 * j + 1] = bf_hi(a) + bf_hi(b) + (DBG_DUMP >= 3 ? bf_hi(c) : 0.f) + (DBG_DUMP >= 4 ? bf_hi(d) : 0.f); }
#pragma unroll
            for (int j = 0; j < 8; ++j) { H[(size_t)m * DM + 2 * (j * 64 + lane)] = acc8[2 * j]; H[(size_t)m * DM + 2 * (j * 64 + lane) + 1] = acc8[2 * j + 1]; }
        }
        if (DBG_DUMP < 3) for (size_t i = (size_t)T * DM + (size_t)bx * 512 + tid; i < (size_t)22282240; i += (size_t)G * 512) H[i] = 0.f;
    }
    if (false) { PHASE_PTRS();
        float* H = P.out;
#else
    if (IN(6)) { PHASE_PTRS();
        float* H = P.out;
#endif
        f32x4 gf[4];
#pragma unroll
        for (int j = 0; j < 4; ++j) gf[j] = *(const f32x4*)(P.g_final + j * 256 + lane * 4);
        for (int m = gw; m < T; m += NGW) {
            GAS f32x4* hr = (GAS f32x4*)(H + (size_t)m * DM) + lane;
            f32x4 v[4]; float s = 0.f;
#pragma unroll
            for (int j = 0; j < 4; ++j) { v[j] = hr[64 * j]; s += (v[j].x * v[j].x + v[j].y * v[j].y) + (v[j].z * v[j].z + v[j].w * v[j].w); }
            const float rstd = 1.0f / sqrtf(wave_sum(s) * (1.0f / DM) + EPS);
#pragma unroll
            for (int j = 0; j < 4; ++j) { f32x4 o = v[j] * rstd * gf[j];
#ifdef DBG_SANITIZE
                o.x = (o.x - o.x == 0.f) ? o.x : 0.f; o.y = (o.y - o.y == 0.f) ? o.y : 0.f; o.z = (o.z - o.z == 0.f) ? o.z : 0.f; o.w = (o.w - o.w == 0.f) ? o.w : 0.f;
#endif
                hr[64 * j] = o; }
        }
    }
#undef WSP
#undef IN
#undef SEAM
}

extern "C" void kernel_launch(void* const* d_in, const int* in_sizes, int n_in, void* d_out, int out_size, void* d_ws, size_t ws_size, hipStream_t stream) {
    static int grid = 0;
    if (grid == 0) {
        if (n_in != 20 || ws_size < WS_END) { fprintf(stderr, "kernel_launch: unexpected n_in %d / ws %zu\n", n_in, ws_size); grid = -1; return; }
        int dev = 0, cus = 0, per_cu = 0;
        if (hipGetDevice(&dev) != hipSuccess || hipDeviceGetAttribute(&cus, hipDeviceAttributeMultiprocessorCount, dev) != hipSuccess) { grid = -1; return; }
        if (hipFuncSetAttribute((const void*)fwd_megakernel, hipFuncAttributeMaxDynamicSharedMemorySize, LDS_BYTES) != hipSuccess) { fprintf(stderr, "kernel_launch: hipFuncSetAttribute failed\n"); grid = -1; return; }
        if (hipOccupancyMaxActiveBlocksPerMultiprocessor(&per_cu, (const void*)fwd_megakernel, NWAVES * 64, LDS_BYTES) != hipSuccess || per_cu < 1) { fprintf(stderr, "kernel_launch: occupancy query says %d\n", per_cu); (void)hipGetLastError(); per_cu = 1; }
        grid = cus;
    }
    if (grid < 0) return;
    (void)hipMemsetAsync((char*)d_ws + WS_CTL, 0, CTL_ZERO_BYTES, stream);
    Args a{};
    const float** pp = (const float**)&a.p;
    for (int i = 0; i < 20; ++i) pp[i] = (const float*)d_in[i];
    a.p.out = (float*)d_out; a.p.ws = (unsigned char*)d_ws;
#if MK_PER_PHASE
#ifdef DBG_DUMP
    for (int ph = 0; ph < NPHASE; ++ph) { if (ph >= (DBG_DUMP > 4 ? DBG_DUMP - 2 : (DBG_DUMP >= 3 ? 3 : DBG_DUMP)) && ph != 6) continue; a.ph_lo = ph; a.ph_hi = ph + 1; hipLaunchKernelGGL(fwd_megakernel, dim3(grid), dim3(NWAVES * 64), LDS_BYTES, stream, a); }
#else
    for (int ph = 0; ph < NPHASE; ++ph) { a.ph_lo = ph; a.ph_hi = ph + 1; hipLaunchKernelGGL(fwd_megakernel, dim3(grid), dim3(NWAVES * 64), LDS_BYTES, stream, a); }
#endif
#else
    a.ph_lo = 0; a.ph_hi = NPHASE;
    void* kargs[] = {&a};
    hipError_t e = hipLaunchCooperativeKernel((const void*)fwd_megakernel, dim3(grid), dim3(NWAVES * 64), kargs, LDS_BYTES, stream);
    if (e != hipSuccess) fprintf(stderr, "kernel_launch: cooperative launch failed: %s (grid %d)\n", hipGetErrorString(e), grid);
#endif
}
```

```cpp
#include <hip/hip_runtime.h>
#include <cstdio>
#include <cstdint>

#ifndef MK_PER_PHASE
#define MK_PER_PHASE 0
#endif

namespace pg8 {
#define PG8_LAS __attribute__((address_space(3)))
typedef unsigned short bf16_t;
typedef short bf16x8 __attribute__((ext_vector_type(8)));
typedef float f32x4 __attribute__((ext_vector_type(4)));
typedef unsigned u32x4 __attribute__((ext_vector_type(4)));
typedef unsigned u32x2 __attribute__((ext_vector_type(2)));
constexpr int BM = 256, BK = 64, HALF = 128, HTB = HALF * BK * 2, STAGE_BYTES = 8 * HTB, NXCD = 8, WGM = 8;

__host__ __device__ __forceinline__ int lds_byte(int r, int c) { const int st = (r >> 4) * 2 + (c >> 5), rr = r & 15, cc = c & 31, ob = rr * 64 + cc * 2; return st * 1024 + (ob ^ (((ob >> 9) & 1) << 5)); }
__host__ __device__ __forceinline__ void stage_rc(int b, int& R, int& C) { const int st = b / 1024, sb = b % 1024, swz = sb ^ (((sb >> 9) & 1) << 5); R = (st >> 1) * 16 + swz / 64; C = (st & 1) * 32 + (swz % 64) / 2; }
__host__ __device__ __forceinline__ int perm32(int rho) { const int n = rho >> 4, i = rho & 15; return 8 * (i >> 2) + 4 * n + (i & 3); }

struct Unit { int pm, pn; };
struct Gemm { const bf16_t* A; const bf16_t* Bt; int M, N, K; };

struct StaticOrder {
    int nM, nN, nwg, G, c;
    __host__ __device__ void init(int M, int N, int G_, int c_) { nM = M / BM; nN = N / BM; nwg = nM * nN; G = G_; c = c_; }
    __host__ __device__ bool next(int i, Unit& u) const {
        const long L = (long)i * G + c; if (L >= nwg) return false;
        int wgid = (int)L; { const int q = nwg / NXCD, r = nwg % NXCD, xcd = wgid % NXCD, off = wgid / NXCD; wgid = (xcd < r ? xcd * (q + 1) : r * (q + 1) + (xcd - r) * q) + off; }
        const int nig = WGM * nN, gid = wgid / nig, fm = gid * WGM, gsz = (nM - fm) < WGM ? (nM - fm) : WGM;
        u.pm = fm + ((wgid % nig) % gsz); u.pn = (wgid % nig) / gsz; return true;
    }
    __device__ __forceinline__ void a_ready(const Unit&) const {}
    __device__ __forceinline__ void done(const Unit&) const {}
};

__device__ __forceinline__ unsigned cvt_pk_bf16(float lo, float hi) { unsigned r; asm volatile("v_cvt_pk_bf16_f32 %0, %1, %2" : "=v"(r) : "v"(lo), "v"(hi)); return r; }
__device__ __forceinline__ float bf_lo(unsigned u) { return __uint_as_float(u << 16); }
__device__ __forceinline__ float bf_hi(unsigned u) { return __uint_as_float(u & 0xffff0000u); }
__device__ __forceinline__ float sigmoidf_(float x) { return __builtin_amdgcn_rcpf(1.0f + __expf(-x)); }
__device__ __forceinline__ u32x4 pack8(const f32x4 a, const f32x4 b) { u32x4 w; w.x = cvt_pk_bf16(a[0], a[1]); w.y = cvt_pk_bf16(a[2], a[3]); w.z = cvt_pk_bf16(b[0], b[1]); w.w = cvt_pk_bf16(b[2], b[3]); return w; }
__device__ __forceinline__ void unpack8(const u32x4 w, f32x4& a, f32x4& b) { a[0] = bf_lo(w.x); a[1] = bf_hi(w.x); a[2] = bf_lo(w.y); a[3] = bf_hi(w.y); b[0] = bf_lo(w.z); b[1] = bf_hi(w.z); b[2] = bf_lo(w.w); b[3] = bf_hi(w.w); }


typedef __amdgpu_buffer_rsrc_t rsrc_t;
__device__ __forceinline__ rsrc_t mkrsrc(const void* p) { return __builtin_amdgcn_make_buffer_rsrc(const_cast<void*>(p), 0, 0x7fffffff, 0x00020000); }
__device__ __forceinline__ u32x4 bld16(rsrc_t r, unsigned voff, unsigned soff) { return __builtin_amdgcn_raw_buffer_load_b128(r, (int)voff, (int)soff, 0); }
__device__ __forceinline__ void bst16(rsrc_t r, unsigned voff, unsigned soff, u32x4 v) { unsigned vo = voff + soff; asm volatile("" : "+v"(vo)); __builtin_amdgcn_raw_buffer_store_b128(v, r, (int)vo, 0, 0); }
__device__ __forceinline__ f32x4 as_f(u32x4 v) { return __builtin_bit_cast(f32x4, v); }
__device__ __forceinline__ u32x4 as_u(f32x4 v) { return __builtin_bit_cast(u32x4, v); }

struct EpiInProj {
    static constexpr bool PERM = true, AFTER_DRAIN = false, MID = false;
    bf16_t *QZ, *S, *V, *GA, *GB;
    __device__ __forceinline__ void mid(f32x4 (&)[2][2][4][2], const Unit&, int, int, int, int) const {}
    template <int TYPE> __device__ __forceinline__ void pair(const f32x4 (&acc)[2][2][4][2], rsrc_t r, unsigned sbase, unsigned voff, unsigned ldb) const {
#pragma unroll
        for (int ai = 0; ai < 2; ++ai)
#pragma unroll
            for (int m = 0; m < 4; ++m) {
                f32x4 o[2];
#pragma unroll
                for (int bj = 0; bj < 2; ++bj) { const f32x4 X = acc[ai][bj][m][0], Y = acc[ai][bj][m][1];
#pragma unroll
                    for (int j = 0; j < 4; ++j) { if (TYPE == 1) o[bj][j] = X[j] * Y[j]; else { const float sg = sigmoidf_(Y[j]); o[bj][j] = TYPE == 0 ? X[j] * Y[j] * sg : X[j] * sg; } } }
                bst16(r, voff, sbase + (unsigned)(ai * HALF + m * 16) * ldb, pack8(o[0], o[1]));
            }
    }
    template <int TYPE> __device__ __forceinline__ void single(const f32x4 (&acc)[2][2][4][2], rsrc_t r, unsigned sbase, unsigned voff, unsigned ldb) const {
#pragma unroll
        for (int ai = 0; ai < 2; ++ai)
#pragma unroll
            for (int m = 0; m < 4; ++m)
#pragma unroll
                for (int bj = 0; bj < 2; ++bj) { f32x4 v0 = acc[ai][bj][m][0], v1 = acc[ai][bj][m][1];
#pragma unroll
                    for (int j = 0; j < 4; ++j) { const float s0 = sigmoidf_(v0[j]), s1 = sigmoidf_(v1[j]); v0[j] = TYPE == 0 ? v0[j] * s0 : s0; v1[j] = TYPE == 0 ? v1[j] * s1 : s1; }
                    bst16(r, voff, sbase + (unsigned)(ai * HALF + m * 16) * ldb + bj * (HALF * 2), pack8(v0, v1)); }
    }
    __device__ __forceinline__ void operator()(const f32x4 (&acc)[2][2][4][2], const Unit& u, int wr, int wc, int fr, int fq) const {
        const unsigned urow = u.pm * BM + wr * 64, pn = u.pn;
        if (pn < 24) {
            const unsigned type = pn >> 3, ucb = (pn & 7) * 128 + 32 * wc;
            if (type == 0) pair<0>(acc, mkrsrc(QZ), (urow * 2048 + ucb) * 2, (unsigned)(fr * 2048 + 8 * fq) * 2u, 4096);
#if !defined(DBG_ONLYQZ)
            else if (type == 1) pair<1>(acc, mkrsrc(S), (urow * 1024 + ucb) * 2, (unsigned)(fr * 1024 + 8 * fq) * 2u, 2048);
            else pair<2>(acc, mkrsrc(V), (urow * 1024 + ucb) * 2, (unsigned)(fr * 1024 + 8 * fq) * 2u, 2048);
#endif
        } else {
            const unsigned t = (pn - 24) >> 2, ucb = ((pn - 24) & 3) * 256 + wc * 32;
            if (t == 0) single<0>(acc, mkrsrc(QZ), (urow * 2048 + 1024 + ucb) * 2, (unsigned)(fr * 2048 + 8 * fq) * 2u, 4096);
#if !defined(DBG_ONLYQZ)
            else if (t == 1) single<1>(acc, mkrsrc(GA), (urow * 1024 + ucb) * 2, (unsigned)(fr * 1024 + 8 * fq) * 2u, 2048);
            else single<1>(acc, mkrsrc(GB), (urow * 1024 + ucb) * 2, (unsigned)(fr * 1024 + 8 * fq) * 2u, 2048);
#endif
        }
    }
};
struct EpiPlain {
    static constexpr bool PERM = true, AFTER_DRAIN = false, MID = false;
    bf16_t* O; int ldc;
    __device__ __forceinline__ void mid(f32x4 (&)[2][2][4][2], const Unit&, int, int, int, int) const {}
    __device__ __forceinline__ void operator()(const f32x4 (&acc)[2][2][4][2], const Unit& u, int wr, int wc, int fr, int fq) const {
#if defined(DBG_DUMP) && DBG_DUMP == 2
        if (u.pn >= 8) return;
#endif
        const rsrc_t r = mkrsrc(O); const unsigned sb = ((unsigned)(u.pm * BM + wr * 64) * ldc + u.pn * BM + wc * 32) * 2, voff = (unsigned)(fr * ldc + 8 * fq) * 2u;
#pragma unroll
        for (int ai = 0; ai < 2; ++ai)
#pragma unroll
            for (int m = 0; m < 4; ++m)
#pragma unroll
                for (int bj = 0; bj < 2; ++bj) bst16(r, voff, sb + (unsigned)(ai * HALF + m * 16) * ldc * 2 + bj * (HALF * 2), pack8(acc[ai][bj][m][0], acc[ai][bj][m][1]));
    }
};
struct EpiOutGate {
    static constexpr bool PERM = true, AFTER_DRAIN = false, MID = true;
    const bf16_t *GA, *GB; bf16_t* Mo;
    __device__ __forceinline__ void mid(f32x4 (&acc)[2][2][4][2], const Unit& u, int wr, int wc, int fr, int fq) const {
        const rsrc_t ra = mkrsrc(GA), rb = mkrsrc(GB);
        const unsigned sb = ((unsigned)(u.pm * BM + wr * 64) * 1024 + u.pn * BM + wc * 32) * 2, voff = (unsigned)(fr * 1024 + 8 * fq) * 2u;
#pragma unroll
        for (int ai = 0; ai < 2; ++ai)
#pragma unroll
            for (int m = 0; m < 4; ++m) {
#pragma unroll
                for (int bj = 0; bj < 2; ++bj) { const unsigned so = sb + (unsigned)(ai * HALF + m * 16) * 2048 + bj * 256;
                    const u32x4 ga = bld16(ra, voff, so), gb = bld16(rb, voff, so); f32x4 a0, a1, b0, b1; unpack8(ga, a0, a1); unpack8(gb, b0, b1);
#pragma unroll
                    for (int j = 0; j < 4; ++j) { acc[ai][bj][m][0][j] *= a0[j] * __builtin_amdgcn_rcpf(fmaxf(b0[j], 1e-30f)); acc[ai][bj][m][1][j] *= a1[j] * __builtin_amdgcn_rcpf(fmaxf(b1[j], 1e-30f)); } }
                asm volatile("" ::: "memory"); }
    }
    __device__ __forceinline__ void operator()(const f32x4 (&acc)[2][2][4][2], const Unit& u, int wr, int wc, int fr, int fq) const {
        const rsrc_t rb = mkrsrc(GB), ro = mkrsrc(Mo);
        const unsigned sb = ((unsigned)(u.pm * BM + wr * 64) * 1024 + u.pn * BM + wc * 32) * 2, voff = (unsigned)(fr * 1024 + 8 * fq) * 2u;
#pragma unroll
        for (int ai = 0; ai < 2; ++ai)
#pragma unroll
            for (int m = 0; m < 4; ++m) {
#pragma unroll
                for (int bj = 0; bj < 2; ++bj) { const unsigned so = sb + (unsigned)(ai * HALF + m * 16) * 2048 + bj * 256;
                    const u32x4 gb = bld16(rb, voff, so); f32x4 b0, b1; unpack8(gb, b0, b1);
                    bst16(ro, voff, so, pack8(acc[ai][bj][m][0] * b0, acc[ai][bj][m][1] * b1)); }
                asm volatile("" ::: "memory"); }
    }
};
struct EpiWo {
    static constexpr bool PERM = true, AFTER_DRAIN = false, MID = false;
    const float *xp, *xs; float* H; bf16_t* HB; float* ssq;
    __device__ __forceinline__ void mid(f32x4 (&)[2][2][4][2], const Unit&, int, int, int, int) const {}
    __device__ __forceinline__ void operator()(const f32x4 (&acc)[2][2][4][2], const Unit& u, int wr, int wc, int fr, int fq) const {
        const unsigned urow = u.pm * BM + wr * 64, ucol = u.pn * BM + wc * 32;
        const bool smp = u.pm >= 64;
        const rsrc_t rx = mkrsrc(smp ? xs : xp), rh = mkrsrc(H), rb = mkrsrc(HB);
        const unsigned ue = urow * 1024 + ucol, uex = (smp ? urow - 16384u : urow) * 1024 + ucol, ve = (unsigned)(fr * 1024 + 8 * fq);
        float* sq = ssq + urow + fr;
#pragma unroll
        for (int ai = 0; ai < 2; ++ai)
#pragma unroll
            for (int m = 0; m < 4; ++m) { const unsigned ro = (unsigned)(ai * HALF + m * 16) * 1024; float ss = 0.f;
#pragma unroll
                for (int bj = 0; bj < 2; ++bj) {
                    const f32x4 h0 = as_f(bld16(rx, ve * 4u, (uex + ro) * 4u + bj * 512)) + acc[ai][bj][m][0], h1 = as_f(bld16(rx, ve * 4u, (uex + ro) * 4u + bj * 512 + 16)) + acc[ai][bj][m][1];
                    bst16(rh, ve * 4u, (ue + ro) * 4u + bj * 512, as_u(h0)); bst16(rh, ve * 4u, (ue + ro) * 4u + bj * 512 + 16, as_u(h1)); bst16(rb, ve * 2u, (ue + ro) * 2u + bj * 256, pack8(h0, h1));
                    ss += (h0[0] * h0[0] + h0[1] * h0[1]) + (h0[2] * h0[2] + h0[3] * h0[3]) + (h1[0] * h1[0] + h1[1] * h1[1]) + (h1[2] * h1[2] + h1[3] * h1[3]);
                    asm volatile("" ::: "memory"); }
                ss += __shfl_xor(ss, 16); ss += __shfl_xor(ss, 32);
                if (fq == 0) atomicAdd(sq + ai * HALF + m * 16, ss);
                asm volatile("" ::: "memory"); }
    }
};
struct EpiPg {
    static constexpr bool PERM = true, AFTER_DRAIN = false, MID = false;
    float* H; const bf16_t* PE; const float* ssq; float* ssq2;
    __device__ __forceinline__ void mid(f32x4 (&)[2][2][4][2], const Unit&, int, int, int, int) const {}
    __device__ __forceinline__ void operator()(const f32x4 (&acc)[2][2][4][2], const Unit& u, int wr, int wc, int fr, int fq) const {
        const unsigned urow = u.pm * BM + wr * 64, ucol = u.pn * BM + wc * 32;
        const rsrc_t rh = mkrsrc(H), rp = mkrsrc(PE);
        const unsigned ue = urow * 1024 + ucol, ve = (unsigned)(fr * 1024 + 8 * fq);
        const float* sq = ssq + urow + fr; float* sq2 = ssq2 + urow + fr;
#pragma unroll
        for (int ai = 0; ai < 2; ++ai)
#pragma unroll
            for (int m = 0; m < 4; ++m) { const unsigned ro = (unsigned)(ai * HALF + m * 16) * 1024; float ss = 0.f;
                const float rstd = 1.0f / sqrtf(sq[ai * HALF + m * 16] * (1.0f / 1024.0f) + 1e-6f);
#pragma unroll
                for (int bj = 0; bj < 2; ++bj) {
                    f32x4 h0 = as_f(bld16(rh, ve * 4u, (ue + ro) * 4u + bj * 512)), h1 = as_f(bld16(rh, ve * 4u, (ue + ro) * 4u + bj * 512 + 16)); const u32x4 pe = bld16(rp, ve * 2u, (ue + ro) * 2u + bj * 256); f32x4 p0, p1; unpack8(pe, p0, p1);
#pragma unroll
                    for (int j = 0; j < 4; ++j) { h0[j] += sigmoidf_(acc[ai][bj][m][0][j] * rstd) * p0[j]; h1[j] += sigmoidf_(acc[ai][bj][m][1][j] * rstd) * p1[j]; }
                    bst16(rh, ve * 4u, (ue + ro) * 4u + bj * 512, as_u(h0)); bst16(rh, ve * 4u, (ue + ro) * 4u + bj * 512 + 16, as_u(h1));
                    ss += (h0[0] * h0[0] + h0[1] * h0[1]) + (h0[2] * h0[2] + h0[3] * h0[3]) + (h1[0] * h1[0] + h1[1] * h1[1]) + (h1[2] * h1[2] + h1[3] * h1[3]); }
                ss += __shfl_xor(ss, 16); ss += __shfl_xor(ss, 32);
                if (fq == 0) atomicAdd(sq2 + ai * HALF + m * 16, ss);
                asm volatile("" ::: "memory"); }
    }
};

template <class Epi, class Sched, bool ALIGN_EPI = false, bool SP2 = false>
__device__ __forceinline__ void gemm_phase(PG8_LAS unsigned char* lds, const Gemm g, const Sched& S, const Epi& E) {
    const int tid = threadIdx.x, wid = __builtin_amdgcn_readfirstlane(tid >> 6), lane = tid & 63, wr = wid >> 2, wc = wid & 3, fr = lane & 15, fq = lane >> 4;
    const int K = g.K, nt = K / BK;
    unsigned voffA[2], voffB[2];
#pragma unroll
    for (int i = 0; i < 2; ++i) { int R, C; stage_rc(tid * 16 + i * 8192, R, C); const int Rb = Epi::PERM ? ((R & ~31) + perm32(R & 31)) : R;
        voffA[i] = (unsigned)(R * K + C) * 2u; voffB[i] = (unsigned)(Rb * K + C) * 2u; }
    const size_t kstep = (size_t)(BK * 2);
    const size_t hstep = (size_t)HALF * K * 2;
    const size_t tstep = 2 * hstep;
    const unsigned ldsw = (unsigned)wid * 1024u;
    const int aoff = lds_byte(wr * 64 + fr, fq * 8), boff = lds_byte(wc * 32 + fr, fq * 8);
#define PG8_SA(b, h) (((b) * 2 + (h)) * HTB)
#define PG8_SB(b, h) ((4 + (b) * 2 + (h)) * HTB)
#define PG8_STAGE(bufoff, gbase, voff) do { _Pragma("unroll") for (int _i = 0; _i < 2; ++_i) \
        __builtin_amdgcn_global_load_lds((const unsigned*)((const char*)(gbase) + (voff)[_i]), (PG8_LAS unsigned*)(lds + (bufoff) + ldsw + _i * 8192), 16, 0, 0); } while (0)
#define PG8_LDA(dst, b, h) do { _Pragma("unroll") for (int m = 0; m < 4; ++m) _Pragma("unroll") for (int k = 0; k < 2; ++k) dst[m][k] = *(const PG8_LAS bf16x8*)(lds + PG8_SA(b, h) + aoff + m * 2048 + k * 1024); } while (0)
#define PG8_LDB(dst, b, h) do { _Pragma("unroll") for (int n = 0; n < 2; ++n) _Pragma("unroll") for (int k = 0; k < 2; ++k) dst[n][k] = *(const PG8_LAS bf16x8*)(lds + PG8_SB(b, h) + boff + n * 2048 + k * 1024); } while (0)
#define PG8_MMA(ai, bj, At, Bt) do { __builtin_amdgcn_s_setprio(1); _Pragma("unroll") for (int m = 0; m < 4; ++m) _Pragma("unroll") for (int n = 0; n < 2; ++n) _Pragma("unroll") for (int k = 0; k < 2; ++k) \
        acc[ai][bj][m][n] = __builtin_amdgcn_mfma_f32_16x16x32_bf16(Bt[n][k], At[m][k], acc[ai][bj][m][n], 0, 0, 0); __builtin_amdgcn_s_setprio(0); } while (0)
#define PG8_WAIT_V(n) asm volatile("s_waitcnt vmcnt(" #n ")" ::: "memory")
#define PG8_WAIT_L(n) asm volatile("s_waitcnt lgkmcnt(" #n ")" ::: "memory")
#define PG8_BAR __builtin_amdgcn_s_barrier()
#define PG8_SCHED __builtin_amdgcn_sched_barrier(0)
    Unit cur, nxt; int ui = 0;
    if (!S.next(0, cur)) return;
    f32x4 acc[2][2][4][2];
#pragma unroll
    for (int a = 0; a < 2; ++a)
#pragma unroll
        for (int b = 0; b < 2; ++b)
#pragma unroll
            for (int m = 0; m < 4; ++m)
#pragma unroll
                for (int n = 0; n < 2; ++n) acc[a][b][m][n] = (f32x4){0.f, 0.f, 0.f, 0.f};
    bf16x8 At[4][2], B0[2][2], B1[2][2];
    const char* cA = (const char*)g.A + (size_t)cur.pm * tstep; const char* cB = (const char*)g.Bt + (size_t)cur.pn * tstep;
    S.a_ready(cur);
    if constexpr (SP2) {
        PG8_STAGE(PG8_SB(0, 0), cB, voffB); PG8_STAGE(PG8_SB(0, 1), cB + hstep, voffB); PG8_STAGE(PG8_SA(0, 0), cA, voffA); PG8_STAGE(PG8_SA(0, 1), cA + hstep, voffA);
        if (wr == 1) PG8_BAR;
        PG8_WAIT_V(2); PG8_BAR;
        PG8_STAGE(PG8_SB(1, 0), cB + kstep, voffB); PG8_STAGE(PG8_SA(1, 0), cA + kstep, voffA); PG8_STAGE(PG8_SB(1, 1), cB + hstep + kstep, voffB);
        PG8_WAIT_V(6); PG8_BAR;
    } else {
        PG8_STAGE(PG8_SB(0, 0), cB, voffB); PG8_STAGE(PG8_SA(0, 0), cA, voffA); PG8_STAGE(PG8_SB(0, 1), cB + hstep, voffB); PG8_STAGE(PG8_SA(0, 1), cA + hstep, voffA);
        if (wr == 1) PG8_BAR;
        PG8_WAIT_V(4); PG8_BAR;
        PG8_STAGE(PG8_SB(1, 0), cB + kstep, voffB); PG8_STAGE(PG8_SA(1, 0), cA + kstep, voffA); PG8_STAGE(PG8_SB(1, 1), cB + hstep + kstep, voffB);
        PG8_WAIT_V(6); PG8_BAR;
    }
    for (;;) {
        const bool has_next = S.next(ui + 1, nxt);
        const char* nA = has_next ? (const char*)g.A + (size_t)nxt.pm * tstep : cA; const char* nB = has_next ? (const char*)g.Bt + (size_t)nxt.pn * tstep : cB;
        for (int th = 0; th < (Epi::MID ? 2 : 1); ++th) {
        if constexpr (Epi::MID) { if (th == 1) E.mid(acc, cur, wr, wc, fr, fq); }
        const int t_lo = Epi::MID ? th * (nt >> 1) : 0, t_hi = Epi::MID ? (th + 1) * (nt >> 1) : nt;
#pragma unroll 1
        for (int t = t_lo; t < t_hi; t += 2) {
            const bool last = (t == nt - 2);
            const char* a1 = cA + (size_t)(t + 1) * kstep;
            const char* a2 = last ? nA : cA + (size_t)(t + 2) * kstep; const char* b2 = last ? nB : cB + (size_t)(t + 2) * kstep;
            const char* a3 = a2 + kstep; const char* b3 = b2 + kstep;
            if (last && has_next) S.a_ready(nxt);
            if constexpr (SP2) {
            PG8_LDB(B0, 0, 0); PG8_LDB(B1, 0, 1); PG8_SCHED; PG8_LDA(At, 0, 0); PG8_STAGE(PG8_SA(1, 1), a1 + hstep, voffA);
            PG8_WAIT_V(8); PG8_WAIT_L(0); PG8_BAR; PG8_MMA(0, 0, At, B0); PG8_MMA(0, 1, At, B1); PG8_BAR; PG8_SCHED;
            PG8_LDA(At, 0, 1); PG8_STAGE(PG8_SB(0, 0), b2, voffB); PG8_STAGE(PG8_SB(0, 1), b2 + hstep, voffB); PG8_STAGE(PG8_SA(0, 0), a2, voffA);
            PG8_WAIT_V(8); PG8_WAIT_L(0); PG8_BAR; PG8_MMA(1, 0, At, B0); PG8_MMA(1, 1, At, B1); PG8_BAR; PG8_SCHED;
            PG8_LDB(B0, 1, 0); PG8_LDB(B1, 1, 1); PG8_SCHED; PG8_LDA(At, 1, 0); PG8_STAGE(PG8_SA(0, 1), a2 + hstep, voffA);
            PG8_WAIT_V(8); PG8_WAIT_L(0); PG8_BAR; PG8_MMA(0, 0, At, B0); PG8_MMA(0, 1, At, B1); PG8_BAR; PG8_SCHED;
            PG8_LDA(At, 1, 1); PG8_STAGE(PG8_SB(1, 0), b3, voffB); PG8_STAGE(PG8_SB(1, 1), b3 + hstep, voffB); PG8_STAGE(PG8_SA(1, 0), a3, voffA);
            PG8_WAIT_V(8); PG8_WAIT_L(0); PG8_BAR; PG8_MMA(1, 0, At, B0); PG8_MMA(1, 1, At, B1); PG8_BAR; PG8_SCHED;
            } else {
            PG8_LDB(B0, 0, 0); PG8_SCHED; PG8_LDA(At, 0, 0); PG8_STAGE(PG8_SA(1, 1), a1 + hstep, voffA);
            PG8_WAIT_L(8); PG8_BAR; PG8_WAIT_L(0); PG8_MMA(0, 0, At, B0); PG8_BAR; PG8_SCHED;
            PG8_LDB(B1, 0, 1); PG8_STAGE(PG8_SB(0, 0), b2, voffB);
            PG8_BAR; PG8_WAIT_L(0); PG8_MMA(0, 1, At, B1); PG8_BAR;
            PG8_LDA(At, 0, 1); PG8_STAGE(PG8_SA(0, 0), a2, voffA);
            PG8_BAR; PG8_WAIT_L(0); PG8_MMA(1, 0, At, B0); PG8_BAR; PG8_SCHED;
            PG8_STAGE(PG8_SB(0, 1), b2 + hstep, voffB);
            PG8_WAIT_V(6); PG8_BAR; PG8_MMA(1, 1, At, B1); PG8_BAR;
            PG8_LDB(B0, 1, 0); PG8_SCHED; PG8_LDA(At, 1, 0); PG8_STAGE(PG8_SA(0, 1), a2 + hstep, voffA);
            PG8_WAIT_L(8); PG8_BAR; PG8_WAIT_L(0); PG8_MMA(0, 0, At, B0); PG8_BAR; PG8_SCHED;
            PG8_LDB(B1, 1, 1); PG8_STAGE(PG8_SB(1, 0), b3, voffB);
            PG8_BAR; PG8_WAIT_L(0); PG8_MMA(0, 1, At, B1); PG8_BAR;
            PG8_LDA(At, 1, 1); PG8_STAGE(PG8_SA(1, 0), a3, voffA);
            PG8_BAR; PG8_WAIT_L(0); PG8_MMA(1, 0, At, B0); PG8_BAR; PG8_SCHED;
            PG8_STAGE(PG8_SB(1, 1), b3 + hstep, voffB);
            PG8_WAIT_V(6); PG8_BAR; PG8_MMA(1, 1, At, B1); PG8_BAR;
            }
        }
        }
        if constexpr (ALIGN_EPI) { if (wr == 0) PG8_BAR; }
        if constexpr (!Epi::AFTER_DRAIN) { E(acc, cur, wr, wc, fr, fq); S.done(cur); }
        if (!has_next) break;
#pragma unroll
        for (int a = 0; a < 2; ++a)
#pragma unroll
            for (int b = 0; b < 2; ++b)
#pragma unroll
                for (int m = 0; m < 4; ++m)
#pragma unroll
                    for (int n = 0; n < 2; ++n) acc[a][b][m][n] = (f32x4){0.f, 0.f, 0.f, 0.f};
        cur = nxt; cA = nA; cB = nB; ++ui;
        if constexpr (ALIGN_EPI) { if (wr == 1) PG8_BAR; }
    }
    PG8_WAIT_V(0);
    if constexpr (!ALIGN_EPI) { if (wr == 0) PG8_BAR; }
    PG8_BAR;
#undef PG8_SA
#undef PG8_SB
#undef PG8_STAGE
#undef PG8_LDA
#undef PG8_LDB
#undef PG8_MMA
#undef PG8_WAIT_V
#undef PG8_WAIT_L
#undef PG8_BAR
#undef PG8_SCHED
}
}

#ifndef PG8_SP2
#define PG8_SP2 true
#endif
#ifndef PG8_ALIGN
#define PG8_ALIGN true
#endif

constexpr int NWAVES = 8;
constexpr int DM = 1024, NP = 16384, NS = 1024, T = NP + NS, SEQ = 2048, DSEQ = 8, DIN = 9216, PLE = 256;
constexpr float EPS = 1e-6f, LN_EPS = 1e-5f;
constexpr size_t OFF_NAP = (size_t)T * DM, OFF_NBP = OFF_NAP + 8 * 2 * 1024, OFF_NAS = OFF_NBP + 8 * 30 * 1024, OFF_NBS = OFF_NAS + 128 * 2 * 1024;
constexpr size_t MiB = 1u << 20;
constexpr size_t WS_CTL = 0, CTL_ZERO_BYTES = 2 * MiB;
constexpr size_t WS_SSQ = 1 * MiB, WS_SSQ2 = 1 * MiB + 256 * 1024;
constexpr size_t WS_WIN = 2 * MiB, WS_WAB = 20 * MiB, WS_WO = 24 * MiB, WS_WPG = 26 * MiB, WS_WPE = 28 * MiB;
constexpr size_t WS_PB = 29 * MiB;
constexpr size_t WS_XB = 38 * MiB;
constexpr size_t WS_QZ = 72 * MiB;
constexpr size_t WS_S = 140 * MiB;
constexpr size_t WS_V = 174 * MiB;
constexpr size_t WS_END = 208 * MiB;
constexpr int CW_BAR = 4096;
constexpr int RING_BYTES = 131072, LDSCTL_OFF = RING_BYTES, MISC_OFF = LDSCTL_OFF + 320, LDS_BYTES = 147456;

#define GAS __attribute__((address_space(1)))
#define LAS __attribute__((address_space(3)))
typedef unsigned short bf16;
typedef unsigned v4u __attribute__((ext_vector_type(4)));
typedef unsigned v2u __attribute__((ext_vector_type(2)));
typedef float f32x4 __attribute__((ext_vector_type(4)));
typedef float f32x2 __attribute__((ext_vector_type(2)));
#define LDS_WAIT() asm volatile("s_waitcnt lgkmcnt(0)" ::: "memory")
using pg8::cvt_pk_bf16; using pg8::bf_lo; using pg8::bf_hi; using pg8::sigmoidf_;

#define XB_TMO      128
#define XB_XCNT(j)  (256  + 64 * (j))
#define XB_XSUB(j)  (1280 + 64 * (j))
#define XB_XGEN(j)  (2304 + 64 * (j))
#define XB_TOP      3328
#define XB_TOPGEN   3392
#define XCD_BAR_WORDS 3456
#define XB_SPIN_CAP (1u << 18)
__device__ __forceinline__ unsigned xb_ld(unsigned* p)              { return __hip_atomic_load(p, __ATOMIC_RELAXED, __HIP_MEMORY_SCOPE_AGENT); }
__device__ __forceinline__ unsigned xb_add(unsigned* p, unsigned v) { return __hip_atomic_fetch_add(p, v, __ATOMIC_RELAXED, __HIP_MEMORY_SCOPE_AGENT); }
__device__ __forceinline__ unsigned xb_xcc_id() { return (unsigned)__builtin_amdgcn_s_getreg((3 << 11) | 20) & 0xFu; }
#define XB_SPIN(cond, bar) do { unsigned _sp = 0; while (cond) { __builtin_amdgcn_s_sleep(1); \
    if ((++_sp & 255u) == 0u) { if (xb_ld(&(bar)[XB_TMO])) break; if (_sp > XB_SPIN_CAP) { atomicAdd(&(bar)[XB_TMO], 1u); break; } } } } while (0)
struct XcdBarrier { unsigned* bar; unsigned x; volatile LAS unsigned* st; };
__device__ __forceinline__ XcdBarrier xcd_barrier_post(unsigned* bar, volatile LAS unsigned* st) {
    XcdBarrier b; b.bar = bar; b.x = xb_xcc_id(); b.st = st;
    if (threadIdx.x == 0) (void)xb_add(&bar[XB_XCNT(b.x)], 1u);
    return b;
}
__device__ __forceinline__ void xcd_barrier_complete(unsigned* bar, unsigned x, unsigned& nloc, unsigned& nx) {
    const unsigned G = gridDim.x * gridDim.y * gridDim.z;
    unsigned sum, cnt, mine, sp = 0u;
    for (;;) {
        sum = 0u; cnt = 0u; mine = 0u;
#pragma unroll
        for (unsigned j = 0; j < 16; ++j) { const unsigned c = xb_ld(&bar[XB_XCNT(j)]); sum += c; cnt += (c > 0u) ? 1u : 0u; mine = (j == x) ? c : mine; }
        if (sum == G) break;
        __builtin_amdgcn_s_sleep(1);
        if ((++sp & 255u) == 0u) { if (xb_ld(&bar[XB_TMO])) break; if (sp > XB_SPIN_CAP) { atomicAdd(&bar[XB_TMO], 1u); break; } }
    }
    nloc = mine > 0u ? mine : 1u; nx = cnt > 0u ? cnt : 1u;
}
__device__ __forceinline__ void xcd_barrier(const XcdBarrier& b) {
    asm volatile("s_waitcnt vmcnt(0)" ::: "memory");
    __syncthreads();
    if (threadIdx.x == 0) {
        unsigned* bar = b.bar;
        __builtin_amdgcn_s_waitcnt(0);
        unsigned nloc = b.st[0], nx = b.st[1];
        if (nloc == 0u) { xcd_barrier_complete(bar, b.x, nloc, nx); b.st[0] = nloc; b.st[1] = nx; }
        const unsigned old = xb_add(&bar[XB_XSUB(b.x)], 1u);
        const unsigned gen = old / nloc;
        if (old + 1u == (gen + 1u) * nloc) {
            __builtin_amdgcn_fence(__ATOMIC_RELEASE, "agent");
            asm volatile("s_waitcnt vmcnt(0)" ::: "memory");
            const unsigned og = xb_add(&bar[XB_TOP], 1u);
            const unsigned tg = og / nx;
            if (og + 1u == (tg + 1u) * nx) xb_add(&bar[XB_TOPGEN], 1u);
            else XB_SPIN(xb_ld(&bar[XB_TOPGEN]) == tg, bar);
            __builtin_amdgcn_fence(__ATOMIC_ACQUIRE, "agent");
            xb_add(&bar[XB_XGEN(b.x)], 1u);
            asm volatile("s_waitcnt vmcnt(0)" ::: "memory");
        } else {
            XB_SPIN(xb_ld(&bar[XB_XGEN(b.x)]) == gen, bar);
            __builtin_amdgcn_fence(__ATOMIC_ACQUIRE, "agent");
            asm volatile("s_waitcnt vmcnt(0)" ::: "memory");
        }
    }
    __syncthreads();
}

__device__ __forceinline__ float wave_sum(float v) {
#pragma unroll
    for (int o = 1; o < 64; o <<= 1) v += __shfl_xor(v, o);
    return v;
}

template <class RowMap>
__device__ __forceinline__ void p0_transpose_item(const float* W, int N, bf16* WT, int ldk, int koff, const float* gk, RowMap rm, LAS float* scr, int item, int lane) {
    const int nblk = N / 32, kb = item / nblk, nb = item % nblk, k0 = 64 * kb, n0 = 32 * nb;
#pragma unroll 8
    for (int i = 0; i < 32; ++i) { const int kk = 2 * i + (lane >> 5); float w = W[(size_t)(k0 + kk) * N + n0 + (lane & 31)]; if (gk) w *= gk[k0 + kk]; scr[kk * 33 + (lane & 31)] = w; }
    LDS_WAIT(); asm volatile("" ::: "memory");
    const int c = lane & 7;
#pragma unroll
    for (int j = 0; j < 4; ++j) { const int n = (lane >> 3) + 8 * j; const LAS float* s = scr + (8 * c) * 33 + n;
        v4u o; o.x = cvt_pk_bf16(s[0 * 33], s[1 * 33]); o.y = cvt_pk_bf16(s[2 * 33], s[3 * 33]); o.z = cvt_pk_bf16(s[4 * 33], s[5 * 33]); o.w = cvt_pk_bf16(s[6 * 33], s[7 * 33]);
        *(GAS v4u*)(WT + (size_t)rm(n0 + n) * ldk + koff + k0 + 8 * c) = o; }
    LDS_WAIT(); asm volatile("" ::: "memory");
}
struct RowId { __device__ __forceinline__ int operator()(int n) const { return n; } };
struct RowInProj { __device__ __forceinline__ int operator()(int sc) const {
    const int g = sc >> 10, ch = sc & 1023;
    if (g >= 6) return 256 * (24 + 4 * (g - 6) + (ch >> 8)) + (ch & 255);
    int base, isY;
    switch (g) { case 0: base = 0; isY = 0; break; case 3: base = 0; isY = 1; break; case 1: base = 8; isY = 0; break; case 2: base = 8; isY = 1; break; case 4: base = 16; isY = 0; break; default: base = 16; isY = 1; break; }
    const int cl = ch & 127, grp = cl >> 3, r8 = cl & 7, bj = r8 >> 2, j = r8 & 3;
    return 256 * (base + (ch >> 7)) + 128 * bj + 8 * grp + 4 * isY + j; } };

struct Ptrs {
    const float *x_p, *x_s, *st_a, *st_b, *p_p, *p_s, *g_mix, *w_in, *w_conv_a, *w_out_a, *w_conv_b, *b_conv_b, *ln_g, *ln_b, *w_out_b, *w_o, *w_pe, *g_ple, *w_pg, *g_final;
    float* out; unsigned char* ws;
};

typedef const __attribute__((address_space(4))) Ptrs* KPtrsT;
__device__ __forceinline__ Ptrs load_ptrs(KPtrsT k) {
    Ptrs P;
    P.x_p = k->x_p; P.x_s = k->x_s; P.st_a = k->st_a; P.st_b = k->st_b; P.p_p = k->p_p; P.p_s = k->p_s; P.g_mix = k->g_mix; P.w_in = k->w_in; P.w_conv_a = k->w_conv_a; P.w_out_a = k->w_out_a;
    P.w_conv_b = k->w_conv_b; P.b_conv_b = k->b_conv_b; P.ln_g = k->ln_g; P.ln_b = k->ln_b; P.w_out_b = k->w_out_b; P.w_o = k->w_o; P.w_pe = k->w_pe; P.g_ple = k->g_ple; P.w_pg = k->w_pg; P.g_final = k->g_final;
    P.out = k->out; P.ws = k->ws; return P;
}
__device__ __forceinline__ void p0_prologue(const Ptrs& P, LAS unsigned char* lds, int gw, int NGW, int lane, int wave) {
    LAS float* scr = (LAS float*)(lds + wave * 16384);
    bf16* Wt_in = (bf16*)(P.ws + WS_WIN); bf16* Wt_ab = (bf16*)(P.ws + WS_WAB); bf16* Wt_o = (bf16*)(P.ws + WS_WO); bf16* Wt_pg = (bf16*)(P.ws + WS_WPG); bf16* Wt_pe = (bf16*)(P.ws + WS_WPE);
    constexpr int I_IN = (DM / 64) * (DIN / 32), I_SQ = (DM / 64) * (DM / 32), I_PE = (PLE / 64) * (DM / 32);
    constexpr int NITEMS = I_IN + 4 * I_SQ + I_PE;
    for (int it = gw; it < NITEMS; it += NGW) {
        int r = it;
        if (r < I_IN) { p0_transpose_item(P.w_in, DIN, Wt_in, DM, 0, P.g_mix, RowInProj(), scr, r, lane); continue; } r -= I_IN;
        if (r < I_SQ) { p0_transpose_item(P.w_out_a, DM, Wt_ab, 2 * DM, 0, nullptr, RowId(), scr, r, lane); continue; } r -= I_SQ;
        if (r < I_SQ) { p0_transpose_item(P.w_out_b, DM, Wt_ab, 2 * DM, DM, nullptr, RowId(), scr, r, lane); continue; } r -= I_SQ;
        if (r < I_SQ) { p0_transpose_item(P.w_o, DM, Wt_o, DM, 0, nullptr, RowId(), scr, r, lane); continue; } r -= I_SQ;
        if (r < I_SQ) { p0_transpose_item(P.w_pg, DM, Wt_pg, DM, 0, P.g_ple, RowId(), scr, r, lane); continue; } r -= I_SQ;
        p0_transpose_item(P.w_pe, DM, Wt_pe, PLE, 0, nullptr, RowId(), scr, r, lane);
    }
    bf16* XB = (bf16*)(P.ws + WS_XB); bf16* PB = (bf16*)(P.ws + WS_PB);
    for (int m = gw; m < T; m += NGW) {
        const float* xrow = m < NP ? P.x_p + (size_t)m * DM : P.x_s + (size_t)(m - NP) * DM;
        const GAS f32x4* xr = (const GAS f32x4*)xrow + lane;
        f32x4 v[4]; float s = 0.f;
#pragma unroll
        for (int j = 0; j < 4; ++j) { v[j] = xr[64 * j]; s += (v[j].x * v[j].x + v[j].y * v[j].y) + (v[j].z * v[j].z + v[j].w * v[j].w); }
        const float rstd = 1.0f / sqrtf(wave_sum(s) * (1.0f / DM) + EPS);
        GAS v2u* o8 = (GAS v2u*)(XB + (size_t)m * DM) + lane;
#pragma unroll
        for (int j = 0; j < 4; ++j) { v2u w; w.x = cvt_pk_bf16(v[j].x * rstd, v[j].y * rstd); w.y = cvt_pk_bf16(v[j].z * rstd, v[j].w * rstd); o8[64 * j] = w; }
        const float* prow = m < NP ? P.p_p + (size_t)m * PLE : P.p_s + (size_t)(m - NP) * PLE;
        const f32x4 pv = ((const GAS f32x4*)prow)[lane];
        v2u w; w.x = cvt_pk_bf16(pv.x, pv.y); w.y = cvt_pk_bf16(pv.z, pv.w);
        ((GAS v2u*)(PB + (size_t)m * PLE))[lane] = w;
    }
}

using pg8::rsrc_t; using pg8::mkrsrc;
__device__ __forceinline__ unsigned bld4(rsrc_t r, unsigned voff, unsigned soff) { return __builtin_amdgcn_raw_buffer_load_b32(r, (int)voff, (int)soff, 0); }
__device__ __forceinline__ void bst4(rsrc_t r, unsigned voff, unsigned soff, unsigned v) { __builtin_amdgcn_raw_buffer_store_b32(v, r, (int)voff, (int)soff, 0); }
__device__ __forceinline__ f32x2 bld8f(rsrc_t r, unsigned voff, unsigned soff) { return __builtin_bit_cast(f32x2, __builtin_amdgcn_raw_buffer_load_b64(r, (int)voff, (int)soff, 0)); }
__device__ __forceinline__ void bst8f(rsrc_t r, unsigned voff, unsigned soff, f32x2 v) { __builtin_amdgcn_raw_buffer_store_b64(__builtin_bit_cast(v2u, v), r, (int)voff, (int)soff, 0); }
__device__ __forceinline__ f32x2 up2(unsigned u) { return (f32x2){bf_lo(u), bf_hi(u)}; }
template <bool SAMPLE>
__device__ __forceinline__ void p2_tile(const Ptrs& P, LAS unsigned char* lds, int tile, int tid, int lane, int wave) {
    const rsrc_t rQZ = mkrsrc(P.ws + WS_QZ), rS = mkrsrc(P.ws + WS_S), rV = mkrsrc(P.ws + WS_V), rWb = mkrsrc(P.w_conv_b), rOut = mkrsrc(P.out);
    const unsigned v4 = (unsigned)tid * 4u, v8 = (unsigned)tid * 8u;
    LAS f32x2* cl2 = (LAS f32x2*)lds;
    const f32x2 wA0 = *(const f32x2*)(P.w_conv_a + 2 * tid), wA1 = *(const f32x2*)(P.w_conv_a + 1024 + 2 * tid), wA2 = *(const f32x2*)(P.w_conv_a + 2048 + 2 * tid);
    const f32x2 bias = *(const f32x2*)(P.b_conv_b + 2 * tid);
    unsigned R0;
    if constexpr (!SAMPLE) {
        const unsigned b = tile >> 6, t0 = (tile & 63) * 32; R0 = b * SEQ + t0;
        const bool lastt = (t0 == SEQ - 32), first = (t0 == 0);
        {
            f32x2 sw[34];
#pragma unroll
            for (int i = 0; i < 34; ++i) { const bool neg = first && i < 2; unsigned u = bld4(rS, v4, neg ? 0u : (R0 - 2 + i) * 2048u); u = neg ? 0u : u; sw[i] = up2(u); }
#pragma unroll
            for (int i = 0; i < 32; ++i) { const f32x2 q = up2(bld4(rQZ, v4, (R0 + i) * 4096u));
                const f32x2 cv = wA0 * sw[i] + wA1 * sw[i + 1] + wA2 * sw[i + 2]; const f32x2 ya = q * cv; bst4(rQZ, v4, (R0 + i) * 4096u, cvt_pk_bf16(ya.x, ya.y)); }
            if (lastt) {
#pragma unroll
                for (int j = 0; j < 2; ++j) bst8f(rOut, v8, (unsigned)(OFF_NAP + (size_t)(b * 2 + j) * 1024) * 4u, sw[32 + j]); }
        }
        {
            f32x2 win[62];
#pragma unroll
            for (int i = 0; i < 62; ++i) { const bool neg = first && i < 30; unsigned u = bld4(rV, v4, neg ? 0u : (R0 - 30 + i) * 2048u); u = neg ? 0u : u; win[i] = up2(u); }
#pragma unroll
            for (int hh = 0; hh < 2; ++hh) {
                f32x2 c[16];
#pragma unroll
                for (int i = 0; i < 16; ++i) c[i] = bias;
#pragma unroll
                for (int k = 0; k < 31; ++k) { const f32x2 w = bld8f(rWb, v8, k * 4096u);
#pragma unroll
                    for (int i = 0; i < 16; ++i) c[i] += w * win[hh * 16 + i + k]; }
#pragma unroll
                for (int i = 0; i < 16; ++i) cl2[(hh * 16 + i) * 512 + tid] = c[i];
            }
            if (lastt) {
#pragma unroll
                for (int j = 0; j < 30; ++j) bst8f(rOut, v8, (unsigned)(OFF_NBP + (size_t)(b * 30 + j) * 1024) * 4u, win[32 + j]); }
        }
    } else {
        R0 = NP + tile * 32;
        const rsrc_t rSa = mkrsrc(P.st_a), rSb = mkrsrc(P.st_b);
#pragma unroll 1
        for (int e = 0; e < 4; ++e) {
            const unsigned n = tile * 4 + e, r0 = NP + n * DSEQ;
            {
                f32x2 sw[10];
#pragma unroll
                for (int i = 0; i < 2; ++i) sw[i] = bld8f(rSa, v8, (n * 2 + i) * 4096u);
#pragma unroll
                for (int i = 0; i < 8; ++i) sw[2 + i] = up2(bld4(rS, v4, (r0 + i) * 2048u));
#pragma unroll
                for (int i = 0; i < 8; ++i) { const f32x2 q = up2(bld4(rQZ, v4, (r0 + i) * 4096u));
                    const f32x2 cv = wA0 * sw[i] + wA1 * sw[i + 1] + wA2 * sw[i + 2]; const f32x2 ya = q * cv; bst4(rQZ, v4, (r0 + i) * 4096u, cvt_pk_bf16(ya.x, ya.y)); }
#pragma unroll
                for (int j = 0; j < 2; ++j) bst8f(rOut, v8, (unsigned)(OFF_NAS + (size_t)(n * 2 + j) * 1024) * 4u, sw[8 + j]);
            }
            {
                f32x2 win[38];
#pragma unroll
                for (int i = 0; i < 30; ++i) win[i] = bld8f(rSb, v8, (n * 30 + i) * 4096u);
#pragma unroll
                for (int i = 0; i < 8; ++i) win[30 + i] = up2(bld4(rV, v4, (r0 + i) * 2048u));
                f32x2 c[8];
#pragma unroll
                for (int i = 0; i < 8; ++i) c[i] = bias;
#pragma unroll
                for (int k = 0; k < 31; ++k) { const f32x2 w = bld8f(rWb, v8, k * 4096u);
#pragma unroll
                    for (int i = 0; i < 8; ++i) c[i] += w * win[i + k]; }
#pragma unroll
                for (int i = 0; i < 8; ++i) cl2[(e * 8 + i) * 512 + tid] = c[i];
#pragma unroll
                for (int j = 0; j < 30; ++j) bst8f(rOut, v8, (unsigned)(OFF_NBS + (size_t)(n * 30 + j) * 1024) * 4u, win[8 + j]);
            }
        }
    }
    __syncthreads();
    {
        f32x4 lg[4], lb[4];
#pragma unroll
        for (int j = 0; j < 4; ++j) { lg[j] = *(const f32x4*)(P.ln_g + j * 256 + lane * 4); lb[j] = *(const f32x4*)(P.ln_b + j * 256 + lane * 4); }
        const LAS f32x4* cl4 = (const LAS f32x4*)lds;
        const unsigned vz = (unsigned)lane * 8u;
#pragma unroll 1
        for (int ii = 0; ii < 4; ++ii) { const int i = wave * 4 + ii;
            f32x4 x[4]; float s = 0.f;
#pragma unroll
            for (int j = 0; j < 4; ++j) { x[j] = cl4[i * 256 + j * 64 + lane]; s += (x[j].x + x[j].y) + (x[j].z + x[j].w); }
            const float mean = wave_sum(s) * (1.0f / 1024.0f); float q = 0.f;
#pragma unroll
            for (int j = 0; j < 4; ++j) { x[j] = x[j] - mean; q += (x[j].x * x[j].x + x[j].y * x[j].y) + (x[j].z * x[j].z + x[j].w * x[j].w); }
            const float rstd = 1.0f / sqrtf(wave_sum(q) * (1.0f / 1024.0f) + LN_EPS);
            const unsigned so = (R0 + i) * 4096u + 2048u;
#pragma unroll
            for (int j = 0; j < 4; ++j) { const v2u z = __builtin_amdgcn_raw_buffer_load_b64(rQZ, (int)vz, (int)(so + j * 512), 0); const f32x4 y = x[j] * rstd * lg[j] + lb[j];
                f32x4 o; o.x = y.x * sigmoidf_(y.x) * bf_lo(z.x); o.y = y.y * sigmoidf_(y.y) * bf_hi(z.x); o.z = y.z * sigmoidf_(y.z) * bf_lo(z.y); o.w = y.w * sigmoidf_(y.w) * bf_hi(z.y);
                v2u w; w.x = cvt_pk_bf16(o.x, o.y); w.y = cvt_pk_bf16(o.z, o.w); __builtin_amdgcn_raw_buffer_store_b64(w, rQZ, (int)vz, (int)(so + j * 512), 0); }
        }
    }
    __syncthreads();
}

struct Args { Ptrs p; int ph_lo, ph_hi; };
constexpr int NPHASE = 7;

__global__ void __launch_bounds__(NWAVES * 64, 2) fwd_megakernel(Args args) {
    extern __shared__ __attribute__((aligned(16))) unsigned char lds_raw[];
    LAS unsigned char* lds = (LAS unsigned char*)lds_raw;
    typedef const __attribute__((address_space(4))) Ptrs* KPtrs;
    const KPtrs Pk = (KPtrs)__builtin_amdgcn_kernarg_segment_ptr();
#define PHASE_PTRS() KPtrs Pq_ = Pk; asm volatile("" : "+s"(Pq_)); const Ptrs P = load_ptrs(Pq_); int tid = threadIdx.x; asm volatile("" : "+v"(tid)); const int lane = tid & 63; (void)lane
    const int tid0 = threadIdx.x, wave = __builtin_amdgcn_readfirstlane(tid0 >> 6);
    const int G = gridDim.x, bx = blockIdx.x;
    const int gw = bx * NWAVES + wave, NGW = G * NWAVES;
    volatile LAS unsigned* MISC = (volatile LAS unsigned*)(lds + MISC_OFF);
    for (int u = tid0; u < (LDS_BYTES - LDSCTL_OFF) / 4; u += NWAVES * 64) ((LAS unsigned*)(lds + LDSCTL_OFF))[u] = 0u;
    __syncthreads();
    unsigned* ctl;
    { PHASE_PTRS(); ctl = (unsigned*)(P.ws + WS_CTL); }
    XcdBarrier bar; bar.bar = ctl + CW_BAR; bar.x = 0; bar.st = nullptr;
#if !MK_PER_PHASE
    bar = xcd_barrier_post(ctl + CW_BAR, MISC + 8);
#endif
    const int lo = args.ph_lo, hi = args.ph_hi;
#ifdef PH_MASK
#define IN(k) ((((PH_MASK) >> (k)) & 1) && lo <= (k) && (k) < hi)
#else
#define IN(k) (lo <= (k) && (k) < hi)
#endif
#define SEAM(k) do { if (IN(k) && IN((k) + 1)) xcd_barrier(bar); } while (0)
#define WSP(off) ((pg8::bf16_t*)(P.ws + (off)))

    if (IN(0)) { PHASE_PTRS(); p0_prologue(P, lds, gw, NGW, lane, wave); }
    SEAM(0);
    if (IN(1)) { PHASE_PTRS();
        pg8::Gemm g{WSP(WS_XB), WSP(WS_WIN), T, DIN, DM}; pg8::StaticOrder S; S.init(T, DIN, G, bx);
#if defined(DBG_DUMP) && DBG_DUMP == 22
        pg8::EpiPlain E{WSP(WS_QZ), 2048};
        pg8::gemm_phase<pg8::EpiPlain, pg8::StaticOrder, PG8_ALIGN, PG8_SP2>(lds, g, S, E);
#else
        pg8::EpiInProj E{WSP(WS_QZ), WSP(WS_S), WSP(WS_V), (pg8::bf16_t*)P.out, (pg8::bf16_t*)P.out + (size_t)T * DM};
        pg8::gemm_phase<pg8::EpiInProj, pg8::StaticOrder, PG8_ALIGN, PG8_SP2>(lds, g, S, E);
#endif
    }
    SEAM(1);
    if (IN(2)) { PHASE_PTRS();
        for (int tile = bx; tile < 544; tile += G) { if (tile < 512) p2_tile<false>(P, lds, tile, tid, lane, wave); else p2_tile<true>(P, lds, tile - 512, tid, lane, wave); }
    }
    SEAM(2);
    if (IN(3)) { PHASE_PTRS();
        pg8::Gemm g{WSP(WS_QZ), WSP(WS_WAB), T, DM, 2 * DM}; pg8::StaticOrder S; S.init(T, DM, G, bx);
        pg8::EpiOutGate E{(const pg8::bf16_t*)P.out, (const pg8::bf16_t*)P.out + (size_t)T * DM, WSP(WS_S)};
        pg8::gemm_phase<pg8::EpiOutGate, pg8::StaticOrder, PG8_ALIGN, PG8_SP2>(lds, g, S, E);
    }
    SEAM(3);
    if (IN(4)) {
        { PHASE_PTRS(); pg8::Gemm g{WSP(WS_S), WSP(WS_WO), T, DM, DM}; pg8::StaticOrder S; S.init(T, DM, G, bx);
          pg8::EpiWo E{P.x_p, P.x_s, P.out, WSP(WS_V), (float*)(P.ws + WS_SSQ)};
          pg8::gemm_phase<pg8::EpiWo, pg8::StaticOrder, PG8_ALIGN, PG8_SP2>(lds, g, S, E); }
        { PHASE_PTRS(); pg8::Gemm g{WSP(WS_PB), WSP(WS_WPE), T, DM, PLE}; pg8::StaticOrder S; S.init(T, DM, G, bx);
          pg8::EpiPlain E{WSP(WS_XB), DM};
          pg8::gemm_phase<pg8::EpiPlain, pg8::StaticOrder, PG8_ALIGN, PG8_SP2>(lds, g, S, E); }
    }
    SEAM(4);
    if (IN(5)) { PHASE_PTRS();
        pg8::Gemm g{WSP(WS_V), WSP(WS_WPG), T, DM, DM}; pg8::StaticOrder S; S.init(T, DM, G, bx);
        pg8::EpiPg E{P.out, WSP(WS_XB), (const float*)(P.ws + WS_SSQ), (float*)(P.ws + WS_SSQ2)};
        pg8::gemm_phase<pg8::EpiPg, pg8::StaticOrder, PG8_ALIGN, PG8_SP2>(lds, g, S, E);
    }
    SEAM(5);
#ifdef DBG_DUMP
    if (lo == 6) { PHASE_PTRS();
        const unsigned* QZu = (const unsigned*)(P.ws + WS_QZ); const unsigned* Su = (const unsigned*)(P.ws + WS_S); const unsigned* Vu = (const unsigned*)(P.ws + WS_V);
        float* H = P.out;
        if (DBG_DUMP == 0) { for (int m = gw; m < T; m += NGW) { const float* xr = m < NP ? P.x_p + (size_t)m * DM : P.x_s + (size_t)(m - NP) * DM; for (int j = 0; j < 16; ++j) H[(size_t)m * DM + j * 64 + lane] = xr[j * 64 + lane]; } }
        else if (DBG_DUMP == 1) { const unsigned short* XBs = (const unsigned short*)(P.ws + WS_XB); const unsigned short* Ws = (const unsigned short*)(P.ws + WS_WIN); const unsigned short* PBs = (const unsigned short*)(P.ws + WS_PB);
            const unsigned short* W2 = (const unsigned short*)(P.ws + WS_WAB);
            for (int m = gw; m < T; m += NGW) { for (int j = 0; j < 16; ++j) { const int c = j * 64 + lane; H[(size_t)m * DM + c] = bf_lo(XBs[(size_t)m * DM + c]) + bf_lo(Ws[(size_t)(m % DIN) * DM + c]) + bf_lo(PBs[(size_t)m * PLE + (c & 255)]) + bf_lo(W2[(size_t)(m % 5376) * DM + c]); } } }
        else
        for (int m = gw; m < T; m += NGW) {
            float acc8[16];
#pragma unroll
            for (int j = 0; j < 8; ++j) { const int c2 = j * 64 + lane;
                const unsigned a = QZu[(size_t)m * 1024 + c2], b = QZu[(size_t)m * 1024 + 512 + c2], c = Su[(size_t)m * 512 + c2], d = Vu[(size_t)m * 512 + c2];
                acc8[2 * j] = bf_lo(a) + bf_lo(b) + (DBG_DUMP >= 3 ? bf_lo(c) : 0.f) + (DBG_DUMP >= 4 ? bf_lo(d) : 0.f); acc8[2 * j + 1] = bf_hi(a) + bf_hi(b) + (DBG_DUMP >= 3 ? bf_hi(c) : 0.f) + (DBG_DUMP >= 4 ? bf_hi(d) : 0.f); }
#pragma unroll
            for (int j = 0; j < 8; ++j) { H[(size_t)m * DM + 2 * (j * 64 + lane)] = acc8[2 * j]; H[(size_t)m * DM + 2 * (j * 64 + lane) + 1] = acc8[2 * j + 1]; }
        }
        if (DBG_DUMP < 3) for (size_t i = (size_t)T * DM + (size_t)bx * 512 + tid; i < (size_t)22282240; i += (size_t)G * 512) H[i] = 0.f;
    }
    if (false) { PHASE_PTRS();
        float* H = P.out;
#else
    if (IN(6)) { PHASE_PTRS();
        float* H = P.out;
#endif
        f32x4 gf[4];
#pragma unroll
        for (int j = 0; j < 4; ++j) gf[j] = *(const f32x4*)(P.g_final + j * 256 + lane * 4);
        for (int m = gw; m < T; m += NGW) {
            GAS f32x4* hr = (GAS f32x4*)(H + (size_t)m * DM) + lane;
            f32x4 v[4]; float s = 0.f;
#pragma unroll
            for (int j = 0; j < 4; ++j) { v[j] = hr[64 * j]; s += (v[j].x * v[j].x + v[j].y * v[j].y) + (v[j].z * v[j].z + v[j].w * v[j].w); }
            const float rstd = 1.0f / sqrtf(wave_sum(s) * (1.0f / DM) + EPS);
#pragma unroll
            for (int j = 0; j < 4; ++j) { f32x4 o = v[j] * rstd * gf[j];
#ifdef DBG_SANITIZE
                o.x = (o.x - o.x == 0.f) ? o.x : 0.f; o.y = (o.y - o.y == 0.f) ? o.y : 0.f; o.z = (o.z - o.z == 0.f) ? o.z : 0.f; o.w = (o.w - o.w == 0.f) ? o.w : 0.f;
#endif
                hr[64 * j] = o; }
        }
    }
#undef WSP
#undef IN
#undef SEAM
}

extern "C" void kernel_launch(void* const* d_in, const int* in_sizes, int n_in, void* d_out, int out_size, void* d_ws, size_t ws_size, hipStream_t stream) {
    static int grid = 0;
    if (grid == 0) {
        if (n_in != 20 || ws_size < WS_END) { fprintf(stderr, "kernel_launch: unexpected n_in %d / ws %zu\n", n_in, ws_size); grid = -1; return; }
        int dev = 0, cus = 0, per_cu = 0;
        if (hipGetDevice(&dev) != hipSuccess || hipDeviceGetAttribute(&cus, hipDeviceAttributeMultiprocessorCount, dev) != hipSuccess) { grid = -1; return; }
        if (hipFuncSetAttribute((const void*)fwd_megakernel, hipFuncAttributeMaxDynamicSharedMemorySize, LDS_BYTES) != hipSuccess) { fprintf(stderr, "kernel_launch: hipFuncSetAttribute failed\n"); grid = -1; return; }
        if (hipOccupancyMaxActiveBlocksPerMultiprocessor(&per_cu, (const void*)fwd_megakernel, NWAVES * 64, LDS_BYTES) != hipSuccess || per_cu < 1) { fprintf(stderr, "kernel_launch: occupancy query says %d\n", per_cu); (void)hipGetLastError(); per_cu = 1; }
        grid = cus;
    }
    if (grid < 0) return;
    (void)hipMemsetAsync((char*)d_ws + WS_CTL, 0, CTL_ZERO_BYTES, stream);
    Args a{};
    const float** pp = (const float**)&a.p;
    for (int i = 0; i < 20; ++i) pp[i] = (const float*)d_in[i];
    a.p.out = (float*)d_out; a.p.ws = (unsigned char*)d_ws;
#if MK_PER_PHASE
#ifdef DBG_DUMP
    for (int ph = 0; ph < NPHASE; ++ph) { if (ph >= (DBG_DUMP > 4 ? DBG_DUMP - 2 : (DBG_DUMP >= 3 ? 3 : DBG_DUMP)) && ph != 6) continue; a.ph_lo = ph; a.ph_hi = ph + 1; hipLaunchKernelGGL(fwd_megakernel, dim3(grid), dim3(NWAVES * 64), LDS_BYTES, stream, a); }
#else
    for (int ph = 0; ph < NPHASE; ++ph) { a.ph_lo = ph; a.ph_hi = ph + 1; hipLaunchKernelGGL(fwd_megakernel, dim3(grid), dim3(NWAVES * 64), LDS_BYTES, stream, a); }
#endif
#else
    a.ph_lo = 0; a.ph_hi = NPHASE;
    void* kargs[] = {&a};
    hipError_t e = hipLaunchCooperativeKernel((const void*)fwd_megakernel, dim3(grid), dim3(NWAVES * 64), kargs, LDS_BYTES, stream);
    if (e != hipSuccess) fprintf(stderr, "kernel_launch: cooperative launch failed: %s (grid %d)\n", hipGetErrorString(e), grid);
#endif
}
```

```cpp
#include <hip/hip_runtime.h>
#include <cstdio>
#include <cstdint>

#ifndef MK_PER_PHASE
#define MK_PER_PHASE 0
#endif

namespace pg8 {
#define PG8_LAS __attribute__((address_space(3)))
typedef unsigned short bf16_t;
typedef short bf16x8 __attribute__((ext_vector_type(8)));
typedef float f32x4 __attribute__((ext_vector_type(4)));
typedef unsigned u32x4 __attribute__((ext_vector_type(4)));
typedef unsigned u32x2 __attribute__((ext_vector_type(2)));
constexpr int BM = 256, BK = 64, HALF = 128, HTB = HALF * BK * 2, STAGE_BYTES = 8 * HTB, NXCD = 8, WGM = 8;

__host__ __device__ __forceinline__ int lds_byte(int r, int c) { const int st = (r >> 4) * 2 + (c >> 5), rr = r & 15, cc = c & 31, ob = rr * 64 + cc * 2; return st * 1024 + (ob ^ (((ob >> 9) & 1) << 5)); }
__host__ __device__ __forceinline__ void stage_rc(int b, int& R, int& C) { const int st = b / 1024, sb = b % 1024, swz = sb ^ (((sb >> 9) & 1) << 5); R = (st >> 1) * 16 + swz / 64; C = (st & 1) * 32 + (swz % 64) / 2; }
__host__ __device__ __forceinline__ int perm32(int rho) { const int n = rho >> 4, i = rho & 15; return 8 * (i >> 2) + 4 * n + (i & 3); }

struct Unit { int pm, pn; };
struct Gemm { const bf16_t* A; const bf16_t* Bt; int M, N, K; };

struct StaticOrder {
    int nM, nN, nwg, G, c;
    __host__ __device__ void init(int M, int N, int G_, int c_) { nM = M / BM; nN = N / BM; nwg = nM * nN; G = G_; c = c_; }
    __host__ __device__ bool next(int i, Unit& u) const {
        const long L = (long)i * G + c; if (L >= nwg) return false;
        int wgid = (int)L; { const int q = nwg / NXCD, r = nwg % NXCD, xcd = wgid % NXCD, off = wgid / NXCD; wgid = (xcd < r ? xcd * (q + 1) : r * (q + 1) + (xcd - r) * q) + off; }
        const int nig = WGM * nN, gid = wgid / nig, fm = gid * WGM, gsz = (nM - fm) < WGM ? (nM - fm) : WGM;
        u.pm = fm + ((wgid % nig) % gsz); u.pn = (wgid % nig) / gsz; return true;
    }
    __device__ __forceinline__ void a_ready(const Unit&) const {}
    __device__ __forceinline__ void done(const Unit&) const {}
};

typedef __bf16 bf16x2_n __attribute__((ext_vector_type(2)));
typedef float f32x2_n __attribute__((ext_vector_type(2)));
__device__ __forceinline__ unsigned cvt_pk_bf16(float lo, float hi) { unsigned r; asm volatile("s_nop 0\n\tv_cvt_pk_bf16_f32 %0, %1, %2" : "=v"(r) : "v"(lo), "v"(hi)); return r; }
__device__ __forceinline__ float bf_lo(unsigned u) { return __uint_as_float(u << 16); }
__device__ __forceinline__ float bf_hi(unsigned u) { return __uint_as_float(u & 0xffff0000u); }
__device__ __forceinline__ float sigmoidf_(float x) { return __builtin_amdgcn_rcpf(1.0f + __expf(-x)); }
__device__ __forceinline__ u32x4 pack8(const f32x4 a, const f32x4 b) { u32x4 w; w.x = cvt_pk_bf16(a[0], a[1]); w.y = cvt_pk_bf16(a[2], a[3]); w.z = cvt_pk_bf16(b[0], b[1]); w.w = cvt_pk_bf16(b[2], b[3]); return w; }
__device__ __forceinline__ void unpack8(const u32x4 w, f32x4& a, f32x4& b) { a[0] = bf_lo(w.x); a[1] = bf_hi(w.x); a[2] = bf_lo(w.y); a[3] = bf_hi(w.y); b[0] = bf_lo(w.z); b[1] = bf_hi(w.z); b[2] = bf_lo(w.w); b[3] = bf_hi(w.w); }


typedef __amdgpu_buffer_rsrc_t rsrc_t;
__device__ __forceinline__ rsrc_t mkrsrc(const void* p) { return __builtin_amdgcn_make_buffer_rsrc(const_cast<void*>(p), 0, 0x7fffffff, 0x00020000); }
__device__ __forceinline__ u32x4 bld16(rsrc_t r, unsigned voff, unsigned soff) { return __builtin_amdgcn_raw_buffer_load_b128(r, (int)voff, (int)soff, 0); }
__device__ __forceinline__ void bst16(rsrc_t r, unsigned voff, unsigned soff, u32x4 v) { unsigned vo = voff + soff; asm volatile("" : "+v"(vo)); __builtin_amdgcn_raw_buffer_store_b128(v, r, (int)vo, 0, 0); }
__device__ __forceinline__ f32x4 as_f(u32x4 v) { return __builtin_bit_cast(f32x4, v); }
__device__ __forceinline__ u32x4 as_u(f32x4 v) { return __builtin_bit_cast(u32x4, v); }

struct EpiInProj {
    static constexpr bool PERM = true, AFTER_DRAIN = false, MID = false;
    bf16_t *QZ, *S, *V, *GA, *GB;
    __device__ __forceinline__ void mid(f32x4 (&)[2][2][4][2], const Unit&, int, int, int, int) const {}
    template <int TYPE> __device__ __forceinline__ void pair(const f32x4 (&acc)[2][2][4][2], rsrc_t r, unsigned sbase, unsigned voff, unsigned ldb) const {
#pragma unroll
        for (int ai = 0; ai < 2; ++ai)
#pragma unroll
            for (int m = 0; m < 4; ++m) {
                f32x4 o[2];
#pragma unroll
                for (int bj = 0; bj < 2; ++bj) { const f32x4 X = acc[ai][bj][m][0], Y = acc[ai][bj][m][1];
#pragma unroll
                    for (int j = 0; j < 4; ++j) { if (TYPE == 1) o[bj][j] = X[j] * Y[j]; else { const float sg = sigmoidf_(Y[j]); o[bj][j] = TYPE == 0 ? X[j] * Y[j] * sg : X[j] * sg; } } }
                bst16(r, voff, sbase + (unsigned)(ai * HALF + m * 16) * ldb, pack8(o[0], o[1]));
            }
    }
    template <int TYPE> __device__ __forceinline__ void single(const f32x4 (&acc)[2][2][4][2], rsrc_t r, unsigned sbase, unsigned voff, unsigned ldb) const {
#pragma unroll
        for (int ai = 0; ai < 2; ++ai)
#pragma unroll
            for (int m = 0; m < 4; ++m)
#pragma unroll
                for (int bj = 0; bj < 2; ++bj) { f32x4 v0 = acc[ai][bj][m][0], v1 = acc[ai][bj][m][1];
#pragma unroll
                    for (int j = 0; j < 4; ++j) { const float s0 = sigmoidf_(v0[j]), s1 = sigmoidf_(v1[j]); v0[j] = TYPE == 0 ? v0[j] * s0 : s0; v1[j] = TYPE == 0 ? v1[j] * s1 : s1; }
                    bst16(r, voff, sbase + (unsigned)(ai * HALF + m * 16) * ldb + bj * (HALF * 2), pack8(v0, v1)); }
    }
    __device__ __forceinline__ void operator()(const f32x4 (&acc)[2][2][4][2], const Unit& u, int wr, int wc, int fr, int fq) const {
        const unsigned urow = u.pm * BM + wr * 64, pn = u.pn;
        if (pn < 24) {
            const unsigned type = pn >> 3, ucb = (pn & 7) * 128 + 32 * wc;
            if (type == 0) pair<0>(acc, mkrsrc(QZ), (urow * 2048 + ucb) * 2, (unsigned)(fr * 2048 + 8 * fq) * 2u, 4096);
#if !defined(DBG_ONLYQZ)
            else if (type == 1) pair<1>(acc, mkrsrc(S), (urow * 1024 + ucb) * 2, (unsigned)(fr * 1024 + 8 * fq) * 2u, 2048);
            else pair<2>(acc, mkrsrc(V), (urow * 1024 + ucb) * 2, (unsigned)(fr * 1024 + 8 * fq) * 2u, 2048);
#endif
        } else {
            const unsigned t = (pn - 24) >> 2, ucb = ((pn - 24) & 3) * 256 + wc * 32;
            if (t == 0) single<0>(acc, mkrsrc(QZ), (urow * 2048 + 1024 + ucb) * 2, (unsigned)(fr * 2048 + 8 * fq) * 2u, 4096);
#if !defined(DBG_ONLYQZ)
            else if (t == 1) single<1>(acc, mkrsrc(GA), (urow * 1024 + ucb) * 2, (unsigned)(fr * 1024 + 8 * fq) * 2u, 2048);
            else single<1>(acc, mkrsrc(GB), (urow * 1024 + ucb) * 2, (unsigned)(fr * 1024 + 8 * fq) * 2u, 2048);
#endif
        }
    }
};
struct EpiPlain {
    static constexpr bool PERM = true, AFTER_DRAIN = false, MID = false;
    bf16_t* O; int ldc;
    __device__ __forceinline__ void mid(f32x4 (&)[2][2][4][2], const Unit&, int, int, int, int) const {}
    __device__ __forceinline__ void operator()(const f32x4 (&acc)[2][2][4][2], const Unit& u, int wr, int wc, int fr, int fq) const {
#if defined(DBG_DUMP) && DBG_DUMP == 2
        if (u.pn >= 8) return;
#endif
        const rsrc_t r = mkrsrc(O); const unsigned sb = ((unsigned)(u.pm * BM + wr * 64) * ldc + u.pn * BM + wc * 32) * 2, voff = (unsigned)(fr * ldc + 8 * fq) * 2u;
#pragma unroll
        for (int ai = 0; ai < 2; ++ai)
#pragma unroll
            for (int m = 0; m < 4; ++m)
#pragma unroll
                for (int bj = 0; bj < 2; ++bj) bst16(r, voff, sb + (unsigned)(ai * HALF + m * 16) * ldc * 2 + bj * (HALF * 2), pack8(acc[ai][bj][m][0], acc[ai][bj][m][1]));
    }
};
struct EpiOutGate {
    static constexpr bool PERM = true, AFTER_DRAIN = false, MID = true;
    const bf16_t *GA, *GB; bf16_t* Mo;
    __device__ __forceinline__ void mid(f32x4 (&acc)[2][2][4][2], const Unit& u, int wr, int wc, int fr, int fq) const {
        const rsrc_t ra = mkrsrc(GA), rb = mkrsrc(GB);
        const unsigned sb = ((unsigned)(u.pm * BM + wr * 64) * 1024 + u.pn * BM + wc * 32) * 2, voff = (unsigned)(fr * 1024 + 8 * fq) * 2u;
#pragma unroll
        for (int ai = 0; ai < 2; ++ai)
#pragma unroll
            for (int m = 0; m < 4; ++m) {
#pragma unroll
                for (int bj = 0; bj < 2; ++bj) { const unsigned so = sb + (unsigned)(ai * HALF + m * 16) * 2048 + bj * 256;
                    const u32x4 ga = bld16(ra, voff, so), gb = bld16(rb, voff, so); f32x4 a0, a1, b0, b1; unpack8(ga, a0, a1); unpack8(gb, b0, b1);
#pragma unroll
                    for (int j = 0; j < 4; ++j) { acc[ai][bj][m][0][j] *= a0[j] * __builtin_amdgcn_rcpf(fmaxf(b0[j], 1e-30f)); acc[ai][bj][m][1][j] *= a1[j] * __builtin_amdgcn_rcpf(fmaxf(b1[j], 1e-30f)); } }
                asm volatile("" ::: "memory"); }
    }
    __device__ __forceinline__ void operator()(const f32x4 (&acc)[2][2][4][2], const Unit& u, int wr, int wc, int fr, int fq) const {
        const rsrc_t rb = mkrsrc(GB), ro = mkrsrc(Mo);
        const unsigned sb = ((unsigned)(u.pm * BM + wr * 64) * 1024 + u.pn * BM + wc * 32) * 2, voff = (unsigned)(fr * 1024 + 8 * fq) * 2u;
#pragma unroll
        for (int ai = 0; ai < 2; ++ai)
#pragma unroll
            for (int m = 0; m < 4; ++m) {
#pragma unroll
                for (int bj = 0; bj < 2; ++bj) { const unsigned so = sb + (unsigned)(ai * HALF + m * 16) * 2048 + bj * 256;
                    const u32x4 gb = bld16(rb, voff, so); f32x4 b0, b1; unpack8(gb, b0, b1);
                    bst16(ro, voff, so, pack8(acc[ai][bj][m][0] * b0, acc[ai][bj][m][1] * b1)); }
                asm volatile("" ::: "memory"); }
    }
};
struct EpiWo {
    static constexpr bool PERM = true, AFTER_DRAIN = false, MID = false;
    const float *xp, *xs; float* H; bf16_t* HB; float* part;
    __device__ __forceinline__ void mid(f32x4 (&)[2][2][4][2], const Unit&, int, int, int, int) const {}
    __device__ __forceinline__ void operator()(const f32x4 (&acc)[2][2][4][2], const Unit& u, int wr, int wc, int fr, int fq) const {
        const unsigned urow = u.pm * BM + wr * 64, ucol = u.pn * BM + wc * 32;
        const bool smp = u.pm >= 64;
        const rsrc_t rx = mkrsrc(smp ? xs : xp), rh = mkrsrc(H), rb = mkrsrc(HB);
        const unsigned ue = urow * 1024 + ucol, uex = (smp ? urow - 16384u : urow) * 1024 + ucol, ve = (unsigned)(fr * 1024 + 8 * fq);
        float* pq = part + (size_t)(urow + fr) * 16 + u.pn * 4 + wc;
#pragma unroll
        for (int ai = 0; ai < 2; ++ai)
#pragma unroll
            for (int m = 0; m < 4; ++m) { const unsigned ro = (unsigned)(ai * HALF + m * 16) * 1024; float ss = 0.f;
#pragma unroll
                for (int bj = 0; bj < 2; ++bj) {
                    const f32x4 h0 = as_f(bld16(rx, ve * 4u, (uex + ro) * 4u + bj * 512)) + acc[ai][bj][m][0], h1 = as_f(bld16(rx, ve * 4u, (uex + ro) * 4u + bj * 512 + 16)) + acc[ai][bj][m][1];
                    bst16(rh, ve * 4u, (ue + ro) * 4u + bj * 512, as_u(h0)); bst16(rh, ve * 4u, (ue + ro) * 4u + bj * 512 + 16, as_u(h1)); bst16(rb, ve * 2u, (ue + ro) * 2u + bj * 256, pack8(h0, h1));
                    ss += (h0[0] * h0[0] + h0[1] * h0[1]) + (h0[2] * h0[2] + h0[3] * h0[3]) + (h1[0] * h1[0] + h1[1] * h1[1]) + (h1[2] * h1[2] + h1[3] * h1[3]);
                    asm volatile("" ::: "memory"); }
                ss += __shfl_xor(ss, 16); ss += __shfl_xor(ss, 32);
                if (fq == 0) pq[(ai * HALF + m * 16) * 16] = ss;
                asm volatile("" ::: "memory"); }
    }
};
struct EpiPg {
    static constexpr bool PERM = true, AFTER_DRAIN = false, MID = false;
    float* H; const bf16_t* PE; const float* part;
    __device__ __forceinline__ void mid(f32x4 (&)[2][2][4][2], const Unit&, int, int, int, int) const {}
    __device__ __forceinline__ void operator()(const f32x4 (&acc)[2][2][4][2], const Unit& u, int wr, int wc, int fr, int fq) const {
        const unsigned urow = u.pm * BM + wr * 64, ucol = u.pn * BM + wc * 32;
        const rsrc_t rh = mkrsrc(H), rp = mkrsrc(PE);
        const unsigned ue = urow * 1024 + ucol, ve = (unsigned)(fr * 1024 + 8 * fq);
        const float* pq = part + (size_t)(urow + fr) * 16 + 4 * fq;
#pragma unroll
        for (int ai = 0; ai < 2; ++ai)
#pragma unroll
            for (int m = 0; m < 4; ++m) { const unsigned ro = (unsigned)(ai * HALF + m * 16) * 1024;
                float rs; { const f32x4 pv = *(const f32x4*)(pq + (ai * HALF + m * 16) * 16); rs = (pv[0] + pv[1]) + (pv[2] + pv[3]); rs += __shfl_xor(rs, 16); rs += __shfl_xor(rs, 32); }
                const float rstd = 1.0f / sqrtf(rs * (1.0f / 1024.0f) + 1e-6f);
#pragma unroll
                for (int bj = 0; bj < 2; ++bj) {
                    f32x4 h0 = as_f(bld16(rh, ve * 4u, (ue + ro) * 4u + bj * 512)), h1 = as_f(bld16(rh, ve * 4u, (ue + ro) * 4u + bj * 512 + 16)); const u32x4 pe = bld16(rp, ve * 2u, (ue + ro) * 2u + bj * 256); f32x4 p0, p1; unpack8(pe, p0, p1);
#pragma unroll
                    for (int j = 0; j < 4; ++j) { h0[j] += sigmoidf_(acc[ai][bj][m][0][j] * rstd) * p0[j]; h1[j] += sigmoidf_(acc[ai][bj][m][1][j] * rstd) * p1[j]; }
                    bst16(rh, ve * 4u, (ue + ro) * 4u + bj * 512, as_u(h0)); bst16(rh, ve * 4u, (ue + ro) * 4u + bj * 512 + 16, as_u(h1)); }
                asm volatile("" ::: "memory"); }
    }
};

template <class Epi, class Sched, bool ALIGN_EPI = false, bool SP2 = false>
__device__ __forceinline__ void gemm_phase(PG8_LAS unsigned char* lds, const Gemm g, const Sched& S, const Epi& E) {
    int tid = threadIdx.x; asm volatile("" : "+v"(tid));
    const int wid = __builtin_amdgcn_readfirstlane(tid >> 6), lane = tid & 63, wr = wid >> 2, wc = wid & 3, fr = lane & 15, fq = lane >> 4;
    const int K = g.K, nt = K / BK;
    unsigned voffA[2], voffB[2];
#pragma unroll
    for (int i = 0; i < 2; ++i) { int R, C; stage_rc(tid * 16 + i * 8192, R, C); const int Rb = Epi::PERM ? ((R & ~31) + perm32(R & 31)) : R;
        voffA[i] = (unsigned)(R * K + C) * 2u; voffB[i] = (unsigned)(Rb * K + C) * 2u; }
    const size_t kstep = (size_t)(BK * 2);
    const size_t hstep = (size_t)HALF * K * 2;
    const size_t tstep = 2 * hstep;
    const unsigned ldsw = (unsigned)wid * 1024u;
    const int aoff = lds_byte(wr * 64 + fr, fq * 8), boff = lds_byte(wc * 32 + fr, fq * 8);
#define PG8_SA(b, h) (((b) * 2 + (h)) * HTB)
#define PG8_SB(b, h) ((4 + (b) * 2 + (h)) * HTB)
#define PG8_STAGE(bufoff, gbase, voff) do { _Pragma("unroll") for (int _i = 0; _i < 2; ++_i) \
        __builtin_amdgcn_global_load_lds((const unsigned*)((const char*)(gbase) + (voff)[_i]), (PG8_LAS unsigned*)(lds + (bufoff) + ldsw + _i * 8192), 16, 0, 0); } while (0)
#define PG8_LDA(dst, b, h) do { _Pragma("unroll") for (int m = 0; m < 4; ++m) _Pragma("unroll") for (int k = 0; k < 2; ++k) dst[m][k] = *(const PG8_LAS bf16x8*)(lds + PG8_SA(b, h) + aoff + m * 2048 + k * 1024); } while (0)
#define PG8_LDB(dst, b, h) do { _Pragma("unroll") for (int n = 0; n < 2; ++n) _Pragma("unroll") for (int k = 0; k < 2; ++k) dst[n][k] = *(const PG8_LAS bf16x8*)(lds + PG8_SB(b, h) + boff + n * 2048 + k * 1024); } while (0)
#define PG8_MMA(ai, bj, At, Bt) do { __builtin_amdgcn_s_setprio(1); _Pragma("unroll") for (int m = 0; m < 4; ++m) _Pragma("unroll") for (int n = 0; n < 2; ++n) _Pragma("unroll") for (int k = 0; k < 2; ++k) \
        acc[ai][bj][m][n] = __builtin_amdgcn_mfma_f32_16x16x32_bf16(Bt[n][k], At[m][k], acc[ai][bj][m][n], 0, 0, 0); __builtin_amdgcn_s_setprio(0); } while (0)
#define PG8_WAIT_V(n) asm volatile("s_waitcnt vmcnt(" #n ")" ::: "memory")
#define PG8_WAIT_L(n) asm volatile("s_waitcnt lgkmcnt(" #n ")" ::: "memory")
#define PG8_BAR __builtin_amdgcn_s_barrier()
#define PG8_SCHED __builtin_amdgcn_sched_barrier(0)
    Unit cur, nxt; int ui = 0;
    if (!S.next(0, cur)) return;
    f32x4 acc[2][2][4][2];
#pragma unroll
    for (int a = 0; a < 2; ++a)
#pragma unroll
        for (int b = 0; b < 2; ++b)
#pragma unroll
            for (int m = 0; m < 4; ++m)
#pragma unroll
                for (int n = 0; n < 2; ++n) acc[a][b][m][n] = (f32x4){0.f, 0.f, 0.f, 0.f};
    bf16x8 At[4][2], B0[2][2], B1[2][2];
    const char* cA = (const char*)g.A + (size_t)cur.pm * tstep; const char* cB = (const char*)g.Bt + (size_t)cur.pn * tstep;
    S.a_ready(cur);
    if constexpr (SP2) {
        PG8_STAGE(PG8_SB(0, 0), cB, voffB); PG8_STAGE(PG8_SB(0, 1), cB + hstep, voffB); PG8_STAGE(PG8_SA(0, 0), cA, voffA); PG8_STAGE(PG8_SA(0, 1), cA + hstep, voffA);
        if (wr == 1) PG8_BAR;
        PG8_WAIT_V(2); PG8_BAR;
        PG8_STAGE(PG8_SB(1, 0), cB + kstep, voffB); PG8_STAGE(PG8_SA(1, 0), cA + kstep, voffA); PG8_STAGE(PG8_SB(1, 1), cB + hstep + kstep, voffB);
        PG8_WAIT_V(6); PG8_BAR;
    } else {
        PG8_STAGE(PG8_SB(0, 0), cB, voffB); PG8_STAGE(PG8_SA(0, 0), cA, voffA); PG8_STAGE(PG8_SB(0, 1), cB + hstep, voffB); PG8_STAGE(PG8_SA(0, 1), cA + hstep, voffA);
        if (wr == 1) PG8_BAR;
        PG8_WAIT_V(4); PG8_BAR;
        PG8_STAGE(PG8_SB(1, 0), cB + kstep, voffB); PG8_STAGE(PG8_SA(1, 0), cA + kstep, voffA); PG8_STAGE(PG8_SB(1, 1), cB + hstep + kstep, voffB);
        PG8_WAIT_V(6); PG8_BAR;
    }
    for (;;) {
        const bool has_next = S.next(ui + 1, nxt);
        const char* nA = has_next ? (const char*)g.A + (size_t)nxt.pm * tstep : cA; const char* nB = has_next ? (const char*)g.Bt + (size_t)nxt.pn * tstep : cB;
        for (int th = 0; th < (Epi::MID ? 2 : 1); ++th) {
        if constexpr (Epi::MID) { if (th == 1) E.mid(acc, cur, wr, wc, fr, fq); }
        const int t_lo = Epi::MID ? th * (nt >> 1) : 0, t_hi = Epi::MID ? (th + 1) * (nt >> 1) : nt;
#pragma unroll 1
        for (int t = t_lo; t < t_hi; t += 2) {
            const bool last = (t == nt - 2);
            const char* a1 = cA + (size_t)(t + 1) * kstep;
            const char* a2 = last ? nA : cA + (size_t)(t + 2) * kstep; const char* b2 = last ? nB : cB + (size_t)(t + 2) * kstep;
            const char* a3 = a2 + kstep; const char* b3 = b2 + kstep;
            if (last && has_next) S.a_ready(nxt);
            if constexpr (SP2) {
            PG8_LDB(B0, 0, 0); PG8_LDB(B1, 0, 1); PG8_SCHED; PG8_LDA(At, 0, 0); PG8_STAGE(PG8_SA(1, 1), a1 + hstep, voffA);
            PG8_WAIT_V(8); PG8_WAIT_L(0); PG8_BAR; PG8_MMA(0, 0, At, B0); PG8_MMA(0, 1, At, B1); PG8_BAR; PG8_SCHED;
            PG8_LDA(At, 0, 1); PG8_STAGE(PG8_SB(0, 0), b2, voffB); PG8_STAGE(PG8_SB(0, 1), b2 + hstep, voffB); PG8_STAGE(PG8_SA(0, 0), a2, voffA);
            PG8_WAIT_V(8); PG8_WAIT_L(0); PG8_BAR; PG8_MMA(1, 0, At, B0); PG8_MMA(1, 1, At, B1); PG8_BAR; PG8_SCHED;
            PG8_LDB(B0, 1, 0); PG8_LDB(B1, 1, 1); PG8_SCHED; PG8_LDA(At, 1, 0); PG8_STAGE(PG8_SA(0, 1), a2 + hstep, voffA);
            PG8_WAIT_V(8); PG8_WAIT_L(0); PG8_BAR; PG8_MMA(0, 0, At, B0); PG8_MMA(0, 1, At, B1); PG8_BAR; PG8_SCHED;
            PG8_LDA(At, 1, 1); PG8_STAGE(PG8_SB(1, 0), b3, voffB); PG8_STAGE(PG8_SB(1, 1), b3 + hstep, voffB); PG8_STAGE(PG8_SA(1, 0), a3, voffA);
            PG8_WAIT_V(8); PG8_WAIT_L(0); PG8_BAR; PG8_MMA(1, 0, At, B0); PG8_MMA(1, 1, At, B1); PG8_BAR; PG8_SCHED;
            } else {
            PG8_LDB(B0, 0, 0); PG8_SCHED; PG8_LDA(At, 0, 0); PG8_STAGE(PG8_SA(1, 1), a1 + hstep, voffA);
            PG8_WAIT_L(8); PG8_BAR; PG8_WAIT_L(0); PG8_MMA(0, 0, At, B0); PG8_BAR; PG8_SCHED;
            PG8_LDB(B1, 0, 1); PG8_STAGE(PG8_SB(0, 0), b2, voffB);
            PG8_BAR; PG8_WAIT_L(0); PG8_MMA(0, 1, At, B1); PG8_BAR;
            PG8_LDA(At, 0, 1); PG8_STAGE(PG8_SA(0, 0), a2, voffA);
            PG8_BAR; PG8_WAIT_L(0); PG8_MMA(1, 0, At, B0); PG8_BAR; PG8_SCHED;
            PG8_STAGE(PG8_SB(0, 1), b2 + hstep, voffB);
            PG8_WAIT_V(6); PG8_BAR; PG8_MMA(1, 1, At, B1); PG8_BAR;
            PG8_LDB(B0, 1, 0); PG8_SCHED; PG8_LDA(At, 1, 0); PG8_STAGE(PG8_SA(0, 1), a2 + hstep, voffA);
            PG8_WAIT_L(8); PG8_BAR; PG8_WAIT_L(0); PG8_MMA(0, 0, At, B0); PG8_BAR; PG8_SCHED;
            PG8_LDB(B1, 1, 1); PG8_STAGE(PG8_SB(1, 0), b3, voffB);
            PG8_BAR; PG8_WAIT_L(0); PG8_MMA(0, 1, At, B1); PG8_BAR;
            PG8_LDA(At, 1, 1); PG8_STAGE(PG8_SA(1, 0), a3, voffA);
            PG8_BAR; PG8_WAIT_L(0); PG8_MMA(1, 0, At, B0); PG8_BAR; PG8_SCHED;
            PG8_STAGE(PG8_SB(1, 1), b3 + hstep, voffB);
            PG8_WAIT_V(6); PG8_BAR; PG8_MMA(1, 1, At, B1); PG8_BAR;
            }
        }
        }
        if constexpr (ALIGN_EPI) { if (wr == 0) PG8_BAR; }
        if constexpr (!Epi::AFTER_DRAIN) { E(acc, cur, wr, wc, fr, fq); S.done(cur); }
        if (!has_next) break;
#pragma unroll
        for (int a = 0; a < 2; ++a)
#pragma unroll
            for (int b = 0; b < 2; ++b)
#pragma unroll
                for (int m = 0; m < 4; ++m)
#pragma unroll
                    for (int n = 0; n < 2; ++n) acc[a][b][m][n] = (f32x4){0.f, 0.f, 0.f, 0.f};
        cur = nxt; cA = nA; cB = nB; ++ui;
        if constexpr (ALIGN_EPI) { if (wr == 1) PG8_BAR; }
    }
    PG8_WAIT_V(0);
    if constexpr (!ALIGN_EPI) { if (wr == 0) PG8_BAR; }
    PG8_BAR;
#undef PG8_SA
#undef PG8_SB
#undef PG8_STAGE
#undef PG8_LDA
#undef PG8_LDB
#undef PG8_MMA
#undef PG8_WAIT_V
#undef PG8_WAIT_L
#undef PG8_BAR
#undef PG8_SCHED
}
}

#ifndef PG8_SP2
#define PG8_SP2 true
#endif
#ifndef PG8_ALIGN
#define PG8_ALIGN true
#endif

constexpr int NWAVES = 8;
constexpr int DM = 1024, NP = 16384, NS = 1024, T = NP + NS, SEQ = 2048, DSEQ = 8, DIN = 9216, PLE = 256;
constexpr float EPS = 1e-6f, LN_EPS = 1e-5f;
constexpr size_t OFF_NAP = (size_t)T * DM, OFF_NBP = OFF_NAP + 8 * 2 * 1024, OFF_NAS = OFF_NBP + 8 * 30 * 1024, OFF_NBS = OFF_NAS + 128 * 2 * 1024;
constexpr size_t MiB = 1u << 20;
constexpr size_t WS_CTL = 0, CTL_ZERO_BYTES = 64 * 1024;
constexpr size_t WS_WIN = 2 * MiB, WS_WAB = 20 * MiB, WS_WO = 24 * MiB, WS_WPG = 26 * MiB, WS_WPE = 28 * MiB;
constexpr size_t WS_PB = 29 * MiB;
constexpr size_t WS_XB = 38 * MiB;
constexpr size_t WS_QZ = 72 * MiB;
constexpr size_t WS_S = 140 * MiB;
constexpr size_t WS_V = 174 * MiB;
constexpr size_t WS_PART = 208 * MiB;
constexpr size_t WS_END = 210 * MiB;
constexpr int CW_BAR = 4096;
constexpr int RING_BYTES = 131072, LDSCTL_OFF = RING_BYTES, MISC_OFF = LDSCTL_OFF + 320, LDS_BYTES = 147456;

#define GAS __attribute__((address_space(1)))
#define LAS __attribute__((address_space(3)))
typedef unsigned short bf16;
typedef unsigned v4u __attribute__((ext_vector_type(4)));
typedef unsigned v2u __attribute__((ext_vector_type(2)));
typedef float f32x4 __attribute__((ext_vector_type(4)));
typedef float f32x2 __attribute__((ext_vector_type(2)));
#define LDS_WAIT() asm volatile("s_waitcnt lgkmcnt(0)" ::: "memory")
using pg8::cvt_pk_bf16; using pg8::bf_lo; using pg8::bf_hi; using pg8::sigmoidf_;

#define XB_TMO      128
#define XB_XCNT(j)  (256  + 64 * (j))
#define XB_XSUB(j)  (1280 + 64 * (j))
#define XB_XGEN(j)  (2304 + 64 * (j))
#define XB_TOP      3328
#define XB_TOPGEN   3392
#define XCD_BAR_WORDS 3456
#define XB_SPIN_CAP (1u << 18)
__device__ __forceinline__ unsigned xb_ld(unsigned* p)              { return __hip_atomic_load(p, __ATOMIC_RELAXED, __HIP_MEMORY_SCOPE_AGENT); }
__device__ __forceinline__ unsigned xb_add(unsigned* p, unsigned v) { return __hip_atomic_fetch_add(p, v, __ATOMIC_RELAXED, __HIP_MEMORY_SCOPE_AGENT); }
__device__ __forceinline__ unsigned xb_xcc_id() { return (unsigned)__builtin_amdgcn_s_getreg((3 << 11) | 20) & 0xFu; }
#define XB_SPIN(cond, bar) do { unsigned _sp = 0; while (cond) { __builtin_amdgcn_s_sleep(1); \
    if ((++_sp & 255u) == 0u) { if (xb_ld(&(bar)[XB_TMO])) break; if (_sp > XB_SPIN_CAP) { atomicAdd(&(bar)[XB_TMO], 1u); break; } } } } while (0)
struct XcdBarrier { unsigned* bar; unsigned x; volatile LAS unsigned* st; };
__device__ __forceinline__ XcdBarrier xcd_barrier_post(unsigned* bar, volatile LAS unsigned* st) {
    XcdBarrier b; b.bar = bar; b.x = xb_xcc_id(); b.st = st;
    if (threadIdx.x == 0) (void)xb_add(&bar[XB_XCNT(b.x)], 1u);
    return b;
}
__device__ __forceinline__ void xcd_barrier_complete(unsigned* bar, unsigned x, unsigned& nloc, unsigned& nx) {
    const unsigned G = gridDim.x * gridDim.y * gridDim.z;
    unsigned sum, cnt, mine, sp = 0u;
    for (;;) {
        sum = 0u; cnt = 0u; mine = 0u;
#pragma unroll
        for (unsigned j = 0; j < 16; ++j) { const unsigned c = xb_ld(&bar[XB_XCNT(j)]); sum += c; cnt += (c > 0u) ? 1u : 0u; mine = (j == x) ? c : mine; }
        if (sum == G) break;
        __builtin_amdgcn_s_sleep(1);
        if ((++sp & 255u) == 0u) { if (xb_ld(&bar[XB_TMO])) break; if (sp > XB_SPIN_CAP) { atomicAdd(&bar[XB_TMO], 1u); break; } }
    }
    nloc = mine > 0u ? mine : 1u; nx = cnt > 0u ? cnt : 1u;
}
__device__ __forceinline__ void xcd_barrier(const XcdBarrier& b) {
    asm volatile("s_waitcnt vmcnt(0)" ::: "memory");
    __syncthreads();
    if (threadIdx.x == 0) {
        unsigned* bar = b.bar;
        __builtin_amdgcn_s_waitcnt(0);
        unsigned nloc = b.st[0], nx = b.st[1];
        if (nloc == 0u) { xcd_barrier_complete(bar, b.x, nloc, nx); b.st[0] = nloc; b.st[1] = nx; }
        const unsigned old = xb_add(&bar[XB_XSUB(b.x)], 1u);
        const unsigned gen = old / nloc;
        if (old + 1u == (gen + 1u) * nloc) {
            __builtin_amdgcn_fence(__ATOMIC_RELEASE, "agent");
            asm volatile("s_waitcnt vmcnt(0)" ::: "memory");
            const unsigned og = xb_add(&bar[XB_TOP], 1u);
            const unsigned tg = og / nx;
            if (og + 1u == (tg + 1u) * nx) xb_add(&bar[XB_TOPGEN], 1u);
            else XB_SPIN(xb_ld(&bar[XB_TOPGEN]) == tg, bar);
            __builtin_amdgcn_fence(__ATOMIC_ACQUIRE, "agent");
            xb_add(&bar[XB_XGEN(b.x)], 1u);
            asm volatile("s_waitcnt vmcnt(0)" ::: "memory");
        } else {
            XB_SPIN(xb_ld(&bar[XB_XGEN(b.x)]) == gen, bar);
            __builtin_amdgcn_fence(__ATOMIC_ACQUIRE, "agent");
            asm volatile("s_waitcnt vmcnt(0)" ::: "memory");
        }
    }
    __syncthreads();
}

__device__ __forceinline__ float wave_sum(float v) {
#pragma unroll
    for (int o = 1; o < 64; o <<= 1) v += __shfl_xor(v, o);
    return v;
}

template <class RowMap>
__device__ __forceinline__ void p0_transpose_item(const float* W, int N, bf16* WT, int ldk, int koff, const float* gk, RowMap rm, LAS float* scr, int item, int lane) {
    const int nblk = N / 32, kb = item / nblk, nb = item % nblk, k0 = 64 * kb, n0 = 32 * nb;
#pragma unroll 8
    for (int i = 0; i < 32; ++i) { const int kk = 2 * i + (lane >> 5); float w = W[(size_t)(k0 + kk) * N + n0 + (lane & 31)]; if (gk) w *= gk[k0 + kk]; scr[kk * 33 + (lane & 31)] = w; }
    LDS_WAIT(); asm volatile("" ::: "memory");
    const int c = lane & 7;
#pragma unroll
    for (int j = 0; j < 4; ++j) { const int n = (lane >> 3) + 8 * j; const LAS float* s = scr + (8 * c) * 33 + n;
        v4u o; o.x = cvt_pk_bf16(s[0 * 33], s[1 * 33]); o.y = cvt_pk_bf16(s[2 * 33], s[3 * 33]); o.z = cvt_pk_bf16(s[4 * 33], s[5 * 33]); o.w = cvt_pk_bf16(s[6 * 33], s[7 * 33]);
        *(GAS v4u*)(WT + (size_t)rm(n0 + n) * ldk + koff + k0 + 8 * c) = o; }
    LDS_WAIT(); asm volatile("" ::: "memory");
}
struct RowId { __device__ __forceinline__ int operator()(int n) const { return n; } };
struct RowInProj { __device__ __forceinline__ int operator()(int sc) const {
    const int g = sc >> 10, ch = sc & 1023;
    if (g >= 6) return 256 * (24 + 4 * (g - 6) + (ch >> 8)) + (ch & 255);
    int base, isY;
    switch (g) { case 0: base = 0; isY = 0; break; case 3: base = 0; isY = 1; break; case 1: base = 8; isY = 0; break; case 2: base = 8; isY = 1; break; case 4: base = 16; isY = 0; break; default: base = 16; isY = 1; break; }
    const int cl = ch & 127, grp = cl >> 3, r8 = cl & 7, bj = r8 >> 2, j = r8 & 3;
    return 256 * (base + (ch >> 7)) + 128 * bj + 8 * grp + 4 * isY + j; } };

struct Ptrs {
    const float *x_p, *x_s, *st_a, *st_b, *p_p, *p_s, *g_mix, *w_in, *w_conv_a, *w_out_a, *w_conv_b, *b_conv_b, *ln_g, *ln_b, *w_out_b, *w_o, *w_pe, *g_ple, *w_pg, *g_final;
    float* out; unsigned char* ws;
};

typedef const __attribute__((address_space(4))) Ptrs* KPtrsT;
__device__ __forceinline__ Ptrs load_ptrs(KPtrsT k) {
    Ptrs P;
    P.x_p = k->x_p; P.x_s = k->x_s; P.st_a = k->st_a; P.st_b = k->st_b; P.p_p = k->p_p; P.p_s = k->p_s; P.g_mix = k->g_mix; P.w_in = k->w_in; P.w_conv_a = k->w_conv_a; P.w_out_a = k->w_out_a;
    P.w_conv_b = k->w_conv_b; P.b_conv_b = k->b_conv_b; P.ln_g = k->ln_g; P.ln_b = k->ln_b; P.w_out_b = k->w_out_b; P.w_o = k->w_o; P.w_pe = k->w_pe; P.g_ple = k->g_ple; P.w_pg = k->w_pg; P.g_final = k->g_final;
    P.out = k->out; P.ws = k->ws; return P;
}
__device__ __forceinline__ void p0_prologue(const Ptrs& P, LAS unsigned char* lds, int gw, int NGW, int lane, int wave) {
    LAS float* scr = (LAS float*)(lds + wave * 16384);
    bf16* Wt_in = (bf16*)(P.ws + WS_WIN); bf16* Wt_ab = (bf16*)(P.ws + WS_WAB); bf16* Wt_o = (bf16*)(P.ws + WS_WO); bf16* Wt_pg = (bf16*)(P.ws + WS_WPG); bf16* Wt_pe = (bf16*)(P.ws + WS_WPE);
    constexpr int I_IN = (DM / 64) * (DIN / 32), I_SQ = (DM / 64) * (DM / 32), I_PE = (PLE / 64) * (DM / 32);
    constexpr int NITEMS = I_IN + 4 * I_SQ + I_PE;
    for (int it = gw; it < NITEMS; it += NGW) {
        int r = it;
        if (r < I_IN) { p0_transpose_item(P.w_in, DIN, Wt_in, DM, 0, P.g_mix, RowInProj(), scr, r, lane); continue; } r -= I_IN;
        if (r < I_SQ) { p0_transpose_item(P.w_out_a, DM, Wt_ab, 2 * DM, 0, nullptr, RowId(), scr, r, lane); continue; } r -= I_SQ;
        if (r < I_SQ) { p0_transpose_item(P.w_out_b, DM, Wt_ab, 2 * DM, DM, nullptr, RowId(), scr, r, lane); continue; } r -= I_SQ;
        if (r < I_SQ) { p0_transpose_item(P.w_o, DM, Wt_o, DM, 0, nullptr, RowId(), scr, r, lane); continue; } r -= I_SQ;
        if (r < I_SQ) { p0_transpose_item(P.w_pg, DM, Wt_pg, DM, 0, P.g_ple, RowId(), scr, r, lane); continue; } r -= I_SQ;
        p0_transpose_item(P.w_pe, DM, Wt_pe, PLE, 0, nullptr, RowId(), scr, r, lane);
    }
    bf16* XB = (bf16*)(P.ws + WS_XB); bf16* PB = (bf16*)(P.ws + WS_PB);
    for (int m = gw; m < T; m += NGW) {
        const float* xrow = m < NP ? P.x_p + (size_t)m * DM : P.x_s + (size_t)(m - NP) * DM;
        const GAS f32x4* xr = (const GAS f32x4*)xrow + lane;
        f32x4 v[4]; float s = 0.f;
#pragma unroll
        for (int j = 0; j < 4; ++j) { v[j] = xr[64 * j]; s += (v[j].x * v[j].x + v[j].y * v[j].y) + (v[j].z * v[j].z + v[j].w * v[j].w); }
        const float rstd = 1.0f / sqrtf(wave_sum(s) * (1.0f / DM) + EPS);
        GAS v2u* o8 = (GAS v2u*)(XB + (size_t)m * DM) + lane;
#pragma unroll
        for (int j = 0; j < 4; ++j) { v2u w; w.x = cvt_pk_bf16(v[j].x * rstd, v[j].y * rstd); w.y = cvt_pk_bf16(v[j].z * rstd, v[j].w * rstd); o8[64 * j] = w; }
        const float* prow = m < NP ? P.p_p + (size_t)m * PLE : P.p_s + (size_t)(m - NP) * PLE;
        const f32x4 pv = ((const GAS f32x4*)prow)[lane];
        v2u w; w.x = cvt_pk_bf16(pv.x, pv.y); w.y = cvt_pk_bf16(pv.z, pv.w);
        ((GAS v2u*)(PB + (size_t)m * PLE))[lane] = w;
    }
}

using pg8::rsrc_t; using pg8::mkrsrc;
__device__ __forceinline__ unsigned bld4(rsrc_t r, unsigned voff, unsigned soff) { return __builtin_amdgcn_raw_buffer_load_b32(r, (int)voff, (int)soff, 0); }
__device__ __forceinline__ void bst4(rsrc_t r, unsigned voff, unsigned soff, unsigned v) { __builtin_amdgcn_raw_buffer_store_b32(v, r, (int)voff, (int)soff, 0); }
__device__ __forceinline__ f32x2 bld8f(rsrc_t r, unsigned voff, unsigned soff) { return __builtin_bit_cast(f32x2, __builtin_amdgcn_raw_buffer_load_b64(r, (int)voff, (int)soff, 0)); }
__device__ __forceinline__ void bst8f(rsrc_t r, unsigned voff, unsigned soff, f32x2 v) { __builtin_amdgcn_raw_buffer_store_b64(__builtin_bit_cast(v2u, v), r, (int)voff, (int)soff, 0); }
__device__ __forceinline__ f32x2 up2(unsigned u) { return (f32x2){bf_lo(u), bf_hi(u)}; }
using pg8::bld16; using pg8::bst16; using pg8::u32x4; using pg8::pack8; using pg8::unpack8; using pg8::as_f; using pg8::as_u;
template <int NTW>
__device__ __forceinline__ void p2_ln_part(const Ptrs& P, LAS unsigned char* lds, rsrc_t rQZ, unsigned R0, int lane, int wave) {
    f32x4 lg[4], lb[4];
#pragma unroll
    for (int h = 0; h < 2; ++h)
#pragma unroll
        for (int q = 0; q < 2; ++q) { lg[2 * h + q] = *(const f32x4*)(P.ln_g + h * 512 + lane * 8 + q * 4); lb[2 * h + q] = *(const f32x4*)(P.ln_b + h * 512 + lane * 8 + q * 4); }
    const LAS f32x4* cl4 = (const LAS f32x4*)lds;
    const unsigned vz = (unsigned)lane * 16u;
#pragma unroll 1
    for (int ii = 0; ii < NTW; ++ii) { const int i = wave * NTW + ii;
        f32x4 x[4]; float s = 0.f;
#pragma unroll
        for (int h = 0; h < 2; ++h)
#pragma unroll
            for (int q = 0; q < 2; ++q) { x[2 * h + q] = cl4[i * 256 + h * 128 + lane * 2 + q]; s += (x[2 * h + q].x + x[2 * h + q].y) + (x[2 * h + q].z + x[2 * h + q].w); }
        const float mean = wave_sum(s) * (1.0f / 1024.0f); float qq = 0.f;
#pragma unroll
        for (int j = 0; j < 4; ++j) { x[j] = x[j] - mean; qq += (x[j].x * x[j].x + x[j].y * x[j].y) + (x[j].z * x[j].z + x[j].w * x[j].w); }
        const float rstd = 1.0f / sqrtf(wave_sum(qq) * (1.0f / 1024.0f) + LN_EPS);
        const unsigned so = (R0 + i) * 4096u + 2048u;
#pragma unroll
        for (int h = 0; h < 2; ++h) { const u32x4 z = bld16(rQZ, vz, so + h * 1024); f32x4 z0, z1; unpack8(z, z0, z1);
            f32x4 y0 = x[2 * h] * rstd * lg[2 * h] + lb[2 * h], y1 = x[2 * h + 1] * rstd * lg[2 * h + 1] + lb[2 * h + 1];
#pragma unroll
            for (int j = 0; j < 4; ++j) { y0[j] = y0[j] * sigmoidf_(y0[j]) * z0[j]; y1[j] = y1[j] * sigmoidf_(y1[j]) * z1[j]; }
            bst16(rQZ, vz, so + h * 1024, pack8(y0, y1)); }
    }
}
__device__ __forceinline__ void p2_tile_prompt(const Ptrs& P, LAS unsigned char* lds, int tile, int tid, int lane, int wave) {
    const rsrc_t rQZ = mkrsrc(P.ws + WS_QZ), rS = mkrsrc(P.ws + WS_S), rWb = mkrsrc(P.w_conv_b), rOut = mkrsrc(P.out);
    const unsigned b = tile >> 6, t0 = (tile & 63) * 32, R0 = b * SEQ + t0;
    const bool lastt = (t0 == SEQ - 32), first = (t0 == 0);
    {
        const unsigned char* Vb = P.ws + WS_V;
#pragma unroll 1
        for (int hr = wave; hr < 124; hr += 8) { const int row = hr >> 1, half = hr & 1;
            if (first && row < 30) { *(LAS u32x4*)(lds + row * 2048 + half * 1024 + lane * 16) = (u32x4){0u, 0u, 0u, 0u}; }
            else __builtin_amdgcn_global_load_lds((const unsigned*)(Vb + (size_t)(R0 - 30 + row) * 2048 + half * 1024 + lane * 16), (LAS unsigned*)(lds + row * 2048 + half * 1024), 16, 0, 0); }
    }
    {
        const unsigned cg = tid & 127, tq = tid >> 7, vo = cg * 16u, r0 = R0 + tq * 8;
        f32x4 w0[2], w1[2], w2[2];
#pragma unroll
        for (int q = 0; q < 2; ++q) { w0[q] = *(const f32x4*)(P.w_conv_a + cg * 8 + q * 4); w1[q] = *(const f32x4*)(P.w_conv_a + 1024 + cg * 8 + q * 4); w2[q] = *(const f32x4*)(P.w_conv_a + 2048 + cg * 8 + q * 4); }
        u32x4 sr[10];
#pragma unroll
        for (int i = 0; i < 10; ++i) { const bool neg = first && tq == 0 && i < 2; sr[i] = bld16(rS, vo, neg ? 0u : (r0 - 2 + i) * 2048u); if (neg) sr[i] = (u32x4){0u, 0u, 0u, 0u}; }
        u32x4 qr[8];
#pragma unroll
        for (int i = 0; i < 8; ++i) qr[i] = bld16(rQZ, vo, (r0 + i) * 4096u);
#pragma unroll
        for (int i = 0; i < 8; ++i) { f32x4 a0, a1, b0, b1, c0, c1, q0, q1; unpack8(sr[i], a0, a1); unpack8(sr[i + 1], b0, b1); unpack8(sr[i + 2], c0, c1); unpack8(qr[i], q0, q1);
            const f32x4 y0 = q0 * (w0[0] * a0 + w1[0] * b0 + w2[0] * c0), y1 = q1 * (w0[1] * a1 + w1[1] * b1 + w2[1] * c1);
            bst16(rQZ, vo, (r0 + i) * 4096u, pack8(y0, y1)); }
        if (lastt && tq == 3) {
#pragma unroll
            for (int j = 0; j < 2; ++j) { f32x4 a0, a1; unpack8(sr[8 + j], a0, a1);
                bst16(rOut, cg * 32u, (unsigned)(OFF_NAP + (size_t)(b * 2 + j) * 1024) * 4u, as_u(a0)); bst16(rOut, cg * 32u, (unsigned)(OFF_NAP + (size_t)(b * 2 + j) * 1024) * 4u + 16u, as_u(a1)); } }
    }
    asm volatile("s_waitcnt vmcnt(0)" ::: "memory");
    __syncthreads();
    {
        const unsigned v8 = (unsigned)tid * 8u;
        const f32x2 bias = *(const f32x2*)(P.b_conv_b + 2 * tid);
        f32x2 win[62];
#pragma unroll
        for (int i = 0; i < 62; ++i) win[i] = up2(*(const LAS unsigned*)(lds + i * 2048 + tid * 4));
        asm volatile("s_waitcnt lgkmcnt(0)" ::: "memory");
        __syncthreads();
        LAS f32x2* cl2 = (LAS f32x2*)lds;
#pragma unroll
        for (int hh = 0; hh < 2; ++hh) {
            f32x2 c[16];
#pragma unroll
            for (int i = 0; i < 16; ++i) c[i] = bias;
#pragma unroll
            for (int k = 0; k < 31; ++k) { const f32x2 w = bld8f(rWb, v8, k * 4096u);
#pragma unroll
                for (int i = 0; i < 16; ++i) c[i] += w * win[hh * 16 + i + k]; }
#pragma unroll
            for (int i = 0; i < 16; ++i) cl2[(hh * 16 + i) * 512 + tid] = c[i];
        }
        if (lastt) {
#pragma unroll
            for (int j = 0; j < 30; ++j) bst8f(rOut, v8, (unsigned)(OFF_NBP + (size_t)(b * 30 + j) * 1024) * 4u, win[32 + j]); }
    }
    __syncthreads();
    p2_ln_part<4>(P, lds, rQZ, R0, lane, wave);
    __syncthreads();
}
__device__ __forceinline__ void p2_seq_sample(const Ptrs& P, LAS unsigned char* lds, int n, int tid, int lane, int wave) {
    const rsrc_t rQZ = mkrsrc(P.ws + WS_QZ), rS = mkrsrc(P.ws + WS_S), rV = mkrsrc(P.ws + WS_V), rWb = mkrsrc(P.w_conv_b), rOut = mkrsrc(P.out);
    const rsrc_t rSa = mkrsrc(P.st_a), rSb = mkrsrc(P.st_b);
    const unsigned v4 = (unsigned)tid * 4u, v8 = (unsigned)tid * 8u, r0 = NP + n * DSEQ;
    LAS f32x2* cl2 = (LAS f32x2*)lds;
    const f32x2 wA0 = *(const f32x2*)(P.w_conv_a + 2 * tid), wA1 = *(const f32x2*)(P.w_conv_a + 1024 + 2 * tid), wA2 = *(const f32x2*)(P.w_conv_a + 2048 + 2 * tid);
    const f32x2 bias = *(const f32x2*)(P.b_conv_b + 2 * tid);
    {
        f32x2 sw[10];
#pragma unroll
        for (int i = 0; i < 2; ++i) sw[i] = bld8f(rSa, v8, (n * 2 + i) * 4096u);
#pragma unroll
        for (int i = 0; i < 8; ++i) sw[2 + i] = up2(bld4(rS, v4, (r0 + i) * 2048u));
#pragma unroll
        for (int i = 0; i < 8; ++i) { const f32x2 q = up2(bld4(rQZ, v4, (r0 + i) * 4096u));
            const f32x2 cv = wA0 * sw[i] + wA1 * sw[i + 1] + wA2 * sw[i + 2]; const f32x2 ya = q * cv; bst4(rQZ, v4, (r0 + i) * 4096u, cvt_pk_bf16(ya.x, ya.y)); }
#pragma unroll
        for (int j = 0; j < 2; ++j) bst8f(rOut, v8, (unsigned)(OFF_NAS + (size_t)(n * 2 + j) * 1024) * 4u, sw[8 + j]);
    }
    {
        f32x2 win[38];
#pragma unroll
        for (int i = 0; i < 30; ++i) win[i] = bld8f(rSb, v8, (n * 30 + i) * 4096u);
#pragma unroll
        for (int i = 0; i < 8; ++i) win[30 + i] = up2(bld4(rV, v4, (r0 + i) * 2048u));
        f32x2 c[8];
#pragma unroll
        for (int i = 0; i < 8; ++i) c[i] = bias;
#pragma unroll
        for (int k = 0; k < 31; ++k) { const f32x2 w = bld8f(rWb, v8, k * 4096u);
#pragma unroll
            for (int i = 0; i < 8; ++i) c[i] += w * win[i + k]; }
#pragma unroll
        for (int i = 0; i < 8; ++i) cl2[i * 512 + tid] = c[i];
#pragma unroll
        for (int j = 0; j < 30; ++j) bst8f(rOut, v8, (unsigned)(OFF_NBS + (size_t)(n * 30 + j) * 1024) * 4u, win[8 + j]);
    }
    __syncthreads();
    p2_ln_part<1>(P, lds, rQZ, r0, lane, wave);
    __syncthreads();
}

struct Args { Ptrs p; int ph_lo, ph_hi; };

__global__ void __launch_bounds__(NWAVES * 64, 2) fwd_megakernel(Args args) {
    extern __shared__ __attribute__((aligned(16))) unsigned char lds_raw[];
    LAS unsigned char* lds = (LAS unsigned char*)lds_raw;
    typedef const __attribute__((address_space(4))) Ptrs* KPtrs;
    const KPtrs Pk = (KPtrs)__builtin_amdgcn_kernarg_segment_ptr();
#define PHASE_PTRS() KPtrs Pq_ = Pk; asm volatile("" : "+s"(Pq_)); const Ptrs P = load_ptrs(Pq_); int tid = threadIdx.x; asm volatile("" : "+v"(tid)); const int lane = tid & 63; (void)lane
    const int tid0 = threadIdx.x, wave = __builtin_amdgcn_readfirstlane(tid0 >> 6);
    const int G = gridDim.x, bx = blockIdx.x;
    const int gw = bx * NWAVES + wave, NGW = G * NWAVES;
    volatile LAS unsigned* MISC = (volatile LAS unsigned*)(lds + MISC_OFF);
    for (int u = tid0; u < (LDS_BYTES - LDSCTL_OFF) / 4; u += NWAVES * 64) ((LAS unsigned*)(lds + LDSCTL_OFF))[u] = 0u;
    __syncthreads();
    unsigned* ctl;
    { PHASE_PTRS(); ctl = (unsigned*)(P.ws + WS_CTL); }
    XcdBarrier bar; bar.bar = ctl + CW_BAR; bar.x = 0; bar.st = nullptr;
#if !MK_PER_PHASE
    bar = xcd_barrier_post(ctl + CW_BAR, MISC + 8);
#endif
    const int lo = args.ph_lo, hi = args.ph_hi;
#define WSP(off) ((pg8::bf16_t*)(P.ws + (off)))

#define RUN0 { PHASE_PTRS(); p0_prologue(P, lds, gw, NGW, lane, wave); }
#define RUN1 { PHASE_PTRS(); \
            pg8::Gemm g{WSP(WS_XB), WSP(WS_WIN), T, DIN, DM}; pg8::StaticOrder S; S.init(T, DIN, G, bx); \
            pg8::EpiInProj E{WSP(WS_QZ), WSP(WS_S), WSP(WS_V), (pg8::bf16_t*)P.out, (pg8::bf16_t*)P.out + (size_t)T * DM}; \
            pg8::gemm_phase<pg8::EpiInProj, pg8::StaticOrder, PG8_ALIGN, PG8_SP2>(lds, g, S, E); }
#define RUN2 { PHASE_PTRS(); \
            for (int tile = bx; tile < 512; tile += G) p2_tile_prompt(P, lds, tile, tid, lane, wave); \
            for (int n = bx; n < 128; n += G) p2_seq_sample(P, lds, n, tid, lane, wave); }
#define RUN3 { PHASE_PTRS(); \
            pg8::Gemm g{WSP(WS_QZ), WSP(WS_WAB), T, DM, 2 * DM}; pg8::StaticOrder S; S.init(T, DM, G, bx); \
            pg8::EpiOutGate E{(const pg8::bf16_t*)P.out, (const pg8::bf16_t*)P.out + (size_t)T * DM, WSP(WS_S)}; \
            pg8::gemm_phase<pg8::EpiOutGate, pg8::StaticOrder, PG8_ALIGN, PG8_SP2>(lds, g, S, E); }
#define RUN4 { \
            { PHASE_PTRS(); pg8::Gemm g{WSP(WS_S), WSP(WS_WO), T, DM, DM}; pg8::StaticOrder S; S.init(T, DM, G, bx); \
              pg8::EpiWo E{P.x_p, P.x_s, P.out, WSP(WS_V), (float*)(P.ws + WS_PART)}; \
              pg8::gemm_phase<pg8::EpiWo, pg8::StaticOrder, PG8_ALIGN, PG8_SP2>(lds, g, S, E); } \
            { PHASE_PTRS(); pg8::Gemm g{WSP(WS_PB), WSP(WS_WPE), T, DM, PLE}; pg8::StaticOrder S; S.init(T, DM, G, bx); \
              pg8::EpiPlain E{WSP(WS_XB), DM}; \
              pg8::gemm_phase<pg8::EpiPlain, pg8::StaticOrder, PG8_ALIGN, PG8_SP2>(lds, g, S, E); } }
#define RUN5 { PHASE_PTRS(); \
            pg8::Gemm g{WSP(WS_V), WSP(WS_WPG), T, DM, DM}; pg8::StaticOrder S; S.init(T, DM, G, bx); \
            pg8::EpiPg E{P.out, WSP(WS_XB), (const float*)(P.ws + WS_PART)}; \
            pg8::gemm_phase<pg8::EpiPg, pg8::StaticOrder, PG8_ALIGN, PG8_SP2>(lds, g, S, E); }
#define RUN6 { PHASE_PTRS(); \
            float* H = P.out; \
            f32x4 gf[4]; \
            _Pragma("unroll") for (int j = 0; j < 4; ++j) gf[j] = *(const f32x4*)(P.g_final + j * 256 + lane * 4); \
            for (int m = gw; m < T; m += NGW) { \
                GAS f32x4* hr = (GAS f32x4*)(H + (size_t)m * DM) + lane; \
                f32x4 v[4]; float sq = 0.f; \
                _Pragma("unroll") for (int j = 0; j < 4; ++j) { v[j] = hr[64 * j]; sq += (v[j].x * v[j].x + v[j].y * v[j].y) + (v[j].z * v[j].z + v[j].w * v[j].w); } \
                const float rstd = 1.0f / sqrtf(wave_sum(sq) * (1.0f / DM) + EPS); \
                _Pragma("unroll") for (int j = 0; j < 4; ++j) hr[64 * j] = v[j] * rstd * gf[j]; \
            } }
#ifndef PROG_STEPS
#define PROG_STEPS X(0) X(1) X(2) X(3) X(4) X(5) X(6)
#endif
    enum { STEP_BASE = __COUNTER__ + 1 };
#if MK_PER_PHASE
#define X(k) { const int si_ = __COUNTER__ - STEP_BASE; if (lo == si_) RUN##k }
#else
#define X(k) { const int si_ = __COUNTER__ - STEP_BASE; if (si_ > 0) xcd_barrier(bar); RUN##k }
#endif
    PROG_STEPS
#undef X
#undef WSP
}

extern "C" void kernel_launch(void* const* d_in, const int* in_sizes, int n_in, void* d_out, int out_size, void* d_ws, size_t ws_size, hipStream_t stream) {
    static int grid = 0;
    if (grid == 0) {
        if (n_in != 20 || ws_size < WS_END) { fprintf(stderr, "kernel_launch: unexpected n_in %d / ws %zu\n", n_in, ws_size); grid = -1; return; }
        int dev = 0, cus = 0, per_cu = 0;
        if (hipGetDevice(&dev) != hipSuccess || hipDeviceGetAttribute(&cus, hipDeviceAttributeMultiprocessorCount, dev) != hipSuccess) { grid = -1; return; }
        if (hipFuncSetAttribute((const void*)fwd_megakernel, hipFuncAttributeMaxDynamicSharedMemorySize, LDS_BYTES) != hipSuccess) { fprintf(stderr, "kernel_launch: hipFuncSetAttribute failed\n"); grid = -1; return; }
        if (hipOccupancyMaxActiveBlocksPerMultiprocessor(&per_cu, (const void*)fwd_megakernel, NWAVES * 64, LDS_BYTES) != hipSuccess || per_cu < 1) { fprintf(stderr, "kernel_launch: occupancy query says %d\n", per_cu); (void)hipGetLastError(); per_cu = 1; }
        grid = cus;
    }
    if (grid < 0) return;
    (void)hipMemsetAsync((char*)d_ws + WS_CTL, 0, CTL_ZERO_BYTES, stream);
    Args a{};
    const float** pp = (const float**)&a.p;
    for (int i = 0; i < 20; ++i) pp[i] = (const float*)d_in[i];
    a.p.out = (float*)d_out; a.p.ws = (unsigned char*)d_ws;
#if MK_PER_PHASE
    for (int ph = 0; ph < 64; ++ph) { a.ph_lo = ph; a.ph_hi = ph + 1; hipLaunchKernelGGL(fwd_megakernel, dim3(grid), dim3(NWAVES * 64), LDS_BYTES, stream, a); }
#else
    a.ph_lo = 0; a.ph_hi = 64;
    void* kargs[] = {&a};
    hipError_t e = hipLaunchCooperativeKernel((const void*)fwd_megakernel, dim3(grid), dim3(NWAVES * 64), kargs, LDS_BYTES, stream);
    if (e != hipSuccess) fprintf(stderr, "kernel_launch: cooperative launch failed: %s (grid %d)\n", hipGetErrorString(e), grid);
#endif
}
```

```cpp
#include <hip/hip_runtime.h>
#include <cstdio>
#include <cstdint>

#ifndef MK_PER_PHASE
#define MK_PER_PHASE 0
#endif

namespace pg8 {
#define PG8_LAS __attribute__((address_space(3)))
typedef unsigned short bf16_t;
typedef short bf16x8 __attribute__((ext_vector_type(8)));
typedef float f32x4 __attribute__((ext_vector_type(4)));
typedef unsigned u32x4 __attribute__((ext_vector_type(4)));
typedef unsigned u32x2 __attribute__((ext_vector_type(2)));
constexpr int BM = 256, BK = 64, HALF = 128, HTB = HALF * BK * 2, STAGE_BYTES = 8 * HTB, NXCD = 8, WGM = 8;

__host__ __device__ __forceinline__ int lds_byte(int r, int c) { const int st = (r >> 4) * 2 + (c >> 5), rr = r & 15, cc = c & 31, ob = rr * 64 + cc * 2; return st * 1024 + (ob ^ (((ob >> 9) & 1) << 5)); }
__host__ __device__ __forceinline__ void stage_rc(int b, int& R, int& C) { const int st = b / 1024, sb = b % 1024, swz = sb ^ (((sb >> 9) & 1) << 5); R = (st >> 1) * 16 + swz / 64; C = (st & 1) * 32 + (swz % 64) / 2; }
__host__ __device__ __forceinline__ int perm32(int rho) { const int n = rho >> 4, i = rho & 15; return 8 * (i >> 2) + 4 * n + (i & 3); }

struct Unit { int pm, pn; };
struct Gemm { const bf16_t* A; const bf16_t* Bt; int M, N, K; };

struct StaticOrder {
    int nM, nN, nwg, G, c, pm0;
    __host__ __device__ void init(int M, int N, int G_, int c_, int pm0_ = 0) { nM = M / BM; nN = N / BM; nwg = nM * nN; G = G_; c = c_; pm0 = pm0_; }
    __host__ __device__ bool next(int i, Unit& u) const {
        const long L = (long)i * G + c; if (c < 0 || L >= nwg) return false;
        int wgid = (int)L; { const int q = nwg / NXCD, r = nwg % NXCD, xcd = wgid % NXCD, off = wgid / NXCD; wgid = (xcd < r ? xcd * (q + 1) : r * (q + 1) + (xcd - r) * q) + off; }
        const int nig = WGM * nN, gid = wgid / nig, fm = gid * WGM, gsz = (nM - fm) < WGM ? (nM - fm) : WGM;
        u.pm = pm0 + fm + ((wgid % nig) % gsz); u.pn = (wgid % nig) / gsz; return true;
    }
    __device__ __forceinline__ void a_ready(const Unit&) const {}
    __device__ __forceinline__ void done(const Unit&) const {}
};

typedef __bf16 bf16x2_n __attribute__((ext_vector_type(2)));
typedef float f32x2_n __attribute__((ext_vector_type(2)));
__device__ __forceinline__ unsigned cvt_pk_bf16(float lo, float hi) { unsigned r; asm volatile("s_nop 0\n\tv_cvt_pk_bf16_f32 %0, %1, %2" : "=v"(r) : "v"(lo), "v"(hi)); return r; }
__device__ __forceinline__ float bf_lo(unsigned u) { return __uint_as_float(u << 16); }
__device__ __forceinline__ float bf_hi(unsigned u) { return __uint_as_float(u & 0xffff0000u); }
__device__ __forceinline__ float sigmoidf_(float x) { return __builtin_amdgcn_rcpf(1.0f + __expf(-x)); }
__device__ __forceinline__ u32x4 pack8(const f32x4 a, const f32x4 b) { u32x4 w; w.x = cvt_pk_bf16(a[0], a[1]); w.y = cvt_pk_bf16(a[2], a[3]); w.z = cvt_pk_bf16(b[0], b[1]); w.w = cvt_pk_bf16(b[2], b[3]); return w; }
__device__ __forceinline__ void unpack8(const u32x4 w, f32x4& a, f32x4& b) { a[0] = bf_lo(w.x); a[1] = bf_hi(w.x); a[2] = bf_lo(w.y); a[3] = bf_hi(w.y); b[0] = bf_lo(w.z); b[1] = bf_hi(w.z); b[2] = bf_lo(w.w); b[3] = bf_hi(w.w); }


typedef __amdgpu_buffer_rsrc_t rsrc_t;
__device__ __forceinline__ rsrc_t mkrsrc(const void* p) { return __builtin_amdgcn_make_buffer_rsrc(const_cast<void*>(p), 0, 0x7fffffff, 0x00020000); }
__device__ __forceinline__ u32x4 bld16(rsrc_t r, unsigned voff, unsigned soff) { return __builtin_amdgcn_raw_buffer_load_b128(r, (int)voff, (int)soff, 0); }
__device__ __forceinline__ void bst16(rsrc_t r, unsigned voff, unsigned soff, u32x4 v) { unsigned vo = voff + soff; asm volatile("" : "+v"(vo)); __builtin_amdgcn_raw_buffer_store_b128(v, r, (int)vo, 0, 0); }
__device__ __forceinline__ f32x4 as_f(u32x4 v) { return __builtin_bit_cast(f32x4, v); }
__device__ __forceinline__ u32x4 as_u(f32x4 v) { return __builtin_bit_cast(u32x4, v); }

struct EpiInProj {
    static constexpr bool PERM = true, AFTER_DRAIN = false, MID = false;
    bf16_t *QZ, *S, *V, *GA, *GB;
    __device__ __forceinline__ void mid(f32x4 (&)[2][2][4][2], const Unit&, int, int, int, int) const {}
    template <int TYPE> __device__ __forceinline__ void pair(const f32x4 (&acc)[2][2][4][2], rsrc_t r, unsigned sbase, unsigned voff, unsigned ldb) const {
#pragma unroll
        for (int ai = 0; ai < 2; ++ai)
#pragma unroll
            for (int m = 0; m < 4; ++m) {
                f32x4 o[2];
#pragma unroll
                for (int bj = 0; bj < 2; ++bj) { const f32x4 X = acc[ai][bj][m][0], Y = acc[ai][bj][m][1];
#pragma unroll
                    for (int j = 0; j < 4; ++j) { if (TYPE == 1) o[bj][j] = X[j] * Y[j]; else { const float sg = sigmoidf_(Y[j]); o[bj][j] = TYPE == 0 ? X[j] * Y[j] * sg : X[j] * sg; } } }
                bst16(r, voff, sbase + (unsigned)(ai * HALF + m * 16) * ldb, pack8(o[0], o[1]));
            }
    }
    template <int TYPE> __device__ __forceinline__ void single(const f32x4 (&acc)[2][2][4][2], rsrc_t r, unsigned sbase, unsigned voff, unsigned ldb) const {
#pragma unroll
        for (int ai = 0; ai < 2; ++ai)
#pragma unroll
            for (int m = 0; m < 4; ++m)
#pragma unroll
                for (int bj = 0; bj < 2; ++bj) { f32x4 v0 = acc[ai][bj][m][0], v1 = acc[ai][bj][m][1];
#pragma unroll
                    for (int j = 0; j < 4; ++j) { const float s0 = sigmoidf_(v0[j]), s1 = sigmoidf_(v1[j]); v0[j] = TYPE == 0 ? v0[j] * s0 : s0; v1[j] = TYPE == 0 ? v1[j] * s1 : s1; }
                    bst16(r, voff, sbase + (unsigned)(ai * HALF + m * 16) * ldb + bj * (HALF * 2), pack8(v0, v1)); }
    }
    __device__ __forceinline__ void operator()(const f32x4 (&acc)[2][2][4][2], const Unit& u, int wr, int wc, int fr, int fq) const {
        const unsigned urow = u.pm * BM + wr * 64, pn = u.pn;
        if (pn < 24) {
            const unsigned type = pn >> 3, ucb = (pn & 7) * 128 + 32 * wc;
            if (type == 0) pair<0>(acc, mkrsrc(QZ), (urow * 2048 + ucb) * 2, (unsigned)(fr * 2048 + 8 * fq) * 2u, 4096);
#if !defined(DBG_ONLYQZ)
            else if (type == 1) pair<1>(acc, mkrsrc(S), (urow * 1024 + ucb) * 2, (unsigned)(fr * 1024 + 8 * fq) * 2u, 2048);
            else pair<2>(acc, mkrsrc(V), (urow * 1024 + ucb) * 2, (unsigned)(fr * 1024 + 8 * fq) * 2u, 2048);
#endif
        } else {
            const unsigned t = (pn - 24) >> 2, ucb = ((pn - 24) & 3) * 256 + wc * 32;
            if (t == 0) single<0>(acc, mkrsrc(QZ), (urow * 2048 + 1024 + ucb) * 2, (unsigned)(fr * 2048 + 8 * fq) * 2u, 4096);
#if !defined(DBG_ONLYQZ)
            else if (t == 1) single<1>(acc, mkrsrc(GA), (urow * 1024 + ucb) * 2, (unsigned)(fr * 1024 + 8 * fq) * 2u, 2048);
            else single<1>(acc, mkrsrc(GB), (urow * 1024 + ucb) * 2, (unsigned)(fr * 1024 + 8 * fq) * 2u, 2048);
#endif
        }
    }
};
struct EpiPlain {
    static constexpr bool PERM = true, AFTER_DRAIN = false, MID = false;
    bf16_t* O; int ldc;
    __device__ __forceinline__ void mid(f32x4 (&)[2][2][4][2], const Unit&, int, int, int, int) const {}
    __device__ __forceinline__ void operator()(const f32x4 (&acc)[2][2][4][2], const Unit& u, int wr, int wc, int fr, int fq) const {
#if defined(DBG_DUMP) && DBG_DUMP == 2
        if (u.pn >= 8) return;
#endif
        const rsrc_t r = mkrsrc(O); const unsigned sb = ((unsigned)(u.pm * BM + wr * 64) * ldc + u.pn * BM + wc * 32) * 2, voff = (unsigned)(fr * ldc + 8 * fq) * 2u;
#pragma unroll
        for (int ai = 0; ai < 2; ++ai)
#pragma unroll
            for (int m = 0; m < 4; ++m)
#pragma unroll
                for (int bj = 0; bj < 2; ++bj) bst16(r, voff, sb + (unsigned)(ai * HALF + m * 16) * ldc * 2 + bj * (HALF * 2), pack8(acc[ai][bj][m][0], acc[ai][bj][m][1]));
    }
};
struct EpiOutGate {
    static constexpr bool PERM = true, AFTER_DRAIN = false, MID = true;
    const bf16_t *GA, *GB; bf16_t* Mo;
    __device__ __forceinline__ void mid(f32x4 (&acc)[2][2][4][2], const Unit& u, int wr, int wc, int fr, int fq) const {
        const rsrc_t ra = mkrsrc(GA), rb = mkrsrc(GB);
        const unsigned sb = ((unsigned)(u.pm * BM + wr * 64) * 1024 + u.pn * BM + wc * 32) * 2, voff = (unsigned)(fr * 1024 + 8 * fq) * 2u;
#pragma unroll
        for (int ai = 0; ai < 2; ++ai)
#pragma unroll
            for (int m = 0; m < 4; ++m) {
#pragma unroll
                for (int bj = 0; bj < 2; ++bj) { const unsigned so = sb + (unsigned)(ai * HALF + m * 16) * 2048 + bj * 256;
                    const u32x4 ga = bld16(ra, voff, so), gb = bld16(rb, voff, so); f32x4 a0, a1, b0, b1; unpack8(ga, a0, a1); unpack8(gb, b0, b1);
#pragma unroll
                    for (int j = 0; j < 4; ++j) { acc[ai][bj][m][0][j] *= a0[j] * __builtin_amdgcn_rcpf(fmaxf(b0[j], 1e-30f)); acc[ai][bj][m][1][j] *= a1[j] * __builtin_amdgcn_rcpf(fmaxf(b1[j], 1e-30f)); } }
                asm volatile("" ::: "memory"); }
    }
    __device__ __forceinline__ void operator()(const f32x4 (&acc)[2][2][4][2], const Unit& u, int wr, int wc, int fr, int fq) const {
        const rsrc_t rb = mkrsrc(GB), ro = mkrsrc(Mo);
        const unsigned sb = ((unsigned)(u.pm * BM + wr * 64) * 1024 + u.pn * BM + wc * 32) * 2, voff = (unsigned)(fr * 1024 + 8 * fq) * 2u;
#pragma unroll
        for (int ai = 0; ai < 2; ++ai)
#pragma unroll
            for (int m = 0; m < 4; ++m) {
#pragma unroll
                for (int bj = 0; bj < 2; ++bj) { const unsigned so = sb + (unsigned)(ai * HALF + m * 16) * 2048 + bj * 256;
                    const u32x4 gb = bld16(rb, voff, so); f32x4 b0, b1; unpack8(gb, b0, b1);
                    bst16(ro, voff, so, pack8(acc[ai][bj][m][0] * b0, acc[ai][bj][m][1] * b1)); }
                asm volatile("" ::: "memory"); }
    }
};
struct EpiWo {
    static constexpr bool PERM = true, AFTER_DRAIN = false, MID = false;
    const float *xp, *xs; float* H; bf16_t* HB; float* part;
    __device__ __forceinline__ void mid(f32x4 (&)[2][2][4][2], const Unit&, int, int, int, int) const {}
    __device__ __forceinline__ void operator()(const f32x4 (&acc)[2][2][4][2], const Unit& u, int wr, int wc, int fr, int fq) const {
        const unsigned urow = u.pm * BM + wr * 64, ucol = u.pn * BM + wc * 32;
        const bool smp = u.pm >= 64;
        const rsrc_t rx = mkrsrc(smp ? xs : xp), rh = mkrsrc(H), rb = mkrsrc(HB);
        const unsigned ue = urow * 1024 + ucol, uex = (smp ? urow - 16384u : urow) * 1024 + ucol, ve = (unsigned)(fr * 1024 + 8 * fq);
        float* pq = part + (size_t)(urow + fr) * 16 + u.pn * 4 + wc;
#pragma unroll
        for (int ai = 0; ai < 2; ++ai)
#pragma unroll
            for (int m = 0; m < 4; ++m) { const unsigned ro = (unsigned)(ai * HALF + m * 16) * 1024; float ss = 0.f;
#pragma unroll
                for (int bj = 0; bj < 2; ++bj) {
                    const f32x4 h0 = as_f(bld16(rx, ve * 4u, (uex + ro) * 4u + bj * 512)) + acc[ai][bj][m][0], h1 = as_f(bld16(rx, ve * 4u, (uex + ro) * 4u + bj * 512 + 16)) + acc[ai][bj][m][1];
                    bst16(rh, ve * 4u, (ue + ro) * 4u + bj * 512, as_u(h0)); bst16(rh, ve * 4u, (ue + ro) * 4u + bj * 512 + 16, as_u(h1)); bst16(rb, ve * 2u, (ue + ro) * 2u + bj * 256, pack8(h0, h1));
                    ss += (h0[0] * h0[0] + h0[1] * h0[1]) + (h0[2] * h0[2] + h0[3] * h0[3]) + (h1[0] * h1[0] + h1[1] * h1[1]) + (h1[2] * h1[2] + h1[3] * h1[3]);
                    asm volatile("" ::: "memory"); }
                ss += __shfl_xor(ss, 16); ss += __shfl_xor(ss, 32);
                if (fq == 0) pq[(ai * HALF + m * 16) * 16] = ss;
                asm volatile("" ::: "memory"); }
    }
};
struct EpiPg {
    static constexpr bool PERM = true, AFTER_DRAIN = false, MID = false;
    float* H; const bf16_t* PE; const float* part;
    __device__ __forceinline__ void mid(f32x4 (&)[2][2][4][2], const Unit&, int, int, int, int) const {}
    __device__ __forceinline__ void operator()(const f32x4 (&acc)[2][2][4][2], const Unit& u, int wr, int wc, int fr, int fq) const {
        const unsigned urow = u.pm * BM + wr * 64, ucol = u.pn * BM + wc * 32;
        const rsrc_t rh = mkrsrc(H), rp = mkrsrc(PE);
        const unsigned ue = urow * 1024 + ucol, ve = (unsigned)(fr * 1024 + 8 * fq);
        const float* pq = part + (size_t)(urow + fr) * 16 + 4 * fq;
#pragma unroll
        for (int ai = 0; ai < 2; ++ai)
#pragma unroll
            for (int m = 0; m < 4; ++m) { const unsigned ro = (unsigned)(ai * HALF + m * 16) * 1024;
                float rs; { const f32x4 pv = *(const f32x4*)(pq + (ai * HALF + m * 16) * 16); rs = (pv[0] + pv[1]) + (pv[2] + pv[3]); rs += __shfl_xor(rs, 16); rs += __shfl_xor(rs, 32); }
                const float rstd = 1.0f / sqrtf(rs * (1.0f / 1024.0f) + 1e-6f);
#pragma unroll
                for (int bj = 0; bj < 2; ++bj) {
                    f32x4 h0 = as_f(bld16(rh, ve * 4u, (ue + ro) * 4u + bj * 512)), h1 = as_f(bld16(rh, ve * 4u, (ue + ro) * 4u + bj * 512 + 16)); const u32x4 pe = bld16(rp, ve * 2u, (ue + ro) * 2u + bj * 256); f32x4 p0, p1; unpack8(pe, p0, p1);
#pragma unroll
                    for (int j = 0; j < 4; ++j) { h0[j] += sigmoidf_(acc[ai][bj][m][0][j] * rstd) * p0[j]; h1[j] += sigmoidf_(acc[ai][bj][m][1][j] * rstd) * p1[j]; }
                    bst16(rh, ve * 4u, (ue + ro) * 4u + bj * 512, as_u(h0)); bst16(rh, ve * 4u, (ue + ro) * 4u + bj * 512 + 16, as_u(h1)); }
                asm volatile("" ::: "memory"); }
    }
};

template <class Epi, class Sched, bool ALIGN_EPI = false, bool SP2 = false>
__device__ __forceinline__ void gemm_phase(PG8_LAS unsigned char* lds, const Gemm g, const Sched& S, const Epi& E) {
    int tid = threadIdx.x; asm volatile("" : "+v"(tid));
    const int wid = __builtin_amdgcn_readfirstlane(tid >> 6), lane = tid & 63, wr = wid >> 2, wc = wid & 3, fr = lane & 15, fq = lane >> 4;
    const int K = g.K, nt = K / BK;
    unsigned voffA[2], voffB[2];
#pragma unroll
    for (int i = 0; i < 2; ++i) { int R, C; stage_rc(tid * 16 + i * 8192, R, C); const int Rb = Epi::PERM ? ((R & ~31) + perm32(R & 31)) : R;
        voffA[i] = (unsigned)(R * K + C) * 2u; voffB[i] = (unsigned)(Rb * K + C) * 2u; }
    const size_t kstep = (size_t)(BK * 2);
    const size_t hstep = (size_t)HALF * K * 2;
    const size_t tstep = 2 * hstep;
    const unsigned ldsw = (unsigned)wid * 1024u;
    const int aoff = lds_byte(wr * 64 + fr, fq * 8), boff = lds_byte(wc * 32 + fr, fq * 8);
#define PG8_SA(b, h) (((b) * 2 + (h)) * HTB)
#define PG8_SB(b, h) ((4 + (b) * 2 + (h)) * HTB)
#define PG8_STAGE(bufoff, gbase, voff) do { _Pragma("unroll") for (int _i = 0; _i < 2; ++_i) \
        __builtin_amdgcn_global_load_lds((const unsigned*)((const char*)(gbase) + (voff)[_i]), (PG8_LAS unsigned*)(lds + (bufoff) + ldsw + _i * 8192), 16, 0, 0); } while (0)
#define PG8_LDA(dst, b, h) do { _Pragma("unroll") for (int m = 0; m < 4; ++m) _Pragma("unroll") for (int k = 0; k < 2; ++k) dst[m][k] = *(const PG8_LAS bf16x8*)(lds + PG8_SA(b, h) + aoff + m * 2048 + k * 1024); } while (0)
#define PG8_LDB(dst, b, h) do { _Pragma("unroll") for (int n = 0; n < 2; ++n) _Pragma("unroll") for (int k = 0; k < 2; ++k) dst[n][k] = *(const PG8_LAS bf16x8*)(lds + PG8_SB(b, h) + boff + n * 2048 + k * 1024); } while (0)
#define PG8_MMA(ai, bj, At, Bt) do { __builtin_amdgcn_s_setprio(1); _Pragma("unroll") for (int m = 0; m < 4; ++m) _Pragma("unroll") for (int n = 0; n < 2; ++n) _Pragma("unroll") for (int k = 0; k < 2; ++k) \
        acc[ai][bj][m][n] = __builtin_amdgcn_mfma_f32_16x16x32_bf16(Bt[n][k], At[m][k], acc[ai][bj][m][n], 0, 0, 0); __builtin_amdgcn_s_setprio(0); } while (0)
#define PG8_WAIT_V(n) asm volatile("s_waitcnt vmcnt(" #n ")" ::: "memory")
#define PG8_WAIT_L(n) asm volatile("s_waitcnt lgkmcnt(" #n ")" ::: "memory")
#define PG8_BAR __builtin_amdgcn_s_barrier()
#define PG8_SCHED __builtin_amdgcn_sched_barrier(0)
    Unit cur, nxt; int ui = 0;
    if (!S.next(0, cur)) return;
    f32x4 acc[2][2][4][2];
#pragma unroll
    for (int a = 0; a < 2; ++a)
#pragma unroll
        for (int b = 0; b < 2; ++b)
#pragma unroll
            for (int m = 0; m < 4; ++m)
#pragma unroll
                for (int n = 0; n < 2; ++n) acc[a][b][m][n] = (f32x4){0.f, 0.f, 0.f, 0.f};
    bf16x8 At[4][2], B0[2][2], B1[2][2];
    const char* cA = (const char*)g.A + (size_t)cur.pm * tstep; const char* cB = (const char*)g.Bt + (size_t)cur.pn * tstep;
    S.a_ready(cur);
    if constexpr (SP2) {
        PG8_STAGE(PG8_SB(0, 0), cB, voffB); PG8_STAGE(PG8_SB(0, 1), cB + hstep, voffB); PG8_STAGE(PG8_SA(0, 0), cA, voffA); PG8_STAGE(PG8_SA(0, 1), cA + hstep, voffA);
        if (wr == 1) PG8_BAR;
        PG8_WAIT_V(2); PG8_BAR;
        PG8_STAGE(PG8_SB(1, 0), cB + kstep, voffB); PG8_STAGE(PG8_SA(1, 0), cA + kstep, voffA); PG8_STAGE(PG8_SB(1, 1), cB + hstep + kstep, voffB);
        PG8_WAIT_V(6); PG8_BAR;
    } else {
        PG8_STAGE(PG8_SB(0, 0), cB, voffB); PG8_STAGE(PG8_SA(0, 0), cA, voffA); PG8_STAGE(PG8_SB(0, 1), cB + hstep, voffB); PG8_STAGE(PG8_SA(0, 1), cA + hstep, voffA);
        if (wr == 1) PG8_BAR;
        PG8_WAIT_V(4); PG8_BAR;
        PG8_STAGE(PG8_SB(1, 0), cB + kstep, voffB); PG8_STAGE(PG8_SA(1, 0), cA + kstep, voffA); PG8_STAGE(PG8_SB(1, 1), cB + hstep + kstep, voffB);
        PG8_WAIT_V(6); PG8_BAR;
    }
    for (;;) {
        const bool has_next = S.next(ui + 1, nxt);
        const char* nA = has_next ? (const char*)g.A + (size_t)nxt.pm * tstep : cA; const char* nB = has_next ? (const char*)g.Bt + (size_t)nxt.pn * tstep : cB;
        for (int th = 0; th < (Epi::MID ? 2 : 1); ++th) {
        if constexpr (Epi::MID) { if (th == 1) E.mid(acc, cur, wr, wc, fr, fq); }
        const int t_lo = Epi::MID ? th * (nt >> 1) : 0, t_hi = Epi::MID ? (th + 1) * (nt >> 1) : nt;
#pragma unroll 1
        for (int t = t_lo; t < t_hi; t += 2) {
            const bool last = (t == nt - 2);
            const char* a1 = cA + (size_t)(t + 1) * kstep;
            const char* a2 = last ? nA : cA + (size_t)(t + 2) * kstep; const char* b2 = last ? nB : cB + (size_t)(t + 2) * kstep;
            const char* a3 = a2 + kstep; const char* b3 = b2 + kstep;
            if (last && has_next) S.a_ready(nxt);
            if constexpr (SP2) {
            PG8_LDB(B0, 0, 0); PG8_LDB(B1, 0, 1); PG8_SCHED; PG8_LDA(At, 0, 0); PG8_STAGE(PG8_SA(1, 1), a1 + hstep, voffA);
            PG8_WAIT_V(8); PG8_WAIT_L(0); PG8_BAR; PG8_MMA(0, 0, At, B0); PG8_MMA(0, 1, At, B1); PG8_BAR; PG8_SCHED;
            PG8_LDA(At, 0, 1); PG8_STAGE(PG8_SB(0, 0), b2, voffB); PG8_STAGE(PG8_SB(0, 1), b2 + hstep, voffB); PG8_STAGE(PG8_SA(0, 0), a2, voffA);
            PG8_WAIT_V(8); PG8_WAIT_L(0); PG8_BAR; PG8_MMA(1, 0, At, B0); PG8_MMA(1, 1, At, B1); PG8_BAR; PG8_SCHED;
            PG8_LDB(B0, 1, 0); PG8_LDB(B1, 1, 1); PG8_SCHED; PG8_LDA(At, 1, 0); PG8_STAGE(PG8_SA(0, 1), a2 + hstep, voffA);
            PG8_WAIT_V(8); PG8_WAIT_L(0); PG8_BAR; PG8_MMA(0, 0, At, B0); PG8_MMA(0, 1, At, B1); PG8_BAR; PG8_SCHED;
            PG8_LDA(At, 1, 1); PG8_STAGE(PG8_SB(1, 0), b3, voffB); PG8_STAGE(PG8_SB(1, 1), b3 + hstep, voffB); PG8_STAGE(PG8_SA(1, 0), a3, voffA);
            PG8_WAIT_V(8); PG8_WAIT_L(0); PG8_BAR; PG8_MMA(1, 0, At, B0); PG8_MMA(1, 1, At, B1); PG8_BAR; PG8_SCHED;
            } else {
            PG8_LDB(B0, 0, 0); PG8_SCHED; PG8_LDA(At, 0, 0); PG8_STAGE(PG8_SA(1, 1), a1 + hstep, voffA);
            PG8_WAIT_L(8); PG8_BAR; PG8_WAIT_L(0); PG8_MMA(0, 0, At, B0); PG8_BAR; PG8_SCHED;
            PG8_LDB(B1, 0, 1); PG8_STAGE(PG8_SB(0, 0), b2, voffB);
            PG8_BAR; PG8_WAIT_L(0); PG8_MMA(0, 1, At, B1); PG8_BAR;
            PG8_LDA(At, 0, 1); PG8_STAGE(PG8_SA(0, 0), a2, voffA);
            PG8_BAR; PG8_WAIT_L(0); PG8_MMA(1, 0, At, B0); PG8_BAR; PG8_SCHED;
            PG8_STAGE(PG8_SB(0, 1), b2 + hstep, voffB);
            PG8_WAIT_V(6); PG8_BAR; PG8_MMA(1, 1, At, B1); PG8_BAR;
            PG8_LDB(B0, 1, 0); PG8_SCHED; PG8_LDA(At, 1, 0); PG8_STAGE(PG8_SA(0, 1), a2 + hstep, voffA);
            PG8_WAIT_L(8); PG8_BAR; PG8_WAIT_L(0); PG8_MMA(0, 0, At, B0); PG8_BAR; PG8_SCHED;
            PG8_LDB(B1, 1, 1); PG8_STAGE(PG8_SB(1, 0), b3, voffB);
            PG8_BAR; PG8_WAIT_L(0); PG8_MMA(0, 1, At, B1); PG8_BAR;
            PG8_LDA(At, 1, 1); PG8_STAGE(PG8_SA(1, 0), a3, voffA);
            PG8_BAR; PG8_WAIT_L(0); PG8_MMA(1, 0, At, B0); PG8_BAR; PG8_SCHED;
            PG8_STAGE(PG8_SB(1, 1), b3 + hstep, voffB);
            PG8_WAIT_V(6); PG8_BAR; PG8_MMA(1, 1, At, B1); PG8_BAR;
            }
        }
        }
        if constexpr (ALIGN_EPI) { if (wr == 0) PG8_BAR; }
        if constexpr (!Epi::AFTER_DRAIN) { E(acc, cur, wr, wc, fr, fq); S.done(cur); }
        if (!has_next) break;
#pragma unroll
        for (int a = 0; a < 2; ++a)
#pragma unroll
            for (int b = 0; b < 2; ++b)
#pragma unroll
                for (int m = 0; m < 4; ++m)
#pragma unroll
                    for (int n = 0; n < 2; ++n) acc[a][b][m][n] = (f32x4){0.f, 0.f, 0.f, 0.f};
        cur = nxt; cA = nA; cB = nB; ++ui;
        if constexpr (ALIGN_EPI) { if (wr == 1) PG8_BAR; }
    }
    PG8_WAIT_V(0);
    if constexpr (!ALIGN_EPI) { if (wr == 0) PG8_BAR; }
    PG8_BAR;
#undef PG8_SA
#undef PG8_SB
#undef PG8_STAGE
#undef PG8_LDA
#undef PG8_LDB
#undef PG8_MMA
#undef PG8_WAIT_V
#undef PG8_WAIT_L
#undef PG8_BAR
#undef PG8_SCHED
}

struct MiniOutGate {
    static constexpr bool MID = true;
    const bf16_t *GA, *GB; bf16_t* Mo;
    __device__ __forceinline__ void mid(f32x4 (&acc)[2], int row, int col, PG8_LAS unsigned char*, int, int, int) const {
        const u32x4 ga = *(const u32x4*)(GA + (size_t)row * 1024 + col), gb = *(const u32x4*)(GB + (size_t)row * 1024 + col); f32x4 a0, a1, b0, b1; unpack8(ga, a0, a1); unpack8(gb, b0, b1);
#pragma unroll
        for (int j = 0; j < 4; ++j) { acc[0][j] *= a0[j] * __builtin_amdgcn_rcpf(fmaxf(b0[j], 1e-30f)); acc[1][j] *= a1[j] * __builtin_amdgcn_rcpf(fmaxf(b1[j], 1e-30f)); }
    }
    __device__ __forceinline__ void operator()(const f32x4 (&acc)[2], int row, int col, PG8_LAS unsigned char*, int, int, int, int) const {
        const u32x4 gb = *(const u32x4*)(GB + (size_t)row * 1024 + col); f32x4 b0, b1; unpack8(gb, b0, b1);
        *(u32x4*)(Mo + (size_t)row * 1024 + col) = pack8(acc[0] * b0, acc[1] * b1);
    }
};
struct MiniWo {
    static constexpr bool MID = false;
    const float* xs; float* H; bf16_t* HB; float* part;
    __device__ __forceinline__ void mid(f32x4 (&)[2], int, int, PG8_LAS unsigned char*, int, int, int) const {}
    __device__ __forceinline__ void operator()(const f32x4 (&acc)[2], int row, int col, PG8_LAS unsigned char* lds, int wm, int wn, int fr, int fq) const {
        const float* xr = xs + (size_t)(row - 16384) * 1024 + col;
        const f32x4 h0 = *(const f32x4*)xr + acc[0], h1 = *(const f32x4*)(xr + 4) + acc[1];
        *(f32x4*)(H + (size_t)row * 1024 + col) = h0; *(f32x4*)(H + (size_t)row * 1024 + col + 4) = h1; *(u32x4*)(HB + (size_t)row * 1024 + col) = pack8(h0, h1);
        float ss = (h0[0] * h0[0] + h0[1] * h0[1]) + (h0[2] * h0[2] + h0[3] * h0[3]) + (h1[0] * h1[0] + h1[1] * h1[1]) + (h1[2] * h1[2] + h1[3] * h1[3]);
        ss += __shfl_xor(ss, 16); ss += __shfl_xor(ss, 32);
        PG8_LAS float* sc = (PG8_LAS float*)lds;
        if (fq == 0) sc[wn * 64 + wm * 16 + fr] = ss;
        __syncthreads();
        if (wn == 0 && fq == 0) part[(size_t)row * 16 + (col >> 6)] = sc[wm * 16 + fr] + sc[64 + wm * 16 + fr];
    }
};
struct MiniPg {
    static constexpr bool MID = false;
    float* H; const bf16_t* PE; const float* part;
    __device__ __forceinline__ void mid(f32x4 (&)[2], int, int, PG8_LAS unsigned char*, int, int, int) const {}
    __device__ __forceinline__ void operator()(const f32x4 (&acc)[2], int row, int col, PG8_LAS unsigned char*, int, int, int, int fq) const {
        float rs; { const f32x4 pv = *(const f32x4*)(part + (size_t)row * 16 + 4 * fq); rs = (pv[0] + pv[1]) + (pv[2] + pv[3]); rs += __shfl_xor(rs, 16); rs += __shfl_xor(rs, 32); }
        const float rstd = 1.0f / sqrtf(rs * (1.0f / 1024.0f) + 1e-6f);
        float* hp = H + (size_t)row * 1024 + col; f32x4 h0 = *(const f32x4*)hp, h1 = *(const f32x4*)(hp + 4); const u32x4 pe = *(const u32x4*)(PE + (size_t)row * 1024 + col); f32x4 p0, p1; unpack8(pe, p0, p1);
#pragma unroll
        for (int j = 0; j < 4; ++j) { h0[j] += sigmoidf_(acc[0][j] * rstd) * p0[j]; h1[j] += sigmoidf_(acc[1][j] * rstd) * p1[j]; }
        *(f32x4*)hp = h0; *(f32x4*)(hp + 4) = h1;
    }
};
template <class MEpi>
__device__ __forceinline__ void mini_gemm(PG8_LAS unsigned char* lds, const bf16_t* A, const bf16_t* Bt, int K, int row0, int col0, const MEpi& E) {
    int tid = threadIdx.x; asm volatile("" : "+v"(tid));
    const int wid = __builtin_amdgcn_readfirstlane(tid >> 6), lane = tid & 63, wm = wid & 3, wn = wid >> 2, fr = lane & 15, fq = lane >> 4;
    const int sr = tid >> 3, sc = tid & 7;
    const bf16_t* ga = A + (size_t)(row0 + sr) * K + sc * 8;
    const bf16_t* gb = Bt + (size_t)(col0 + (sr & ~31) + perm32(sr & 31)) * K + sc * 8;
    const unsigned wofs = (unsigned)(sr * 128 + ((sc ^ (sr & 7)) << 4));
    const int ar = wm * 16 + fr, br = wn * 32 + fr;
    f32x4 acc[2] = {(f32x4){0.f, 0.f, 0.f, 0.f}, (f32x4){0.f, 0.f, 0.f, 0.f}};
    const int ns = K / 64;
    u32x4 a0 = *(const u32x4*)ga, b0 = *(const u32x4*)gb, a1 = *(const u32x4*)(ga + 64), b1 = *(const u32x4*)(gb + 64);
    *(PG8_LAS u32x4*)(lds + wofs) = a0; *(PG8_LAS u32x4*)(lds + 8192 + wofs) = b0;
    __syncthreads();
#define MINI_COMPUTE(buf) do { _Pragma("unroll") for (int kk = 0; kk < 2; ++kk) { \
        const bf16x8 af = *(const PG8_LAS bf16x8*)(lds + (buf) * 16384 + ar * 128 + ((((kk << 2) + fq) ^ (ar & 7)) << 4)); \
        const bf16x8 bf0 = *(const PG8_LAS bf16x8*)(lds + (buf) * 16384 + 8192 + br * 128 + ((((kk << 2) + fq) ^ (br & 7)) << 4)); \
        const bf16x8 bf1 = *(const PG8_LAS bf16x8*)(lds + (buf) * 16384 + 8192 + (br + 16) * 128 + ((((kk << 2) + fq) ^ ((br + 16) & 7)) << 4)); \
        acc[0] = __builtin_amdgcn_mfma_f32_16x16x32_bf16(bf0, af, acc[0], 0, 0, 0); acc[1] = __builtin_amdgcn_mfma_f32_16x16x32_bf16(bf1, af, acc[1], 0, 0, 0); } } while (0)
#pragma unroll 1
    for (int s = 0; s < ns; s += 2) {
        if constexpr (MEpi::MID) { if (s == (ns >> 1)) E.mid(acc, row0 + ar, col0 + wn * 32 + 8 * fq, lds, wm, fr, fq); }
        if (s + 2 < ns) { a0 = *(const u32x4*)(ga + (size_t)(s + 2) * 64); b0 = *(const u32x4*)(gb + (size_t)(s + 2) * 64); }
        MINI_COMPUTE(0);
        *(PG8_LAS u32x4*)(lds + 16384 + wofs) = a1; *(PG8_LAS u32x4*)(lds + 16384 + 8192 + wofs) = b1;
        __syncthreads();
        if (s + 3 < ns) { a1 = *(const u32x4*)(ga + (size_t)(s + 3) * 64); b1 = *(const u32x4*)(gb + (size_t)(s + 3) * 64); }
        MINI_COMPUTE(1);
        if (s + 2 < ns) { *(PG8_LAS u32x4*)(lds + wofs) = a0; *(PG8_LAS u32x4*)(lds + 8192 + wofs) = b0; }
        __syncthreads();
    }
#undef MINI_COMPUTE
    E(acc, row0 + ar, col0 + wn * 32 + 8 * fq, lds, wm, wn, fr, fq);
    __syncthreads();
}
}

#ifndef PG8_SP2
#define PG8_SP2 true
#endif
#ifndef PG8_ALIGN
#define PG8_ALIGN true
#endif

constexpr int NWAVES = 8;
constexpr int DM = 1024, NP = 16384, NS = 1024, T = NP + NS, SEQ = 2048, DSEQ = 8, DIN = 9216, PLE = 256;
constexpr float EPS = 1e-6f, LN_EPS = 1e-5f;
constexpr size_t OFF_NAP = (size_t)T * DM, OFF_NBP = OFF_NAP + 8 * 2 * 1024, OFF_NAS = OFF_NBP + 8 * 30 * 1024, OFF_NBS = OFF_NAS + 128 * 2 * 1024;
constexpr size_t MiB = 1u << 20;
constexpr size_t WS_CTL = 0, CTL_ZERO_BYTES = 64 * 1024;
constexpr size_t WS_WIN = 2 * MiB, WS_WAB = 20 * MiB, WS_WO = 24 * MiB, WS_WPG = 26 * MiB, WS_WPE = 28 * MiB;
constexpr size_t WS_PB = 29 * MiB;
constexpr size_t WS_XB = 38 * MiB;
constexpr size_t WS_QZ = 72 * MiB;
constexpr size_t WS_S = 140 * MiB;
constexpr size_t WS_V = 174 * MiB;
constexpr size_t WS_PART = 208 * MiB;
constexpr size_t WS_PE = 214 * MiB;
constexpr size_t WS_END = 248 * MiB;
constexpr int CW_BAR = 4096;
constexpr int RING_BYTES = 131072, LDSCTL_OFF = RING_BYTES, MISC_OFF = LDSCTL_OFF + 320, LDS_BYTES = 147456;

#define GAS __attribute__((address_space(1)))
#define LAS __attribute__((address_space(3)))
typedef unsigned short bf16;
typedef unsigned v4u __attribute__((ext_vector_type(4)));
typedef unsigned v2u __attribute__((ext_vector_type(2)));
typedef float f32x4 __attribute__((ext_vector_type(4)));
typedef float f32x2 __attribute__((ext_vector_type(2)));
#define LDS_WAIT() asm volatile("s_waitcnt lgkmcnt(0)" ::: "memory")
using pg8::cvt_pk_bf16; using pg8::bf_lo; using pg8::bf_hi; using pg8::sigmoidf_;

#define XB_TMO      128
#define XB_XCNT(j)  (256  + 64 * (j))
#define XB_XSUB(j)  (1280 + 64 * (j))
#define XB_XGEN(j)  (2304 + 64 * (j))
#define XB_TOP      3328
#define XB_TOPGEN   3392
#define XCD_BAR_WORDS 3456
#define XB_SPIN_CAP (1u << 18)
__device__ __forceinline__ unsigned xb_ld(unsigned* p)              { return __hip_atomic_load(p, __ATOMIC_RELAXED, __HIP_MEMORY_SCOPE_AGENT); }
__device__ __forceinline__ unsigned xb_add(unsigned* p, unsigned v) { return __hip_atomic_fetch_add(p, v, __ATOMIC_RELAXED, __HIP_MEMORY_SCOPE_AGENT); }
__device__ __forceinline__ unsigned xb_xcc_id() { return (unsigned)__builtin_amdgcn_s_getreg((3 << 11) | 20) & 0xFu; }
#define XB_SPIN(cond, bar) do { unsigned _sp = 0; while (cond) { __builtin_amdgcn_s_sleep(1); \
    if ((++_sp & 255u) == 0u) { if (xb_ld(&(bar)[XB_TMO])) break; if (_sp > XB_SPIN_CAP) { atomicAdd(&(bar)[XB_TMO], 1u); break; } } } } while (0)
struct XcdBarrier { unsigned* bar; unsigned x; volatile LAS unsigned* st; };
__device__ __forceinline__ XcdBarrier xcd_barrier_post(unsigned* bar, volatile LAS unsigned* st) {
    XcdBarrier b; b.bar = bar; b.x = xb_xcc_id(); b.st = st;
    if (threadIdx.x == 0) (void)xb_add(&bar[XB_XCNT(b.x)], 1u);
    return b;
}
__device__ __forceinline__ void xcd_barrier_complete(unsigned* bar, unsigned x, unsigned& nloc, unsigned& nx) {
    const unsigned G = gridDim.x * gridDim.y * gridDim.z;
    unsigned sum, cnt, mine, sp = 0u;
    for (;;) {
        sum = 0u; cnt = 0u; mine = 0u;
#pragma unroll
        for (unsigned j = 0; j < 16; ++j) { const unsigned c = xb_ld(&bar[XB_XCNT(j)]); sum += c; cnt += (c > 0u) ? 1u : 0u; mine = (j == x) ? c : mine; }
        if (sum == G) break;
        __builtin_amdgcn_s_sleep(1);
        if ((++sp & 255u) == 0u) { if (xb_ld(&bar[XB_TMO])) break; if (sp > XB_SPIN_CAP) { atomicAdd(&bar[XB_TMO], 1u); break; } }
    }
    nloc = mine > 0u ? mine : 1u; nx = cnt > 0u ? cnt : 1u;
}
__device__ __forceinline__ void xcd_barrier(const XcdBarrier& b) {
    asm volatile("s_waitcnt vmcnt(0)" ::: "memory");
    __syncthreads();
    if (threadIdx.x == 0) {
        unsigned* bar = b.bar;
        __builtin_amdgcn_s_waitcnt(0);
        unsigned nloc = b.st[0], nx = b.st[1];
        if (nloc == 0u) { xcd_barrier_complete(bar, b.x, nloc, nx); b.st[0] = nloc; b.st[1] = nx; }
        const unsigned old = xb_add(&bar[XB_XSUB(b.x)], 1u);
        const unsigned gen = old / nloc;
        if (old + 1u == (gen + 1u) * nloc) {
            __builtin_amdgcn_fence(__ATOMIC_RELEASE, "agent");
            asm volatile("s_waitcnt vmcnt(0)" ::: "memory");
            const unsigned og = xb_add(&bar[XB_TOP], 1u);
            const unsigned tg = og / nx;
            if (og + 1u == (tg + 1u) * nx) xb_add(&bar[XB_TOPGEN], 1u);
            else XB_SPIN(xb_ld(&bar[XB_TOPGEN]) == tg, bar);
            __builtin_amdgcn_fence(__ATOMIC_ACQUIRE, "agent");
            xb_add(&bar[XB_XGEN(b.x)], 1u);
            asm volatile("s_waitcnt vmcnt(0)" ::: "memory");
        } else {
            XB_SPIN(xb_ld(&bar[XB_XGEN(b.x)]) == gen, bar);
            __builtin_amdgcn_fence(__ATOMIC_ACQUIRE, "agent");
            asm volatile("s_waitcnt vmcnt(0)" ::: "memory");
        }
    }
    __syncthreads();
}

__device__ __forceinline__ float wave_sum(float v) {
#pragma unroll
    for (int o = 1; o < 64; o <<= 1) v += __shfl_xor(v, o);
    return v;
}

template <class RowMap>
__device__ __forceinline__ void p0_transpose_item(const float* W, int N, bf16* WT, int ldk, int koff, const float* gk, RowMap rm, LAS float* scr, int item, int lane) {
    const int nblk = N / 32, kb = item / nblk, nb = item % nblk, k0 = 64 * kb, n0 = 32 * nb;
#pragma unroll 8
    for (int i = 0; i < 32; ++i) { const int kk = 2 * i + (lane >> 5); float w = W[(size_t)(k0 + kk) * N + n0 + (lane & 31)]; if (gk) w *= gk[k0 + kk]; scr[kk * 33 + (lane & 31)] = w; }
    LDS_WAIT(); asm volatile("" ::: "memory");
    const int c = lane & 7;
#pragma unroll
    for (int j = 0; j < 4; ++j) { const int n = (lane >> 3) + 8 * j; const LAS float* s = scr + (8 * c) * 33 + n;
        v4u o; o.x = cvt_pk_bf16(s[0 * 33], s[1 * 33]); o.y = cvt_pk_bf16(s[2 * 33], s[3 * 33]); o.z = cvt_pk_bf16(s[4 * 33], s[5 * 33]); o.w = cvt_pk_bf16(s[6 * 33], s[7 * 33]);
        *(GAS v4u*)(WT + (size_t)rm(n0 + n) * ldk + koff + k0 + 8 * c) = o; }
    LDS_WAIT(); asm volatile("" ::: "memory");
}
struct RowId { __device__ __forceinline__ int operator()(int n) const { return n; } };
struct RowInProj { __device__ __forceinline__ int operator()(int sc) const {
    const int g = sc >> 10, ch = sc & 1023;
    if (g >= 6) return 256 * (24 + 4 * (g - 6) + (ch >> 8)) + (ch & 255);
    int base, isY;
    switch (g) { case 0: base = 0; isY = 0; break; case 3: base = 0; isY = 1; break; case 1: base = 8; isY = 0; break; case 2: base = 8; isY = 1; break; case 4: base = 16; isY = 0; break; default: base = 16; isY = 1; break; }
    const int cl = ch & 127, grp = cl >> 3, r8 = cl & 7, bj = r8 >> 2, j = r8 & 3;
    return 256 * (base + (ch >> 7)) + 128 * bj + 8 * grp + 4 * isY + j; } };

struct Ptrs {
    const float *x_p, *x_s, *st_a, *st_b, *p_p, *p_s, *g_mix, *w_in, *w_conv_a, *w_out_a, *w_conv_b, *b_conv_b, *ln_g, *ln_b, *w_out_b, *w_o, *w_pe, *g_ple, *w_pg, *g_final;
    float* out; unsigned char* ws;
};

typedef const __attribute__((address_space(4))) Ptrs* KPtrsT;
__device__ __forceinline__ Ptrs load_ptrs(KPtrsT k) {
    Ptrs P;
    P.x_p = k->x_p; P.x_s = k->x_s; P.st_a = k->st_a; P.st_b = k->st_b; P.p_p = k->p_p; P.p_s = k->p_s; P.g_mix = k->g_mix; P.w_in = k->w_in; P.w_conv_a = k->w_conv_a; P.w_out_a = k->w_out_a;
    P.w_conv_b = k->w_conv_b; P.b_conv_b = k->b_conv_b; P.ln_g = k->ln_g; P.ln_b = k->ln_b; P.w_out_b = k->w_out_b; P.w_o = k->w_o; P.w_pe = k->w_pe; P.g_ple = k->g_ple; P.w_pg = k->w_pg; P.g_final = k->g_final;
    P.out = k->out; P.ws = k->ws; return P;
}
__device__ __forceinline__ void p0_prologue(const Ptrs& P, LAS unsigned char* lds, int gw, int NGW, int lane, int wave) {
    LAS float* scr = (LAS float*)(lds + wave * 16384);
    bf16* Wt_in = (bf16*)(P.ws + WS_WIN); bf16* Wt_ab = (bf16*)(P.ws + WS_WAB); bf16* Wt_o = (bf16*)(P.ws + WS_WO); bf16* Wt_pg = (bf16*)(P.ws + WS_WPG); bf16* Wt_pe = (bf16*)(P.ws + WS_WPE);
    constexpr int I_IN = (DM / 64) * (DIN / 32), I_SQ = (DM / 64) * (DM / 32), I_PE = (PLE / 64) * (DM / 32);
    constexpr int NITEMS = I_IN + 4 * I_SQ + I_PE;
    for (int it = gw; it < NITEMS; it += NGW) {
        int r = it;
        if (r < I_IN) { p0_transpose_item(P.w_in, DIN, Wt_in, DM, 0, P.g_mix, RowInProj(), scr, r, lane); continue; } r -= I_IN;
        if (r < I_SQ) { p0_transpose_item(P.w_out_a, DM, Wt_ab, 2 * DM, 0, nullptr, RowId(), scr, r, lane); continue; } r -= I_SQ;
        if (r < I_SQ) { p0_transpose_item(P.w_out_b, DM, Wt_ab, 2 * DM, DM, nullptr, RowId(), scr, r, lane); continue; } r -= I_SQ;
        if (r < I_SQ) { p0_transpose_item(P.w_o, DM, Wt_o, DM, 0, nullptr, RowId(), scr, r, lane); continue; } r -= I_SQ;
        if (r < I_SQ) { p0_transpose_item(P.w_pg, DM, Wt_pg, DM, 0, P.g_ple, RowId(), scr, r, lane); continue; } r -= I_SQ;
        p0_transpose_item(P.w_pe, DM, Wt_pe, PLE, 0, nullptr, RowId(), scr, r, lane);
    }
    bf16* XB = (bf16*)(P.ws + WS_XB); bf16* PB = (bf16*)(P.ws + WS_PB);
    for (int m = gw; m < T; m += NGW) {
        const float* xrow = m < NP ? P.x_p + (size_t)m * DM : P.x_s + (size_t)(m - NP) * DM;
        const GAS f32x4* xr = (const GAS f32x4*)xrow + lane;
        f32x4 v[4]; float s = 0.f;
#pragma unroll
        for (int j = 0; j < 4; ++j) { v[j] = xr[64 * j]; s += (v[j].x * v[j].x + v[j].y * v[j].y) + (v[j].z * v[j].z + v[j].w * v[j].w); }
        const float rstd = 1.0f / sqrtf(wave_sum(s) * (1.0f / DM) + EPS);
        GAS v2u* o8 = (GAS v2u*)(XB + (size_t)m * DM) + lane;
#pragma unroll
        for (int j = 0; j < 4; ++j) { v2u w; w.x = cvt_pk_bf16(v[j].x * rstd, v[j].y * rstd); w.y = cvt_pk_bf16(v[j].z * rstd, v[j].w * rstd); o8[64 * j] = w; }
        const float* prow = m < NP ? P.p_p + (size_t)m * PLE : P.p_s + (size_t)(m - NP) * PLE;
        const f32x4 pv = ((const GAS f32x4*)prow)[lane];
        v2u w; w.x = cvt_pk_bf16(pv.x, pv.y); w.y = cvt_pk_bf16(pv.z, pv.w);
        ((GAS v2u*)(PB + (size_t)m * PLE))[lane] = w;
    }
}

using pg8::rsrc_t; using pg8::mkrsrc;
__device__ __forceinline__ unsigned bld4(rsrc_t r, unsigned voff, unsigned soff) { return __builtin_amdgcn_raw_buffer_load_b32(r, (int)voff, (int)soff, 0); }
__device__ __forceinline__ void bst4(rsrc_t r, unsigned voff, unsigned soff, unsigned v) { __builtin_amdgcn_raw_buffer_store_b32(v, r, (int)voff, (int)soff, 0); }
__device__ __forceinline__ f32x2 bld8f(rsrc_t r, unsigned voff, unsigned soff) { return __builtin_bit_cast(f32x2, __builtin_amdgcn_raw_buffer_load_b64(r, (int)voff, (int)soff, 0)); }
__device__ __forceinline__ void bst8f(rsrc_t r, unsigned voff, unsigned soff, f32x2 v) { __builtin_amdgcn_raw_buffer_store_b64(__builtin_bit_cast(v2u, v), r, (int)voff, (int)soff, 0); }
__device__ __forceinline__ f32x2 up2(unsigned u) { return (f32x2){bf_lo(u), bf_hi(u)}; }
using pg8::bld16; using pg8::bst16; using pg8::u32x4; using pg8::pack8; using pg8::unpack8; using pg8::as_f; using pg8::as_u;
template <int NTW>
__device__ __forceinline__ void p2_ln_part(const Ptrs& P, LAS unsigned char* lds, rsrc_t rQZ, unsigned R0, int lane, int wave) {
    f32x4 lg[4], lb[4];
#pragma unroll
    for (int h = 0; h < 2; ++h)
#pragma unroll
        for (int q = 0; q < 2; ++q) { lg[2 * h + q] = *(const f32x4*)(P.ln_g + h * 512 + lane * 8 + q * 4); lb[2 * h + q] = *(const f32x4*)(P.ln_b + h * 512 + lane * 8 + q * 4); }
    const LAS f32x4* cl4 = (const LAS f32x4*)lds;
    const unsigned vz = (unsigned)lane * 16u;
#pragma unroll 1
    for (int ii = 0; ii < NTW; ++ii) { const int i = wave * NTW + ii;
        f32x4 x[4]; float s = 0.f;
#pragma unroll
        for (int h = 0; h < 2; ++h)
#pragma unroll
            for (int q = 0; q < 2; ++q) { x[2 * h + q] = cl4[i * 256 + h * 128 + lane * 2 + q]; s += (x[2 * h + q].x + x[2 * h + q].y) + (x[2 * h + q].z + x[2 * h + q].w); }
        const float mean = wave_sum(s) * (1.0f / 1024.0f); float qq = 0.f;
#pragma unroll
        for (int j = 0; j < 4; ++j) { x[j] = x[j] - mean; qq += (x[j].x * x[j].x + x[j].y * x[j].y) + (x[j].z * x[j].z + x[j].w * x[j].w); }
        const float rstd = 1.0f / sqrtf(wave_sum(qq) * (1.0f / 1024.0f) + LN_EPS);
        const unsigned so = (R0 + i) * 4096u + 2048u;
#pragma unroll
        for (int h = 0; h < 2; ++h) { const u32x4 z = bld16(rQZ, vz, so + h * 1024); f32x4 z0, z1; unpack8(z, z0, z1);
            f32x4 y0 = x[2 * h] * rstd * lg[2 * h] + lb[2 * h], y1 = x[2 * h + 1] * rstd * lg[2 * h + 1] + lb[2 * h + 1];
#pragma unroll
            for (int j = 0; j < 4; ++j) { y0[j] = y0[j] * sigmoidf_(y0[j]) * z0[j]; y1[j] = y1[j] * sigmoidf_(y1[j]) * z1[j]; }
            bst16(rQZ, vz, so + h * 1024, pack8(y0, y1)); }
    }
}
__device__ __forceinline__ void p2_tile_prompt(const Ptrs& P, LAS unsigned char* lds, int tile, int tid, int lane, int wave) {
    const rsrc_t rQZ = mkrsrc(P.ws + WS_QZ), rS = mkrsrc(P.ws + WS_S), rWb = mkrsrc(P.w_conv_b), rOut = mkrsrc(P.out);
    const unsigned b = tile >> 6, t0 = (tile & 63) * 32, R0 = b * SEQ + t0;
    const bool lastt = (t0 == SEQ - 32), first = (t0 == 0);
    {
        const unsigned char* Vb = P.ws + WS_V;
#pragma unroll 1
        for (int hr = wave; hr < 124; hr += 8) { const int row = hr >> 1, half = hr & 1;
            if (first && row < 30) { *(LAS u32x4*)(lds + row * 2048 + half * 1024 + lane * 16) = (u32x4){0u, 0u, 0u, 0u}; }
            else __builtin_amdgcn_global_load_lds((const unsigned*)(Vb + (size_t)(R0 - 30 + row) * 2048 + half * 1024 + lane * 16), (LAS unsigned*)(lds + row * 2048 + half * 1024), 16, 0, 0); }
    }
    {
        const unsigned cg = tid & 127, tq = tid >> 7, vo = cg * 16u, r0 = R0 + tq * 8;
        f32x4 w0[2], w1[2], w2[2];
#pragma unroll
        for (int q = 0; q < 2; ++q) { w0[q] = *(const f32x4*)(P.w_conv_a + cg * 8 + q * 4); w1[q] = *(const f32x4*)(P.w_conv_a + 1024 + cg * 8 + q * 4); w2[q] = *(const f32x4*)(P.w_conv_a + 2048 + cg * 8 + q * 4); }
        u32x4 sr[10];
#pragma unroll
        for (int i = 0; i < 10; ++i) { const bool neg = first && tq == 0 && i < 2; sr[i] = bld16(rS, vo, neg ? 0u : (r0 - 2 + i) * 2048u); if (neg) sr[i] = (u32x4){0u, 0u, 0u, 0u}; }
        u32x4 qr[8];
#pragma unroll
        for (int i = 0; i < 8; ++i) qr[i] = bld16(rQZ, vo, (r0 + i) * 4096u);
#pragma unroll
        for (int i = 0; i < 8; ++i) { f32x4 a0, a1, b0, b1, c0, c1, q0, q1; unpack8(sr[i], a0, a1); unpack8(sr[i + 1], b0, b1); unpack8(sr[i + 2], c0, c1); unpack8(qr[i], q0, q1);
            const f32x4 y0 = q0 * (w0[0] * a0 + w1[0] * b0 + w2[0] * c0), y1 = q1 * (w0[1] * a1 + w1[1] * b1 + w2[1] * c1);
            bst16(rQZ, vo, (r0 + i) * 4096u, pack8(y0, y1)); }
        if (lastt && tq == 3) {
#pragma unroll
            for (int j = 0; j < 2; ++j) { f32x4 a0, a1; unpack8(sr[8 + j], a0, a1);
                bst16(rOut, cg * 32u, (unsigned)(OFF_NAP + (size_t)(b * 2 + j) * 1024) * 4u, as_u(a0)); bst16(rOut, cg * 32u, (unsigned)(OFF_NAP + (size_t)(b * 2 + j) * 1024) * 4u + 16u, as_u(a1)); } }
    }
    asm volatile("s_waitcnt vmcnt(0)" ::: "memory");
    __syncthreads();
    {
        const unsigned v8 = (unsigned)tid * 8u;
        const f32x2 bias = *(const f32x2*)(P.b_conv_b + 2 * tid);
        f32x2 win[62];
#pragma unroll
        for (int i = 0; i < 62; ++i) win[i] = up2(*(const LAS unsigned*)(lds + i * 2048 + tid * 4));
        asm volatile("s_waitcnt lgkmcnt(0)" ::: "memory");
        __syncthreads();
        LAS f32x2* cl2 = (LAS f32x2*)lds;
#pragma unroll
        for (int hh = 0; hh < 2; ++hh) {
            f32x2 c[16];
#pragma unroll
            for (int i = 0; i < 16; ++i) c[i] = bias;
#pragma unroll
            for (int k = 0; k < 31; ++k) { const f32x2 w = bld8f(rWb, v8, k * 4096u);
#pragma unroll
                for (int i = 0; i < 16; ++i) c[i] += w * win[hh * 16 + i + k]; }
#pragma unroll
            for (int i = 0; i < 16; ++i) cl2[(hh * 16 + i) * 512 + tid] = c[i];
        }
        if (lastt) {
#pragma unroll
            for (int j = 0; j < 30; ++j) bst8f(rOut, v8, (unsigned)(OFF_NBP + (size_t)(b * 30 + j) * 1024) * 4u, win[32 + j]); }
    }
    __syncthreads();
    p2_ln_part<4>(P, lds, rQZ, R0, lane, wave);
    __syncthreads();
}
__device__ __forceinline__ void p2_seq_sample(const Ptrs& P, LAS unsigned char* lds, int n, int tid, int lane, int wave) {
    const rsrc_t rQZ = mkrsrc(P.ws + WS_QZ), rS = mkrsrc(P.ws + WS_S), rV = mkrsrc(P.ws + WS_V), rWb = mkrsrc(P.w_conv_b), rOut = mkrsrc(P.out);
    const rsrc_t rSa = mkrsrc(P.st_a), rSb = mkrsrc(P.st_b);
    const unsigned v4 = (unsigned)tid * 4u, v8 = (unsigned)tid * 8u, r0 = NP + n * DSEQ;
    LAS f32x2* cl2 = (LAS f32x2*)lds;
    const f32x2 wA0 = *(const f32x2*)(P.w_conv_a + 2 * tid), wA1 = *(const f32x2*)(P.w_conv_a + 1024 + 2 * tid), wA2 = *(const f32x2*)(P.w_conv_a + 2048 + 2 * tid);
    const f32x2 bias = *(const f32x2*)(P.b_conv_b + 2 * tid);
    {
        f32x2 sw[10];
#pragma unroll
        for (int i = 0; i < 2; ++i) sw[i] = bld8f(rSa, v8, (n * 2 + i) * 4096u);
#pragma unroll
        for (int i = 0; i < 8; ++i) sw[2 + i] = up2(bld4(rS, v4, (r0 + i) * 2048u));
#pragma unroll
        for (int i = 0; i < 8; ++i) { const f32x2 q = up2(bld4(rQZ, v4, (r0 + i) * 4096u));
            const f32x2 cv = wA0 * sw[i] + wA1 * sw[i + 1] + wA2 * sw[i + 2]; const f32x2 ya = q * cv; bst4(rQZ, v4, (r0 + i) * 4096u, cvt_pk_bf16(ya.x, ya.y)); }
#pragma unroll
        for (int j = 0; j < 2; ++j) bst8f(rOut, v8, (unsigned)(OFF_NAS + (size_t)(n * 2 + j) * 1024) * 4u, sw[8 + j]);
    }
    {
        f32x2 win[38];
#pragma unroll
        for (int i = 0; i < 30; ++i) win[i] = bld8f(rSb, v8, (n * 30 + i) * 4096u);
#pragma unroll
        for (int i = 0; i < 8; ++i) win[30 + i] = up2(bld4(rV, v4, (r0 + i) * 2048u));
        f32x2 c[8];
#pragma unroll
        for (int i = 0; i < 8; ++i) c[i] = bias;
#pragma unroll
        for (int k = 0; k < 31; ++k) { const f32x2 w = bld8f(rWb, v8, k * 4096u);
#pragma unroll
            for (int i = 0; i < 8; ++i) c[i] += w * win[i + k]; }
#pragma unroll
        for (int i = 0; i < 8; ++i) cl2[i * 512 + tid] = c[i];
#pragma unroll
        for (int j = 0; j < 30; ++j) bst8f(rOut, v8, (unsigned)(OFF_NBS + (size_t)(n * 30 + j) * 1024) * 4u, win[8 + j]);
    }
    __syncthreads();
    p2_ln_part<1>(P, lds, rQZ, r0, lane, wave);
    __syncthreads();
}

struct Args { Ptrs p; int ph_lo, ph_hi; };

__global__ void __launch_bounds__(NWAVES * 64, 2) fwd_megakernel(Args args) {
    extern __shared__ __attribute__((aligned(16))) unsigned char lds_raw[];
    LAS unsigned char* lds = (LAS unsigned char*)lds_raw;
    typedef const __attribute__((address_space(4))) Ptrs* KPtrs;
    const KPtrs Pk = (KPtrs)__builtin_amdgcn_kernarg_segment_ptr();
#define PHASE_PTRS() KPtrs Pq_ = Pk; asm volatile("" : "+s"(Pq_)); const Ptrs P = load_ptrs(Pq_); int tid = threadIdx.x; asm volatile("" : "+v"(tid)); const int lane = tid & 63; (void)lane
    const int tid0 = threadIdx.x, wave = __builtin_amdgcn_readfirstlane(tid0 >> 6);
    const int G = gridDim.x, bx = blockIdx.x;
    const int gw = bx * NWAVES + wave, NGW = G * NWAVES;
    volatile LAS unsigned* MISC = (volatile LAS unsigned*)(lds + MISC_OFF);
    for (int u = tid0; u < (LDS_BYTES - LDSCTL_OFF) / 4; u += NWAVES * 64) ((LAS unsigned*)(lds + LDSCTL_OFF))[u] = 0u;
    __syncthreads();
    unsigned* ctl;
    { PHASE_PTRS(); ctl = (unsigned*)(P.ws + WS_CTL); }
    XcdBarrier bar; bar.bar = ctl + CW_BAR; bar.x = 0; bar.st = nullptr;
#if !MK_PER_PHASE
    bar = xcd_barrier_post(ctl + CW_BAR, MISC + 8);
#endif
    const int lo = args.ph_lo, hi = args.ph_hi;
#define WSP(off) ((pg8::bf16_t*)(P.ws + (off)))

#define RUN0 { PHASE_PTRS(); p0_prologue(P, lds, gw, NGW, lane, wave); }
#define RUN1 { PHASE_PTRS(); \
            pg8::Gemm g{WSP(WS_XB), WSP(WS_WIN), T, DIN, DM}; pg8::StaticOrder S; S.init(T, DIN, G, bx); \
            pg8::EpiInProj E{WSP(WS_QZ), WSP(WS_S), WSP(WS_V), (pg8::bf16_t*)P.out, (pg8::bf16_t*)P.out + (size_t)T * DM}; \
            pg8::gemm_phase<pg8::EpiInProj, pg8::StaticOrder, PG8_ALIGN, PG8_SP2>(lds, g, S, E); \
              \
            { pg8::Gemm g2{WSP(WS_PB), WSP(WS_WPE), T, DM, PLE}; pg8::StaticOrder S2; S2.init(T, DM, G - 144, bx - 144); \
              pg8::EpiPlain E2{WSP(WS_PE), DM}; \
              pg8::gemm_phase<pg8::EpiPlain, pg8::StaticOrder, PG8_ALIGN, PG8_SP2>(lds, g2, S2, E2); } }
#define RUN2 { PHASE_PTRS(); \
            for (int tile = bx; tile < 512; tile += G) p2_tile_prompt(P, lds, tile, tid, lane, wave); \
            for (int n = bx; n < 128; n += G) p2_seq_sample(P, lds, n, tid, lane, wave); }
#define RUN3 { PHASE_PTRS(); \
            pg8::Gemm g{WSP(WS_QZ), WSP(WS_WAB), NP, DM, 2 * DM}; pg8::StaticOrder S; S.init(NP, DM, G, bx); \
            pg8::EpiOutGate E{(const pg8::bf16_t*)P.out, (const pg8::bf16_t*)P.out + (size_t)T * DM, WSP(WS_S)}; \
            pg8::gemm_phase<pg8::EpiOutGate, pg8::StaticOrder, PG8_ALIGN, PG8_SP2>(lds, g, S, E); \
            pg8::MiniOutGate ME{(const pg8::bf16_t*)P.out, (const pg8::bf16_t*)P.out + (size_t)T * DM, WSP(WS_S)}; \
            pg8::mini_gemm(lds, WSP(WS_QZ), WSP(WS_WAB), 2 * DM, NP + (bx >> 4) * 64, (bx & 15) * 64, ME); }
#define RUN4 { \
            { PHASE_PTRS(); pg8::Gemm g{WSP(WS_S), WSP(WS_WO), NP, DM, DM}; pg8::StaticOrder S; S.init(NP, DM, G, bx); \
              pg8::EpiWo E{P.x_p, P.x_s, P.out, WSP(WS_V), (float*)(P.ws + WS_PART)}; \
              pg8::gemm_phase<pg8::EpiWo, pg8::StaticOrder, PG8_ALIGN, PG8_SP2>(lds, g, S, E); \
              pg8::MiniWo ME{P.x_s, P.out, WSP(WS_V), (float*)(P.ws + WS_PART)}; \
              pg8::mini_gemm(lds, WSP(WS_S), WSP(WS_WO), DM, NP + (bx >> 4) * 64, (bx & 15) * 64, ME); } }
#define RUN5 { PHASE_PTRS(); \
            pg8::Gemm g{WSP(WS_V), WSP(WS_WPG), NP, DM, DM}; pg8::StaticOrder S; S.init(NP, DM, G, bx); \
            pg8::EpiPg E{P.out, WSP(WS_PE), (const float*)(P.ws + WS_PART)}; \
            pg8::gemm_phase<pg8::EpiPg, pg8::StaticOrder, PG8_ALIGN, PG8_SP2>(lds, g, S, E); \
            pg8::MiniPg ME{P.out, WSP(WS_PE), (const float*)(P.ws + WS_PART)}; \
            pg8::mini_gemm(lds, WSP(WS_V), WSP(WS_WPG), DM, NP + (bx >> 4) * 64, (bx & 15) * 64, ME); }
#define RUN6 { PHASE_PTRS(); \
            float* H = P.out; \
            f32x4 gf[4]; \
            _Pragma("unroll") for (int j = 0; j < 4; ++j) gf[j] = *(const f32x4*)(P.g_final + j * 256 + lane * 4); \
            for (int m = gw; m < T; m += NGW) { \
                GAS f32x4* hr = (GAS f32x4*)(H + (size_t)m * DM) + lane; \
                f32x4 v[4]; float sq = 0.f; \
                _Pragma("unroll") for (int j = 0; j < 4; ++j) { v[j] = hr[64 * j]; sq += (v[j].x * v[j].x + v[j].y * v[j].y) + (v[j].z * v[j].z + v[j].w * v[j].w); } \
                const float rstd = 1.0f / sqrtf(wave_sum(sq) * (1.0f / DM) + EPS); \
                _Pragma("unroll") for (int j = 0; j < 4; ++j) hr[64 * j] = v[j] * rstd * gf[j]; \
            } }
#ifndef PROG_STEPS
#define PROG_STEPS X(0) X(1) X(2) X(3) X(4) X(5) X(6)
#endif
    enum { STEP_BASE = __COUNTER__ + 1 };
#if MK_PER_PHASE
#define X(k) { const int si_ = __COUNTER__ - STEP_BASE; if (lo == si_) RUN##k }
#else
#define X(k) { const int si_ = __COUNTER__ - STEP_BASE; if (si_ > 0) xcd_barrier(bar); RUN##k }
#endif
    PROG_STEPS
#undef X
#undef WSP
}

extern "C" void kernel_launch(void* const* d_in, const int* in_sizes, int n_in, void* d_out, int out_size, void* d_ws, size_t ws_size, hipStream_t stream) {
    static int grid = 0;
    if (grid == 0) {
        if (n_in != 20 || ws_size < WS_END) { fprintf(stderr, "kernel_launch: unexpected n_in %d / ws %zu\n", n_in, ws_size); grid = -1; return; }
        int dev = 0, cus = 0, per_cu = 0;
        if (hipGetDevice(&dev) != hipSuccess || hipDeviceGetAttribute(&cus, hipDeviceAttributeMultiprocessorCount, dev) != hipSuccess) { grid = -1; return; }
        if (hipFuncSetAttribute((const void*)fwd_megakernel, hipFuncAttributeMaxDynamicSharedMemorySize, LDS_BYTES) != hipSuccess) { fprintf(stderr, "kernel_launch: hipFuncSetAttribute failed\n"); grid = -1; return; }
        if (hipOccupancyMaxActiveBlocksPerMultiprocessor(&per_cu, (const void*)fwd_megakernel, NWAVES * 64, LDS_BYTES) != hipSuccess || per_cu < 1) { fprintf(stderr, "kernel_launch: occupancy query says %d\n", per_cu); (void)hipGetLastError(); per_cu = 1; }
        grid = cus;
    }
    if (grid < 0) return;
    (void)hipMemsetAsync((char*)d_ws + WS_CTL, 0, CTL_ZERO_BYTES, stream);
    Args a{};
    const float** pp = (const float**)&a.p;
    for (int i = 0; i < 20; ++i) pp[i] = (const float*)d_in[i];
    a.p.out = (float*)d_out; a.p.ws = (unsigned char*)d_ws;
#if MK_PER_PHASE
    for (int ph = 0; ph < 64; ++ph) { a.ph_lo = ph; a.ph_hi = ph + 1; hipLaunchKernelGGL(fwd_megakernel, dim3(grid), dim3(NWAVES * 64), LDS_BYTES, stream, a); }
#else
    a.ph_lo = 0; a.ph_hi = 64;
    void* kargs[] = {&a};
    hipError_t e = hipLaunchCooperativeKernel((const void*)fwd_megakernel, dim3(grid), dim3(NWAVES * 64), kargs, LDS_BYTES, stream);
    if (e != hipSuccess) fprintf(stderr, "kernel_launch: cooperative launch failed: %s (grid %d)\n", hipGetErrorString(e), grid);
#endif
}
```

```cpp
#include <hip/hip_runtime.h>
#include <cstdio>
#include <cstdint>

#ifndef MK_PER_PHASE
#define MK_PER_PHASE 0
#endif

namespace pg8 {
#define PG8_LAS __attribute__((address_space(3)))
typedef unsigned short bf16_t;
typedef short bf16x8 __attribute__((ext_vector_type(8)));
typedef float f32x4 __attribute__((ext_vector_type(4)));
typedef unsigned u32x4 __attribute__((ext_vector_type(4)));
typedef unsigned u32x2 __attribute__((ext_vector_type(2)));
constexpr int BM = 256, BK = 64, HALF = 128, HTB = HALF * BK * 2, STAGE_BYTES = 8 * HTB, NXCD = 8, WGM = 8;

__host__ __device__ __forceinline__ int lds_byte(int r, int c) { const int st = (r >> 4) * 2 + (c >> 5), rr = r & 15, cc = c & 31, ob = rr * 64 + cc * 2; return st * 1024 + (ob ^ (((ob >> 9) & 1) << 5)); }
__host__ __device__ __forceinline__ void stage_rc(int b, int& R, int& C) { const int st = b / 1024, sb = b % 1024, swz = sb ^ (((sb >> 9) & 1) << 5); R = (st >> 1) * 16 + swz / 64; C = (st & 1) * 32 + (swz % 64) / 2; }
__host__ __device__ __forceinline__ int perm32(int rho) { const int n = rho >> 4, i = rho & 15; return 8 * (i >> 2) + 4 * n + (i & 3); }

struct Unit { int pm, pn; };
struct Gemm { const bf16_t* A; const bf16_t* Bt; int M, N, K; };

struct StaticOrder {
    int nM, nN, nwg, G, c, pm0;
    __host__ __device__ void init(int M, int N, int G_, int c_, int pm0_ = 0) { nM = M / BM; nN = N / BM; nwg = nM * nN; G = G_; c = c_; pm0 = pm0_; }
    __host__ __device__ bool next(int i, Unit& u) const {
        const long L = (long)i * G + c; if (c < 0 || L >= nwg) return false;
        int wgid = (int)L; { const int q = nwg / NXCD, r = nwg % NXCD, xcd = wgid % NXCD, off = wgid / NXCD; wgid = (xcd < r ? xcd * (q + 1) : r * (q + 1) + (xcd - r) * q) + off; }
        const int nig = WGM * nN, gid = wgid / nig, fm = gid * WGM, gsz = (nM - fm) < WGM ? (nM - fm) : WGM;
        u.pm = pm0 + fm + ((wgid % nig) % gsz); u.pn = (wgid % nig) / gsz; return true;
    }
    __device__ __forceinline__ void a_ready(const Unit&) const {}
    __device__ __forceinline__ void done(const Unit&) const {}
};

typedef __bf16 bf16x2_n __attribute__((ext_vector_type(2)));
typedef float f32x2_n __attribute__((ext_vector_type(2)));
__device__ __forceinline__ unsigned cvt_pk_bf16(float lo, float hi) { unsigned r; asm volatile("s_nop 0\n\tv_cvt_pk_bf16_f32 %0, %1, %2" : "=v"(r) : "v"(lo), "v"(hi)); return r; }
__device__ __forceinline__ float bf_lo(unsigned u) { return __uint_as_float(u << 16); }
__device__ __forceinline__ float bf_hi(unsigned u) { return __uint_as_float(u & 0xffff0000u); }
__device__ __forceinline__ float sigmoidf_(float x) { return __builtin_amdgcn_rcpf(1.0f + __expf(-x)); }
__device__ __forceinline__ u32x4 pack8(const f32x4 a, const f32x4 b) { u32x4 w; w.x = cvt_pk_bf16(a[0], a[1]); w.y = cvt_pk_bf16(a[2], a[3]); w.z = cvt_pk_bf16(b[0], b[1]); w.w = cvt_pk_bf16(b[2], b[3]); return w; }
__device__ __forceinline__ void unpack8(const u32x4 w, f32x4& a, f32x4& b) { a[0] = bf_lo(w.x); a[1] = bf_hi(w.x); a[2] = bf_lo(w.y); a[3] = bf_hi(w.y); b[0] = bf_lo(w.z); b[1] = bf_hi(w.z); b[2] = bf_lo(w.w); b[3] = bf_hi(w.w); }


typedef __amdgpu_buffer_rsrc_t rsrc_t;
__device__ __forceinline__ rsrc_t mkrsrc(const void* p) { return __builtin_amdgcn_make_buffer_rsrc(const_cast<void*>(p), 0, 0x7fffffff, 0x00020000); }
__device__ __forceinline__ u32x4 bld16(rsrc_t r, unsigned voff, unsigned soff) { return __builtin_amdgcn_raw_buffer_load_b128(r, (int)voff, (int)soff, 0); }
__device__ __forceinline__ void bst16(rsrc_t r, unsigned voff, unsigned soff, u32x4 v) { unsigned vo = voff + soff; asm volatile("" : "+v"(vo)); __builtin_amdgcn_raw_buffer_store_b128(v, r, (int)vo, 0, 0); }
__device__ __forceinline__ f32x4 as_f(u32x4 v) { return __builtin_bit_cast(f32x4, v); }
__device__ __forceinline__ u32x4 as_u(f32x4 v) { return __builtin_bit_cast(u32x4, v); }

struct EpiInProj {
    static constexpr bool PERM = true, AFTER_DRAIN = false, MID = false;
    bf16_t *QZ, *S, *V, *GA, *GB;
    __device__ __forceinline__ void mid(f32x4 (&)[2][2][4][2], const Unit&, int, int, int, int) const {}
    template <int TYPE> __device__ __forceinline__ void pair(const f32x4 (&acc)[2][2][4][2], rsrc_t r, unsigned sbase, unsigned voff, unsigned ldb) const {
#pragma unroll
        for (int ai = 0; ai < 2; ++ai)
#pragma unroll
            for (int m = 0; m < 4; ++m) {
                f32x4 o[2];
#pragma unroll
                for (int bj = 0; bj < 2; ++bj) { const f32x4 X = acc[ai][bj][m][0], Y = acc[ai][bj][m][1];
#pragma unroll
                    for (int j = 0; j < 4; ++j) { if (TYPE == 1) o[bj][j] = X[j] * Y[j]; else { const float sg = sigmoidf_(Y[j]); o[bj][j] = TYPE == 0 ? X[j] * Y[j] * sg : X[j] * sg; } } }
                bst16(r, voff, sbase + (unsigned)(ai * HALF + m * 16) * ldb, pack8(o[0], o[1]));
            }
    }
    template <int TYPE> __device__ __forceinline__ void single(const f32x4 (&acc)[2][2][4][2], rsrc_t r, unsigned sbase, unsigned voff, unsigned ldb) const {
#pragma unroll
        for (int ai = 0; ai < 2; ++ai)
#pragma unroll
            for (int m = 0; m < 4; ++m)
#pragma unroll
                for (int bj = 0; bj < 2; ++bj) { f32x4 v0 = acc[ai][bj][m][0], v1 = acc[ai][bj][m][1];
#pragma unroll
                    for (int j = 0; j < 4; ++j) { const float s0 = sigmoidf_(v0[j]), s1 = sigmoidf_(v1[j]); v0[j] = TYPE == 0 ? v0[j] * s0 : s0; v1[j] = TYPE == 0 ? v1[j] * s1 : s1; }
                    bst16(r, voff, sbase + (unsigned)(ai * HALF + m * 16) * ldb + bj * (HALF * 2), pack8(v0, v1)); }
    }
    __device__ __forceinline__ void operator()(const f32x4 (&acc)[2][2][4][2], const Unit& u, int wr, int wc, int fr, int fq) const {
        const unsigned urow = u.pm * BM + wr * 64, pn = u.pn;
        if (pn < 24) {
            const unsigned type = pn >> 3, ucb = (pn & 7) * 128 + 32 * wc;
            if (type == 0) pair<0>(acc, mkrsrc(QZ), (urow * 2048 + ucb) * 2, (unsigned)(fr * 2048 + 8 * fq) * 2u, 4096);
#if !defined(DBG_ONLYQZ)
            else if (type == 1) pair<1>(acc, mkrsrc(S), (urow * 1024 + ucb) * 2, (unsigned)(fr * 1024 + 8 * fq) * 2u, 2048);
            else pair<2>(acc, mkrsrc(V), (urow * 1024 + ucb) * 2, (unsigned)(fr * 1024 + 8 * fq) * 2u, 2048);
#endif
        } else {
            const unsigned t = (pn - 24) >> 2, ucb = ((pn - 24) & 3) * 256 + wc * 32;
            if (t == 0) single<0>(acc, mkrsrc(QZ), (urow * 2048 + 1024 + ucb) * 2, (unsigned)(fr * 2048 + 8 * fq) * 2u, 4096);
#if !defined(DBG_ONLYQZ)
            else if (t == 1) single<1>(acc, mkrsrc(GA), (urow * 1024 + ucb) * 2, (unsigned)(fr * 1024 + 8 * fq) * 2u, 2048);
            else single<1>(acc, mkrsrc(GB), (urow * 1024 + ucb) * 2, (unsigned)(fr * 1024 + 8 * fq) * 2u, 2048);
#endif
        }
    }
};
struct EpiPlain {
    static constexpr bool PERM = true, AFTER_DRAIN = false, MID = false;
    bf16_t* O; int ldc;
    __device__ __forceinline__ void mid(f32x4 (&)[2][2][4][2], const Unit&, int, int, int, int) const {}
    __device__ __forceinline__ void operator()(const f32x4 (&acc)[2][2][4][2], const Unit& u, int wr, int wc, int fr, int fq) const {
#if defined(DBG_DUMP) && DBG_DUMP == 2
        if (u.pn >= 8) return;
#endif
        const rsrc_t r = mkrsrc(O); const unsigned sb = ((unsigned)(u.pm * BM + wr * 64) * ldc + u.pn * BM + wc * 32) * 2, voff = (unsigned)(fr * ldc + 8 * fq) * 2u;
#pragma unroll
        for (int ai = 0; ai < 2; ++ai)
#pragma unroll
            for (int m = 0; m < 4; ++m)
#pragma unroll
                for (int bj = 0; bj < 2; ++bj) bst16(r, voff, sb + (unsigned)(ai * HALF + m * 16) * ldc * 2 + bj * (HALF * 2), pack8(acc[ai][bj][m][0], acc[ai][bj][m][1]));
    }
};
struct EpiOutGate {
    static constexpr bool PERM = true, AFTER_DRAIN = false, MID = true;
    const bf16_t *GA, *GB; bf16_t* Mo;
    __device__ __forceinline__ void mid(f32x4 (&acc)[2][2][4][2], const Unit& u, int wr, int wc, int fr, int fq) const {
        const rsrc_t ra = mkrsrc(GA), rb = mkrsrc(GB);
        const unsigned sb = ((unsigned)(u.pm * BM + wr * 64) * 1024 + u.pn * BM + wc * 32) * 2, voff = (unsigned)(fr * 1024 + 8 * fq) * 2u;
#pragma unroll
        for (int ai = 0; ai < 2; ++ai)
#pragma unroll
            for (int m = 0; m < 4; ++m) {
#pragma unroll
                for (int bj = 0; bj < 2; ++bj) { const unsigned so = sb + (unsigned)(ai * HALF + m * 16) * 2048 + bj * 256;
                    const u32x4 ga = bld16(ra, voff, so), gb = bld16(rb, voff, so); f32x4 a0, a1, b0, b1; unpack8(ga, a0, a1); unpack8(gb, b0, b1);
#pragma unroll
                    for (int j = 0; j < 4; ++j) { acc[ai][bj][m][0][j] *= a0[j] * __builtin_amdgcn_rcpf(fmaxf(b0[j], 1e-30f)); acc[ai][bj][m][1][j] *= a1[j] * __builtin_amdgcn_rcpf(fmaxf(b1[j], 1e-30f)); } }
                asm volatile("" ::: "memory"); }
    }
    __device__ __forceinline__ void operator()(const f32x4 (&acc)[2][2][4][2], const Unit& u, int wr, int wc, int fr, int fq) const {
        const rsrc_t rb = mkrsrc(GB), ro = mkrsrc(Mo);
        const unsigned sb = ((unsigned)(u.pm * BM + wr * 64) * 1024 + u.pn * BM + wc * 32) * 2, voff = (unsigned)(fr * 1024 + 8 * fq) * 2u;
#pragma unroll
        for (int ai = 0; ai < 2; ++ai)
#pragma unroll
            for (int m = 0; m < 4; ++m) {
#pragma unroll
                for (int bj = 0; bj < 2; ++bj) { const unsigned so = sb + (unsigned)(ai * HALF + m * 16) * 2048 + bj * 256;
                    const u32x4 gb = bld16(rb, voff, so); f32x4 b0, b1; unpack8(gb, b0, b1);
                    bst16(ro, voff, so, pack8(acc[ai][bj][m][0] * b0, acc[ai][bj][m][1] * b1)); }
                asm volatile("" ::: "memory"); }
    }
};
struct EpiWo {
    static constexpr bool PERM = true, AFTER_DRAIN = false, MID = false;
    const float *xp, *xs; float* H; bf16_t* HB; float* part;
    __device__ __forceinline__ void mid(f32x4 (&)[2][2][4][2], const Unit&, int, int, int, int) const {}
    __device__ __forceinline__ void operator()(const f32x4 (&acc)[2][2][4][2], const Unit& u, int wr, int wc, int fr, int fq) const {
        const unsigned urow = u.pm * BM + wr * 64, ucol = u.pn * BM + wc * 32;
        const bool smp = u.pm >= 64;
        const rsrc_t rx = mkrsrc(smp ? xs : xp), rh = mkrsrc(H), rb = mkrsrc(HB);
        const unsigned ue = urow * 1024 + ucol, uex = (smp ? urow - 16384u : urow) * 1024 + ucol, ve = (unsigned)(fr * 1024 + 8 * fq);
        float* pq = part + (size_t)(urow + fr) * 16 + u.pn * 4 + wc;
#pragma unroll
        for (int ai = 0; ai < 2; ++ai)
#pragma unroll
            for (int m = 0; m < 4; ++m) { const unsigned ro = (unsigned)(ai * HALF + m * 16) * 1024; float ss = 0.f;
#pragma unroll
                for (int bj = 0; bj < 2; ++bj) {
                    const f32x4 h0 = as_f(bld16(rx, ve * 4u, (uex + ro) * 4u + bj * 512)) + acc[ai][bj][m][0], h1 = as_f(bld16(rx, ve * 4u, (uex + ro) * 4u + bj * 512 + 16)) + acc[ai][bj][m][1];
                    bst16(rb, ve * 2u, (ue + ro) * 2u + bj * 256, pack8(h0, h1));
                    ss += (h0[0] * h0[0] + h0[1] * h0[1]) + (h0[2] * h0[2] + h0[3] * h0[3]) + (h1[0] * h1[0] + h1[1] * h1[1]) + (h1[2] * h1[2] + h1[3] * h1[3]);
                    asm volatile("" ::: "memory"); }
                ss += __shfl_xor(ss, 16); ss += __shfl_xor(ss, 32);
                if (fq == 0) pq[(ai * HALF + m * 16) * 16] = ss;
                asm volatile("" ::: "memory"); }
    }
};
struct EpiPg {
    static constexpr bool PERM = true, AFTER_DRAIN = false, MID = false;
    float* H; const bf16_t* HB; const bf16_t* PE; const float* part;
    __device__ __forceinline__ void mid(f32x4 (&)[2][2][4][2], const Unit&, int, int, int, int) const {}
    __device__ __forceinline__ void operator()(const f32x4 (&acc)[2][2][4][2], const Unit& u, int wr, int wc, int fr, int fq) const {
        const unsigned urow = u.pm * BM + wr * 64, ucol = u.pn * BM + wc * 32;
        const rsrc_t rh = mkrsrc(H), rp = mkrsrc(PE), rhb = mkrsrc(HB);
        const unsigned ue = urow * 1024 + ucol, ve = (unsigned)(fr * 1024 + 8 * fq);
        const float* pq = part + (size_t)(urow + fr) * 16 + 4 * fq;
#pragma unroll
        for (int ai = 0; ai < 2; ++ai)
#pragma unroll
            for (int m = 0; m < 4; ++m) { const unsigned ro = (unsigned)(ai * HALF + m * 16) * 1024;
                float rs; { const f32x4 pv = *(const f32x4*)(pq + (ai * HALF + m * 16) * 16); rs = (pv[0] + pv[1]) + (pv[2] + pv[3]); rs += __shfl_xor(rs, 16); rs += __shfl_xor(rs, 32); }
                const float rstd = 1.0f / sqrtf(rs * (1.0f / 1024.0f) + 1e-6f);
#pragma unroll
                for (int bj = 0; bj < 2; ++bj) {
                    f32x4 h0, h1; unpack8(bld16(rhb, ve * 2u, (ue + ro) * 2u + bj * 256), h0, h1); const u32x4 pe = bld16(rp, ve * 2u, (ue + ro) * 2u + bj * 256); f32x4 p0, p1; unpack8(pe, p0, p1);
#pragma unroll
                    for (int j = 0; j < 4; ++j) { h0[j] += sigmoidf_(acc[ai][bj][m][0][j] * rstd) * p0[j]; h1[j] += sigmoidf_(acc[ai][bj][m][1][j] * rstd) * p1[j]; }
                    bst16(rh, ve * 4u, (ue + ro) * 4u + bj * 512, as_u(h0)); bst16(rh, ve * 4u, (ue + ro) * 4u + bj * 512 + 16, as_u(h1)); }
                asm volatile("" ::: "memory"); }
    }
};

__device__ __forceinline__ void agent_store_f32(float* p, float v) { __hip_atomic_store(p, v, __ATOMIC_RELAXED, __HIP_MEMORY_SCOPE_AGENT); }
__device__ __forceinline__ float agent_load_f32(const float* p) { return __hip_atomic_load(p, __ATOMIC_RELAXED, __HIP_MEMORY_SCOPE_AGENT); }
__device__ __forceinline__ void wait_count(unsigned* cnt, unsigned want) {
    unsigned sp = 0;
    while ((unsigned)__builtin_amdgcn_readfirstlane(__hip_atomic_load(cnt, __ATOMIC_RELAXED, __HIP_MEMORY_SCOPE_AGENT)) < want) { __builtin_amdgcn_s_sleep(2); if (++sp > (1u << 21)) break; }
    __builtin_amdgcn_fence(__ATOMIC_ACQUIRE, "agent");
}
struct EpiPgFinal {
    static constexpr bool PERM = true, AFTER_DRAIN = true, MID = false;
    float* Y; const bf16_t* HB; const bf16_t* PE; const float* part; const float* gfin; float* xs; unsigned* cnt;
    __device__ __forceinline__ void mid(f32x4 (&)[2][2][4][2], const Unit&, int, int, int, int) const {}
    __device__ __forceinline__ void fused(f32x4 (&acc)[2][2][4][2], const Unit& u, int wr, int wc, int fr, int fq, PG8_LAS unsigned char* lds, int wid, int lane) const {
        const unsigned urow = u.pm * BM + wr * 64, ucol = u.pn * BM + wc * 32;
        const rsrc_t ry = mkrsrc(Y), rp = mkrsrc(PE), rhb = mkrsrc(HB);
        const unsigned ue = urow * 1024 + ucol, ve = (unsigned)(fr * 1024 + 8 * fq);
        const float* pq = part + (size_t)(urow + fr) * 16 + 4 * fq;
        PG8_LAS float* Pt = (PG8_LAS float*)lds;
        PG8_LAS float* St = (PG8_LAS float*)(lds + 4096);
#pragma unroll
        for (int ai = 0; ai < 2; ++ai)
#pragma unroll
            for (int m = 0; m < 4; ++m) { const unsigned ro = (unsigned)(ai * HALF + m * 16) * 1024;
                float rs; { const f32x4 pv = *(const f32x4*)(pq + (ai * HALF + m * 16) * 16); rs = (pv[0] + pv[1]) + (pv[2] + pv[3]); rs += __shfl_xor(rs, 16); rs += __shfl_xor(rs, 32); }
                const float rstd = 1.0f / sqrtf(rs * (1.0f / 1024.0f) + 1e-6f); float ss = 0.f;
#pragma unroll
                for (int bj = 0; bj < 2; ++bj) {
                    f32x4 h0, h1; unpack8(bld16(rhb, ve * 2u, (ue + ro) * 2u + bj * 256), h0, h1); const u32x4 pe = bld16(rp, ve * 2u, (ue + ro) * 2u + bj * 256); f32x4 p0, p1; unpack8(pe, p0, p1);
#pragma unroll
                    for (int j = 0; j < 4; ++j) { h0[j] += sigmoidf_(acc[ai][bj][m][0][j] * rstd) * p0[j]; h1[j] += sigmoidf_(acc[ai][bj][m][1][j] * rstd) * p1[j]; }
                    acc[ai][bj][m][0] = h0; acc[ai][bj][m][1] = h1;
                    ss += (h0[0] * h0[0] + h0[1] * h0[1]) + (h0[2] * h0[2] + h0[3] * h0[3]) + (h1[0] * h1[0] + h1[1] * h1[1]) + (h1[2] * h1[2] + h1[3] * h1[3]); }
                ss += __shfl_xor(ss, 16); ss += __shfl_xor(ss, 32);
                if (fq == 0) Pt[(ai * HALF + wr * 64 + m * 16 + fr) * 4 + wc] = ss;
                asm volatile("" ::: "memory"); }
        asm volatile("s_waitcnt lgkmcnt(0)" ::: "memory"); __builtin_amdgcn_s_barrier(); asm volatile("" ::: "memory");
        const int row = wid * 32 + (lane & 31);
        if (lane < 32) { const f32x4 pv = *(const PG8_LAS f32x4*)(Pt + row * 4); agent_store_f32(xs + (size_t)(u.pm * BM + row) * 4 + u.pn, (pv[0] + pv[1]) + (pv[2] + pv[3])); }
        asm volatile("s_waitcnt vmcnt(0)" ::: "memory");
        if (lane == 0) __hip_atomic_fetch_add(cnt + 64 * u.pm, 1u, __ATOMIC_RELAXED, __HIP_MEMORY_SCOPE_AGENT);
        if (wid == 0) wait_count(cnt + 64 * u.pm, 32u);
        asm volatile("s_waitcnt vmcnt(0) lgkmcnt(0)" ::: "memory"); __builtin_amdgcn_s_barrier(); asm volatile("" ::: "memory");
        if (lane < 32) { const float* sp = xs + (size_t)(u.pm * BM + row) * 4; const float q = (agent_load_f32(sp) + agent_load_f32(sp + 1)) + (agent_load_f32(sp + 2) + agent_load_f32(sp + 3));
            St[row] = 1.0f / sqrtf(q * (1.0f / 1024.0f) + 1e-6f); }
        asm volatile("s_waitcnt lgkmcnt(0)" ::: "memory"); __builtin_amdgcn_s_barrier(); asm volatile("" ::: "memory");
        f32x4 g[2][2];
#pragma unroll
        for (int bj = 0; bj < 2; ++bj)
#pragma unroll
            for (int n = 0; n < 2; ++n) g[bj][n] = *(const f32x4*)(gfin + ucol + bj * HALF + 8 * fq + 4 * n);
#pragma unroll
        for (int ai = 0; ai < 2; ++ai)
#pragma unroll
            for (int m = 0; m < 4; ++m) { const unsigned ro = (unsigned)(ai * HALF + m * 16) * 1024; const float r3 = St[ai * HALF + wr * 64 + m * 16 + fr];
#pragma unroll
                for (int bj = 0; bj < 2; ++bj) { bst16(ry, ve * 4u, (ue + ro) * 4u + bj * 512, as_u(acc[ai][bj][m][0] * r3 * g[bj][0])); bst16(ry, ve * 4u, (ue + ro) * 4u + bj * 512 + 16, as_u(acc[ai][bj][m][1] * r3 * g[bj][1])); } }
    }
};

template <class Epi, class Sched, bool ALIGN_EPI = false, bool SP2 = false>
__device__ __forceinline__ void gemm_phase(PG8_LAS unsigned char* lds, const Gemm g, const Sched& S, const Epi& E) {
    int tid = threadIdx.x; asm volatile("" : "+v"(tid));
    const int wid = __builtin_amdgcn_readfirstlane(tid >> 6), lane = tid & 63, wr = wid >> 2, wc = wid & 3, fr = lane & 15, fq = lane >> 4;
    const int K = g.K, nt = K / BK;
    unsigned voffA[2], voffB[2];
#pragma unroll
    for (int i = 0; i < 2; ++i) { int R, C; stage_rc(tid * 16 + i * 8192, R, C); const int Rb = Epi::PERM ? ((R & ~31) + perm32(R & 31)) : R;
        voffA[i] = (unsigned)(R * K + C) * 2u; voffB[i] = (unsigned)(Rb * K + C) * 2u; }
    const size_t kstep = (size_t)(BK * 2);
    const size_t hstep = (size_t)HALF * K * 2;
    const size_t tstep = 2 * hstep;
    const unsigned ldsw = (unsigned)wid * 1024u;
    const int aoff = lds_byte(wr * 64 + fr, fq * 8), boff = lds_byte(wc * 32 + fr, fq * 8);
#define PG8_SA(b, h) (((b) * 2 + (h)) * HTB)
#define PG8_SB(b, h) ((4 + (b) * 2 + (h)) * HTB)
#define PG8_STAGE(bufoff, gbase, voff) do { _Pragma("unroll") for (int _i = 0; _i < 2; ++_i) \
        __builtin_amdgcn_global_load_lds((const unsigned*)((const char*)(gbase) + (voff)[_i]), (PG8_LAS unsigned*)(lds + (bufoff) + ldsw + _i * 8192), 16, 0, 0); } while (0)
#define PG8_LDA(dst, b, h) do { _Pragma("unroll") for (int m = 0; m < 4; ++m) _Pragma("unroll") for (int k = 0; k < 2; ++k) dst[m][k] = *(const PG8_LAS bf16x8*)(lds + PG8_SA(b, h) + aoff + m * 2048 + k * 1024); } while (0)
#define PG8_LDB(dst, b, h) do { _Pragma("unroll") for (int n = 0; n < 2; ++n) _Pragma("unroll") for (int k = 0; k < 2; ++k) dst[n][k] = *(const PG8_LAS bf16x8*)(lds + PG8_SB(b, h) + boff + n * 2048 + k * 1024); } while (0)
#define PG8_MMA(ai, bj, At, Bt) do { __builtin_amdgcn_s_setprio(1); _Pragma("unroll") for (int m = 0; m < 4; ++m) _Pragma("unroll") for (int n = 0; n < 2; ++n) _Pragma("unroll") for (int k = 0; k < 2; ++k) \
        acc[ai][bj][m][n] = __builtin_amdgcn_mfma_f32_16x16x32_bf16(Bt[n][k], At[m][k], acc[ai][bj][m][n], 0, 0, 0); __builtin_amdgcn_s_setprio(0); } while (0)
#define PG8_WAIT_V(n) asm volatile("s_waitcnt vmcnt(" #n ")" ::: "memory")
#define PG8_WAIT_L(n) asm volatile("s_waitcnt lgkmcnt(" #n ")" ::: "memory")
#define PG8_BAR __builtin_amdgcn_s_barrier()
#define PG8_SCHED __builtin_amdgcn_sched_barrier(0)
    Unit cur, nxt; int ui = 0;
    if (!S.next(0, cur)) return;
    f32x4 acc[2][2][4][2];
#pragma unroll
    for (int a = 0; a < 2; ++a)
#pragma unroll
        for (int b = 0; b < 2; ++b)
#pragma unroll
            for (int m = 0; m < 4; ++m)
#pragma unroll
                for (int n = 0; n < 2; ++n) acc[a][b][m][n] = (f32x4){0.f, 0.f, 0.f, 0.f};
    bf16x8 At[4][2], B0[2][2], B1[2][2];
    const char* cA = (const char*)g.A + (size_t)cur.pm * tstep; const char* cB = (const char*)g.Bt + (size_t)cur.pn * tstep;
    S.a_ready(cur);
    if constexpr (SP2) {
        PG8_STAGE(PG8_SB(0, 0), cB, voffB); PG8_STAGE(PG8_SB(0, 1), cB + hstep, voffB); PG8_STAGE(PG8_SA(0, 0), cA, voffA); PG8_STAGE(PG8_SA(0, 1), cA + hstep, voffA);
        if (wr == 1) PG8_BAR;
        PG8_WAIT_V(2); PG8_BAR;
        PG8_STAGE(PG8_SB(1, 0), cB + kstep, voffB); PG8_STAGE(PG8_SA(1, 0), cA + kstep, voffA); PG8_STAGE(PG8_SB(1, 1), cB + hstep + kstep, voffB);
        PG8_WAIT_V(6); PG8_BAR;
    } else {
        PG8_STAGE(PG8_SB(0, 0), cB, voffB); PG8_STAGE(PG8_SA(0, 0), cA, voffA); PG8_STAGE(PG8_SB(0, 1), cB + hstep, voffB); PG8_STAGE(PG8_SA(0, 1), cA + hstep, voffA);
        if (wr == 1) PG8_BAR;
        PG8_WAIT_V(4); PG8_BAR;
        PG8_STAGE(PG8_SB(1, 0), cB + kstep, voffB); PG8_STAGE(PG8_SA(1, 0), cA + kstep, voffA); PG8_STAGE(PG8_SB(1, 1), cB + hstep + kstep, voffB);
        PG8_WAIT_V(6); PG8_BAR;
    }
    for (;;) {
        const bool has_next = S.next(ui + 1, nxt);
        const char* nA = has_next ? (const char*)g.A + (size_t)nxt.pm * tstep : cA; const char* nB = has_next ? (const char*)g.Bt + (size_t)nxt.pn * tstep : cB;
        for (int th = 0; th < (Epi::MID ? 2 : 1); ++th) {
        if constexpr (Epi::MID) { if (th == 1) E.mid(acc, cur, wr, wc, fr, fq); }
        const int t_lo = Epi::MID ? th * (nt >> 1) : 0, t_hi = Epi::MID ? (th + 1) * (nt >> 1) : nt;
#pragma unroll 1
        for (int t = t_lo; t < t_hi; t += 2) {
            const bool last = (t == nt - 2);
            const char* a1 = cA + (size_t)(t + 1) * kstep;
            const char* a2 = last ? nA : cA + (size_t)(t + 2) * kstep; const char* b2 = last ? nB : cB + (size_t)(t + 2) * kstep;
            const char* a3 = a2 + kstep; const char* b3 = b2 + kstep;
            if (last && has_next) S.a_ready(nxt);
            if constexpr (SP2) {
            PG8_LDB(B0, 0, 0); PG8_LDB(B1, 0, 1); PG8_SCHED; PG8_LDA(At, 0, 0); PG8_STAGE(PG8_SA(1, 1), a1 + hstep, voffA);
            PG8_WAIT_V(8); PG8_WAIT_L(0); PG8_BAR; PG8_MMA(0, 0, At, B0); PG8_MMA(0, 1, At, B1); PG8_BAR; PG8_SCHED;
            PG8_LDA(At, 0, 1); PG8_STAGE(PG8_SB(0, 0), b2, voffB); PG8_STAGE(PG8_SB(0, 1), b2 + hstep, voffB); PG8_STAGE(PG8_SA(0, 0), a2, voffA);
            PG8_WAIT_V(8); PG8_WAIT_L(0); PG8_BAR; PG8_MMA(1, 0, At, B0); PG8_MMA(1, 1, At, B1); PG8_BAR; PG8_SCHED;
            PG8_LDB(B0, 1, 0); PG8_LDB(B1, 1, 1); PG8_SCHED; PG8_LDA(At, 1, 0); PG8_STAGE(PG8_SA(0, 1), a2 + hstep, voffA);
            PG8_WAIT_V(8); PG8_WAIT_L(0); PG8_BAR; PG8_MMA(0, 0, At, B0); PG8_MMA(0, 1, At, B1); PG8_BAR; PG8_SCHED;
            PG8_LDA(At, 1, 1); PG8_STAGE(PG8_SB(1, 0), b3, voffB); PG8_STAGE(PG8_SB(1, 1), b3 + hstep, voffB); PG8_STAGE(PG8_SA(1, 0), a3, voffA);
            PG8_WAIT_V(8); PG8_WAIT_L(0); PG8_BAR; PG8_MMA(1, 0, At, B0); PG8_MMA(1, 1, At, B1); PG8_BAR; PG8_SCHED;
            } else {
            PG8_LDB(B0, 0, 0); PG8_SCHED; PG8_LDA(At, 0, 0); PG8_STAGE(PG8_SA(1, 1), a1 + hstep, voffA);
            PG8_WAIT_L(8); PG8_BAR; PG8_WAIT_L(0); PG8_MMA(0, 0, At, B0); PG8_BAR; PG8_SCHED;
            PG8_LDB(B1, 0, 1); PG8_STAGE(PG8_SB(0, 0), b2, voffB);
            PG8_BAR; PG8_WAIT_L(0); PG8_MMA(0, 1, At, B1); PG8_BAR;
            PG8_LDA(At, 0, 1); PG8_STAGE(PG8_SA(0, 0), a2, voffA);
            PG8_BAR; PG8_WAIT_L(0); PG8_MMA(1, 0, At, B0); PG8_BAR; PG8_SCHED;
            PG8_STAGE(PG8_SB(0, 1), b2 + hstep, voffB);
            PG8_WAIT_V(6); PG8_BAR; PG8_MMA(1, 1, At, B1); PG8_BAR;
            PG8_LDB(B0, 1, 0); PG8_SCHED; PG8_LDA(At, 1, 0); PG8_STAGE(PG8_SA(0, 1), a2 + hstep, voffA);
            PG8_WAIT_L(8); PG8_BAR; PG8_WAIT_L(0); PG8_MMA(0, 0, At, B0); PG8_BAR; PG8_SCHED;
            PG8_LDB(B1, 1, 1); PG8_STAGE(PG8_SB(1, 0), b3, voffB);
            PG8_BAR; PG8_WAIT_L(0); PG8_MMA(0, 1, At, B1); PG8_BAR;
            PG8_LDA(At, 1, 1); PG8_STAGE(PG8_SA(1, 0), a3, voffA);
            PG8_BAR; PG8_WAIT_L(0); PG8_MMA(1, 0, At, B0); PG8_BAR; PG8_SCHED;
            PG8_STAGE(PG8_SB(1, 1), b3 + hstep, voffB);
            PG8_WAIT_V(6); PG8_BAR; PG8_MMA(1, 1, At, B1); PG8_BAR;
            }
        }
        }
        if constexpr (ALIGN_EPI) { if (wr == 0) PG8_BAR; }
        if constexpr (!Epi::AFTER_DRAIN) { E(acc, cur, wr, wc, fr, fq); S.done(cur); }
        if (!has_next) break;
#pragma unroll
        for (int a = 0; a < 2; ++a)
#pragma unroll
            for (int b = 0; b < 2; ++b)
#pragma unroll
                for (int m = 0; m < 4; ++m)
#pragma unroll
                    for (int n = 0; n < 2; ++n) acc[a][b][m][n] = (f32x4){0.f, 0.f, 0.f, 0.f};
        cur = nxt; cA = nA; cB = nB; ++ui;
        if constexpr (ALIGN_EPI) { if (wr == 1) PG8_BAR; }
    }
    PG8_WAIT_V(0);
    if constexpr (!ALIGN_EPI) { if (wr == 0) PG8_BAR; }
    PG8_BAR;
    if constexpr (Epi::AFTER_DRAIN) { E.fused(acc, cur, wr, wc, fr, fq, lds, wid, lane); }
#undef PG8_SA
#undef PG8_SB
#undef PG8_STAGE
#undef PG8_LDA
#undef PG8_LDB
#undef PG8_MMA
#undef PG8_WAIT_V
#undef PG8_WAIT_L
#undef PG8_BAR
#undef PG8_SCHED
}

struct MiniOutGate {
    static constexpr bool MID = true;
    const bf16_t *GA, *GB; bf16_t* Mo;
    __device__ __forceinline__ void mid(f32x4 (&acc)[2], int row, int col, PG8_LAS unsigned char*, int, int, int) const {
        const u32x4 ga = *(const u32x4*)(GA + (size_t)row * 1024 + col), gb = *(const u32x4*)(GB + (size_t)row * 1024 + col); f32x4 a0, a1, b0, b1; unpack8(ga, a0, a1); unpack8(gb, b0, b1);
#pragma unroll
        for (int j = 0; j < 4; ++j) { acc[0][j] *= a0[j] * __builtin_amdgcn_rcpf(fmaxf(b0[j], 1e-30f)); acc[1][j] *= a1[j] * __builtin_amdgcn_rcpf(fmaxf(b1[j], 1e-30f)); }
    }
    __device__ __forceinline__ void operator()(const f32x4 (&acc)[2], int row, int col, PG8_LAS unsigned char*, int, int, int, int) const {
        const u32x4 gb = *(const u32x4*)(GB + (size_t)row * 1024 + col); f32x4 b0, b1; unpack8(gb, b0, b1);
        *(u32x4*)(Mo + (size_t)row * 1024 + col) = pack8(acc[0] * b0, acc[1] * b1);
    }
};
struct MiniWo {
    static constexpr bool MID = false;
    const float* xs; float* H; bf16_t* HB; float* part;
    __device__ __forceinline__ void mid(f32x4 (&)[2], int, int, PG8_LAS unsigned char*, int, int, int) const {}
    __device__ __forceinline__ void operator()(const f32x4 (&acc)[2], int row, int col, PG8_LAS unsigned char* lds, int wm, int wn, int fr, int fq) const {
        const float* xr = xs + (size_t)(row - 16384) * 1024 + col;
        const f32x4 h0 = *(const f32x4*)xr + acc[0], h1 = *(const f32x4*)(xr + 4) + acc[1];
        *(u32x4*)(HB + (size_t)row * 1024 + col) = pack8(h0, h1);
        float ss = (h0[0] * h0[0] + h0[1] * h0[1]) + (h0[2] * h0[2] + h0[3] * h0[3]) + (h1[0] * h1[0] + h1[1] * h1[1]) + (h1[2] * h1[2] + h1[3] * h1[3]);
        ss += __shfl_xor(ss, 16); ss += __shfl_xor(ss, 32);
        PG8_LAS float* sc = (PG8_LAS float*)lds;
        if (fq == 0) sc[wn * 64 + wm * 16 + fr] = ss;
        __syncthreads();
        if (wn == 0 && fq == 0) part[(size_t)row * 16 + (col >> 6)] = sc[wm * 16 + fr] + sc[64 + wm * 16 + fr];
    }
};
struct MiniPg {
    static constexpr bool MID = false;
    float* Y; const bf16_t* HB; const bf16_t* PE; const float* part; const float* gfin; float* xs; unsigned* cnt;
    __device__ __forceinline__ void mid(f32x4 (&)[2], int, int, PG8_LAS unsigned char*, int, int, int) const {}
    __device__ __forceinline__ void operator()(const f32x4 (&acc)[2], int row, int col, PG8_LAS unsigned char* lds, int wm, int wn, int fr, int fq) const {
        float rs; { const f32x4 pv = *(const f32x4*)(part + (size_t)row * 16 + 4 * fq); rs = (pv[0] + pv[1]) + (pv[2] + pv[3]); rs += __shfl_xor(rs, 16); rs += __shfl_xor(rs, 32); }
        const float rstd = 1.0f / sqrtf(rs * (1.0f / 1024.0f) + 1e-6f);
        f32x4 h0, h1; unpack8(*(const u32x4*)(HB + (size_t)row * 1024 + col), h0, h1); const u32x4 pe = *(const u32x4*)(PE + (size_t)row * 1024 + col); f32x4 p0, p1; unpack8(pe, p0, p1);
#pragma unroll
        for (int j = 0; j < 4; ++j) { h0[j] += sigmoidf_(acc[0][j] * rstd) * p0[j]; h1[j] += sigmoidf_(acc[1][j] * rstd) * p1[j]; }
        float ss = (h0[0] * h0[0] + h0[1] * h0[1]) + (h0[2] * h0[2] + h0[3] * h0[3]) + (h1[0] * h1[0] + h1[1] * h1[1]) + (h1[2] * h1[2] + h1[3] * h1[3]);
        ss += __shfl_xor(ss, 16); ss += __shfl_xor(ss, 32);
        PG8_LAS float* sc = (PG8_LAS float*)lds;
        if (fq == 0) sc[wn * 64 + wm * 16 + fr] = ss;
        __syncthreads();
        const int r64 = wm * 16 + fr, lrow = row - 16384;
        if (wn == 0) { if (fq == 0) agent_store_f32(xs + (size_t)lrow * 16 + (col >> 6), sc[r64] + sc[64 + r64]);
            asm volatile("s_waitcnt vmcnt(0)" ::: "memory");
            if (fq == 0 && fr == 0) __hip_atomic_fetch_add(cnt, 1u, __ATOMIC_RELAXED, __HIP_MEMORY_SCOPE_AGENT); }
        if (wn == 0 && wm == 0) wait_count(cnt, 64u);
        asm volatile("s_waitcnt vmcnt(0) lgkmcnt(0)" ::: "memory"); __syncthreads();
        float q = 0.f;
#pragma unroll
        for (int t = 0; t < 4; ++t) q += agent_load_f32(xs + (size_t)lrow * 16 + 4 * fq + t);
        q += __shfl_xor(q, 16); q += __shfl_xor(q, 32);
        const float r3 = 1.0f / sqrtf(q * (1.0f / 1024.0f) + 1e-6f);
        float* yp = Y + (size_t)row * 1024 + col;
        *(f32x4*)yp = h0 * r3 * *(const f32x4*)(gfin + col); *(f32x4*)(yp + 4) = h1 * r3 * *(const f32x4*)(gfin + col + 4);
    }
};
template <class MEpi>
__device__ __forceinline__ void mini_gemm(PG8_LAS unsigned char* lds, const bf16_t* A, const bf16_t* Bt, int K, int row0, int col0, const MEpi& E) {
    int tid = threadIdx.x; asm volatile("" : "+v"(tid));
    const int wid = __builtin_amdgcn_readfirstlane(tid >> 6), lane = tid & 63, wm = wid & 3, wn = wid >> 2, fr = lane & 15, fq = lane >> 4;
    const int sr = tid >> 3, sc = tid & 7;
    const bf16_t* ga = A + (size_t)(row0 + sr) * K + sc * 8;
    const bf16_t* gb = Bt + (size_t)(col0 + (sr & ~31) + perm32(sr & 31)) * K + sc * 8;
    const unsigned wofs = (unsigned)(sr * 128 + ((sc ^ (sr & 7)) << 4));
    const int ar = wm * 16 + fr, br = wn * 32 + fr;
    f32x4 acc[2] = {(f32x4){0.f, 0.f, 0.f, 0.f}, (f32x4){0.f, 0.f, 0.f, 0.f}};
    const int ns = K / 64;
    u32x4 a0 = *(const u32x4*)ga, b0 = *(const u32x4*)gb, a1 = *(const u32x4*)(ga + 64), b1 = *(const u32x4*)(gb + 64);
    *(PG8_LAS u32x4*)(lds + wofs) = a0; *(PG8_LAS u32x4*)(lds + 8192 + wofs) = b0;
    __syncthreads();
#define MINI_COMPUTE(buf) do { _Pragma("unroll") for (int kk = 0; kk < 2; ++kk) { \
        const bf16x8 af = *(const PG8_LAS bf16x8*)(lds + (buf) * 16384 + ar * 128 + ((((kk << 2) + fq) ^ (ar & 7)) << 4)); \
        const bf16x8 bf0 = *(const PG8_LAS bf16x8*)(lds + (buf) * 16384 + 8192 + br * 128 + ((((kk << 2) + fq) ^ (br & 7)) << 4)); \
        const bf16x8 bf1 = *(const PG8_LAS bf16x8*)(lds + (buf) * 16384 + 8192 + (br + 16) * 128 + ((((kk << 2) + fq) ^ ((br + 16) & 7)) << 4)); \
        acc[0] = __builtin_amdgcn_mfma_f32_16x16x32_bf16(bf0, af, acc[0], 0, 0, 0); acc[1] = __builtin_amdgcn_mfma_f32_16x16x32_bf16(bf1, af, acc[1], 0, 0, 0); } } while (0)
#pragma unroll 1
    for (int s = 0; s < ns; s += 2) {
        if constexpr (MEpi::MID) { if (s == (ns >> 1)) E.mid(acc, row0 + ar, col0 + wn * 32 + 8 * fq, lds, wm, fr, fq); }
        if (s + 2 < ns) { a0 = *(const u32x4*)(ga + (size_t)(s + 2) * 64); b0 = *(const u32x4*)(gb + (size_t)(s + 2) * 64); }
        MINI_COMPUTE(0);
        *(PG8_LAS u32x4*)(lds + 16384 + wofs) = a1; *(PG8_LAS u32x4*)(lds + 16384 + 8192 + wofs) = b1;
        __syncthreads();
        if (s + 3 < ns) { a1 = *(const u32x4*)(ga + (size_t)(s + 3) * 64); b1 = *(const u32x4*)(gb + (size_t)(s + 3) * 64); }
        MINI_COMPUTE(1);
        if (s + 2 < ns) { *(PG8_LAS u32x4*)(lds + wofs) = a0; *(PG8_LAS u32x4*)(lds + 8192 + wofs) = b0; }
        __syncthreads();
    }
#undef MINI_COMPUTE
    E(acc, row0 + ar, col0 + wn * 32 + 8 * fq, lds, wm, wn, fr, fq);
    __syncthreads();
}
}

#ifndef PG8_SP2
#define PG8_SP2 true
#endif
#ifndef PG8_ALIGN
#define PG8_ALIGN true
#endif

constexpr int NWAVES = 8;
constexpr int DM = 1024, NP = 16384, NS = 1024, T = NP + NS, SEQ = 2048, DSEQ = 8, DIN = 9216, PLE = 256;
constexpr float EPS = 1e-6f, LN_EPS = 1e-5f;
constexpr size_t OFF_NAP = (size_t)T * DM, OFF_NBP = OFF_NAP + 8 * 2 * 1024, OFF_NAS = OFF_NBP + 8 * 30 * 1024, OFF_NBS = OFF_NAS + 128 * 2 * 1024;
constexpr size_t MiB = 1u << 20;
constexpr size_t WS_CTL = 0, CTL_ZERO_BYTES = 64 * 1024;
constexpr size_t WS_WIN = 2 * MiB, WS_WAB = 20 * MiB, WS_WO = 24 * MiB, WS_WPG = 26 * MiB, WS_WPE = 28 * MiB;
constexpr size_t WS_PB = 29 * MiB;
constexpr size_t WS_XB = 38 * MiB;
constexpr size_t WS_QZ = 72 * MiB;
constexpr size_t WS_S = 140 * MiB;
constexpr size_t WS_V = 174 * MiB;
constexpr size_t WS_PART = 208 * MiB;
constexpr size_t WS_X2 = 210 * MiB, WS_X2S = 211 * MiB;
constexpr size_t WS_PE = 214 * MiB;
constexpr size_t WS_END = 248 * MiB;
constexpr int CW_BAR = 4096, CW_GRP = 8192;
constexpr int RING_BYTES = 131072, LDSCTL_OFF = RING_BYTES, MISC_OFF = LDSCTL_OFF + 320, LDS_BYTES = 147456;

#define GAS __attribute__((address_space(1)))
#define LAS __attribute__((address_space(3)))
typedef unsigned short bf16;
typedef unsigned v4u __attribute__((ext_vector_type(4)));
typedef unsigned v2u __attribute__((ext_vector_type(2)));
typedef float f32x4 __attribute__((ext_vector_type(4)));
typedef float f32x2 __attribute__((ext_vector_type(2)));
#define LDS_WAIT() asm volatile("s_waitcnt lgkmcnt(0)" ::: "memory")
using pg8::cvt_pk_bf16; using pg8::bf_lo; using pg8::bf_hi; using pg8::sigmoidf_;

#define XB_TMO      128
#define XB_XCNT(j)  (256  + 64 * (j))
#define XB_XSUB(j)  (1280 + 64 * (j))
#define XB_XGEN(j)  (2304 + 64 * (j))
#define XB_TOP      3328
#define XB_TOPGEN   3392
#define XCD_BAR_WORDS 3456
#define XB_SPIN_CAP (1u << 18)
__device__ __forceinline__ unsigned xb_ld(unsigned* p)              { return __hip_atomic_load(p, __ATOMIC_RELAXED, __HIP_MEMORY_SCOPE_AGENT); }
__device__ __forceinline__ unsigned xb_add(unsigned* p, unsigned v) { return __hip_atomic_fetch_add(p, v, __ATOMIC_RELAXED, __HIP_MEMORY_SCOPE_AGENT); }
__device__ __forceinline__ unsigned xb_xcc_id() { return (unsigned)__builtin_amdgcn_s_getreg((3 << 11) | 20) & 0xFu; }
#define XB_SPIN(cond, bar) do { unsigned _sp = 0; while (cond) { __builtin_amdgcn_s_sleep(1); \
    if ((++_sp & 255u) == 0u) { if (xb_ld(&(bar)[XB_TMO])) break; if (_sp > XB_SPIN_CAP) { atomicAdd(&(bar)[XB_TMO], 1u); break; } } } } while (0)
struct XcdBarrier { unsigned* bar; unsigned x; volatile LAS unsigned* st; };
__device__ __forceinline__ XcdBarrier xcd_barrier_post(unsigned* bar, volatile LAS unsigned* st) {
    XcdBarrier b; b.bar = bar; b.x = xb_xcc_id(); b.st = st;
    if (threadIdx.x == 0) (void)xb_add(&bar[XB_XCNT(b.x)], 1u);
    return b;
}
__device__ __forceinline__ void xcd_barrier_complete(unsigned* bar, unsigned x, unsigned& nloc, unsigned& nx) {
    const unsigned G = gridDim.x * gridDim.y * gridDim.z;
    unsigned sum, cnt, mine, sp = 0u;
    for (;;) {
        sum = 0u; cnt = 0u; mine = 0u;
#pragma unroll
        for (unsigned j = 0; j < 16; ++j) { const unsigned c = xb_ld(&bar[XB_XCNT(j)]); sum += c; cnt += (c > 0u) ? 1u : 0u; mine = (j == x) ? c : mine; }
        if (sum == G) break;
        __builtin_amdgcn_s_sleep(1);
        if ((++sp & 255u) == 0u) { if (xb_ld(&bar[XB_TMO])) break; if (sp > XB_SPIN_CAP) { atomicAdd(&bar[XB_TMO], 1u); break; } }
    }
    nloc = mine > 0u ? mine : 1u; nx = cnt > 0u ? cnt : 1u;
}
__device__ __forceinline__ void xcd_barrier(const XcdBarrier& b) {
    asm volatile("s_waitcnt vmcnt(0)" ::: "memory");
    __syncthreads();
    if (threadIdx.x == 0) {
        unsigned* bar = b.bar;
        __builtin_amdgcn_s_waitcnt(0);
        unsigned nloc = b.st[0], nx = b.st[1];
        if (nloc == 0u) { xcd_barrier_complete(bar, b.x, nloc, nx); b.st[0] = nloc; b.st[1] = nx; }
        const unsigned old = xb_add(&bar[XB_XSUB(b.x)], 1u);
        const unsigned gen = old / nloc;
        if (old + 1u == (gen + 1u) * nloc) {
            __builtin_amdgcn_fence(__ATOMIC_RELEASE, "agent");
            asm volatile("s_waitcnt vmcnt(0)" ::: "memory");
            const unsigned og = xb_add(&bar[XB_TOP], 1u);
            const unsigned tg = og / nx;
            if (og + 1u == (tg + 1u) * nx) xb_add(&bar[XB_TOPGEN], 1u);
            else XB_SPIN(xb_ld(&bar[XB_TOPGEN]) == tg, bar);
            __builtin_amdgcn_fence(__ATOMIC_ACQUIRE, "agent");
            xb_add(&bar[XB_XGEN(b.x)], 1u);
            asm volatile("s_waitcnt vmcnt(0)" ::: "memory");
        } else {
            XB_SPIN(xb_ld(&bar[XB_XGEN(b.x)]) == gen, bar);
            __builtin_amdgcn_fence(__ATOMIC_ACQUIRE, "agent");
            asm volatile("s_waitcnt vmcnt(0)" ::: "memory");
        }
    }
    __syncthreads();
}

__device__ __forceinline__ float wave_sum(float v) {
#pragma unroll
    for (int o = 1; o < 64; o <<= 1) v += __shfl_xor(v, o);
    return v;
}

template <class RowMap>
__device__ __forceinline__ void p0_transpose_item(const float* W, int N, bf16* WT, int ldk, int koff, const float* gk, RowMap rm, LAS float* scr, int item, int lane) {
    const int nblk = N / 32, kb = item / nblk, nb = item % nblk, k0 = 64 * kb, n0 = 32 * nb;
#pragma unroll
    for (int i = 0; i < 8; ++i) { const int kk = 8 * i + (lane >> 3), n4 = (lane & 7) * 4; f32x4 w = *(const f32x4*)(W + (size_t)(k0 + kk) * N + n0 + n4); if (gk) w = w * gk[k0 + kk];
        LAS float* d = scr + kk * 33 + n4; d[0] = w.x; d[1] = w.y; d[2] = w.z; d[3] = w.w; }
    LDS_WAIT(); asm volatile("" ::: "memory");
    const int c = lane & 7;
#pragma unroll
    for (int j = 0; j < 4; ++j) { const int n = (lane >> 3) + 8 * j; const LAS float* s = scr + (8 * c) * 33 + n;
        v4u o; o.x = cvt_pk_bf16(s[0 * 33], s[1 * 33]); o.y = cvt_pk_bf16(s[2 * 33], s[3 * 33]); o.z = cvt_pk_bf16(s[4 * 33], s[5 * 33]); o.w = cvt_pk_bf16(s[6 * 33], s[7 * 33]);
        *(GAS v4u*)(WT + (size_t)rm(n0 + n) * ldk + koff + k0 + 8 * c) = o; }
    LDS_WAIT(); asm volatile("" ::: "memory");
}
struct RowId { __device__ __forceinline__ int operator()(int n) const { return n; } };
struct RowInProj { __device__ __forceinline__ int operator()(int sc) const {
    const int g = sc >> 10, ch = sc & 1023;
    if (g >= 6) return 256 * (24 + 4 * (g - 6) + (ch >> 8)) + (ch & 255);
    int base, isY;
    switch (g) { case 0: base = 0; isY = 0; break; case 3: base = 0; isY = 1; break; case 1: base = 8; isY = 0; break; case 2: base = 8; isY = 1; break; case 4: base = 16; isY = 0; break; default: base = 16; isY = 1; break; }
    const int cl = ch & 127, grp = cl >> 3, r8 = cl & 7, bj = r8 >> 2, j = r8 & 3;
    return 256 * (base + (ch >> 7)) + 128 * bj + 8 * grp + 4 * isY + j; } };

struct Ptrs {
    const float *x_p, *x_s, *st_a, *st_b, *p_p, *p_s, *g_mix, *w_in, *w_conv_a, *w_out_a, *w_conv_b, *b_conv_b, *ln_g, *ln_b, *w_out_b, *w_o, *w_pe, *g_ple, *w_pg, *g_final;
    float* out; unsigned char* ws;
};

typedef const __attribute__((address_space(4))) Ptrs* KPtrsT;
__device__ __forceinline__ Ptrs load_ptrs(KPtrsT k) {
    Ptrs P;
    P.x_p = k->x_p; P.x_s = k->x_s; P.st_a = k->st_a; P.st_b = k->st_b; P.p_p = k->p_p; P.p_s = k->p_s; P.g_mix = k->g_mix; P.w_in = k->w_in; P.w_conv_a = k->w_conv_a; P.w_out_a = k->w_out_a;
    P.w_conv_b = k->w_conv_b; P.b_conv_b = k->b_conv_b; P.ln_g = k->ln_g; P.ln_b = k->ln_b; P.w_out_b = k->w_out_b; P.w_o = k->w_o; P.w_pe = k->w_pe; P.g_ple = k->g_ple; P.w_pg = k->w_pg; P.g_final = k->g_final;
    P.out = k->out; P.ws = k->ws; return P;
}
__device__ __forceinline__ void p0_prologue(const Ptrs& P, LAS unsigned char* lds, int gw, int NGW, int lane, int wave) {
    LAS float* scr = (LAS float*)(lds + wave * 16384);
    bf16* Wt_in = (bf16*)(P.ws + WS_WIN); bf16* Wt_ab = (bf16*)(P.ws + WS_WAB); bf16* Wt_o = (bf16*)(P.ws + WS_WO); bf16* Wt_pg = (bf16*)(P.ws + WS_WPG); bf16* Wt_pe = (bf16*)(P.ws + WS_WPE);
    constexpr int I_IN = (DM / 64) * (DIN / 32), I_SQ = (DM / 64) * (DM / 32), I_PE = (PLE / 64) * (DM / 32);
    constexpr int NITEMS = I_IN + 4 * I_SQ + I_PE;
    for (int it = gw; it < NITEMS; it += NGW) {
        int r = it;
        if (r < I_IN) { p0_transpose_item(P.w_in, DIN, Wt_in, DM, 0, P.g_mix, RowInProj(), scr, r, lane); continue; } r -= I_IN;
        if (r < I_SQ) { p0_transpose_item(P.w_out_a, DM, Wt_ab, 2 * DM, 0, nullptr, RowId(), scr, r, lane); continue; } r -= I_SQ;
        if (r < I_SQ) { p0_transpose_item(P.w_out_b, DM, Wt_ab, 2 * DM, DM, nullptr, RowId(), scr, r, lane); continue; } r -= I_SQ;
        if (r < I_SQ) { p0_transpose_item(P.w_o, DM, Wt_o, DM, 0, nullptr, RowId(), scr, r, lane); continue; } r -= I_SQ;
        if (r < I_SQ) { p0_transpose_item(P.w_pg, DM, Wt_pg, DM, 0, P.g_ple, RowId(), scr, r, lane); continue; } r -= I_SQ;
        p0_transpose_item(P.w_pe, DM, Wt_pe, PLE, 0, nullptr, RowId(), scr, r, lane);
    }
    bf16* XB = (bf16*)(P.ws + WS_XB); bf16* PB = (bf16*)(P.ws + WS_PB);
    for (int m0 = 2 * gw; m0 < T; m0 += 2 * NGW) {
        f32x4 v[2][4], pv[2]; float s[2] = {0.f, 0.f};
#pragma unroll
        for (int r = 0; r < 2; ++r) { const int m = m0 + r;
            const float* xrow = m < NP ? P.x_p + (size_t)m * DM : P.x_s + (size_t)(m - NP) * DM;
            const float* prow = m < NP ? P.p_p + (size_t)m * PLE : P.p_s + (size_t)(m - NP) * PLE;
            const GAS f32x4* xr = (const GAS f32x4*)xrow + lane;
#pragma unroll
            for (int j = 0; j < 4; ++j) v[r][j] = xr[64 * j];
            pv[r] = ((const GAS f32x4*)prow)[lane]; }
#pragma unroll
        for (int r = 0; r < 2; ++r) { const int m = m0 + r;
#pragma unroll
            for (int j = 0; j < 4; ++j) s[r] += (v[r][j].x * v[r][j].x + v[r][j].y * v[r][j].y) + (v[r][j].z * v[r][j].z + v[r][j].w * v[r][j].w);
            const float rstd = 1.0f / sqrtf(wave_sum(s[r]) * (1.0f / DM) + EPS);
            GAS v2u* o8 = (GAS v2u*)(XB + (size_t)m * DM) + lane;
#pragma unroll
            for (int j = 0; j < 4; ++j) { v2u w; w.x = cvt_pk_bf16(v[r][j].x * rstd, v[r][j].y * rstd); w.y = cvt_pk_bf16(v[r][j].z * rstd, v[r][j].w * rstd); o8[64 * j] = w; }
            v2u w; w.x = cvt_pk_bf16(pv[r].x, pv[r].y); w.y = cvt_pk_bf16(pv[r].z, pv[r].w);
            ((GAS v2u*)(PB + (size_t)m * PLE))[lane] = w; }
    }
}

using pg8::rsrc_t; using pg8::mkrsrc;
__device__ __forceinline__ unsigned bld4(rsrc_t r, unsigned voff, unsigned soff) { return __builtin_amdgcn_raw_buffer_load_b32(r, (int)voff, (int)soff, 0); }
__device__ __forceinline__ void bst4(rsrc_t r, unsigned voff, unsigned soff, unsigned v) { __builtin_amdgcn_raw_buffer_store_b32(v, r, (int)voff, (int)soff, 0); }
__device__ __forceinline__ f32x2 bld8f(rsrc_t r, unsigned voff, unsigned soff) { return __builtin_bit_cast(f32x2, __builtin_amdgcn_raw_buffer_load_b64(r, (int)voff, (int)soff, 0)); }
__device__ __forceinline__ void bst8f(rsrc_t r, unsigned voff, unsigned soff, f32x2 v) { __builtin_amdgcn_raw_buffer_store_b64(__builtin_bit_cast(v2u, v), r, (int)voff, (int)soff, 0); }
__device__ __forceinline__ f32x2 up2(unsigned u) { return (f32x2){bf_lo(u), bf_hi(u)}; }
using pg8::bld16; using pg8::bst16; using pg8::u32x4; using pg8::pack8; using pg8::unpack8; using pg8::as_f; using pg8::as_u;
template <int NTW>
__device__ __forceinline__ void p2_ln_part(const Ptrs& P, LAS unsigned char* lds, rsrc_t rQZ, unsigned R0, int lane, int wave) {
    f32x4 lg[4], lb[4];
#pragma unroll
    for (int h = 0; h < 2; ++h)
#pragma unroll
        for (int q = 0; q < 2; ++q) { lg[2 * h + q] = *(const f32x4*)(P.ln_g + h * 512 + lane * 8 + q * 4); lb[2 * h + q] = *(const f32x4*)(P.ln_b + h * 512 + lane * 8 + q * 4); }
    const LAS f32x4* cl4 = (const LAS f32x4*)lds;
    const unsigned vz = (unsigned)lane * 16u;
#pragma unroll 1
    for (int ii = 0; ii < NTW; ++ii) { const int i = wave * NTW + ii;
        f32x4 x[4]; float s = 0.f;
#pragma unroll
        for (int h = 0; h < 2; ++h)
#pragma unroll
            for (int q = 0; q < 2; ++q) { x[2 * h + q] = cl4[i * 256 + h * 128 + lane * 2 + q]; s += (x[2 * h + q].x + x[2 * h + q].y) + (x[2 * h + q].z + x[2 * h + q].w); }
        const float mean = wave_sum(s) * (1.0f / 1024.0f); float qq = 0.f;
#pragma unroll
        for (int j = 0; j < 4; ++j) { x[j] = x[j] - mean; qq += (x[j].x * x[j].x + x[j].y * x[j].y) + (x[j].z * x[j].z + x[j].w * x[j].w); }
        const float rstd = 1.0f / sqrtf(wave_sum(qq) * (1.0f / 1024.0f) + LN_EPS);
        const unsigned so = (R0 + i) * 4096u + 2048u;
#pragma unroll
        for (int h = 0; h < 2; ++h) { const u32x4 z = bld16(rQZ, vz, so + h * 1024); f32x4 z0, z1; unpack8(z, z0, z1);
            f32x4 y0 = x[2 * h] * rstd * lg[2 * h] + lb[2 * h], y1 = x[2 * h + 1] * rstd * lg[2 * h + 1] + lb[2 * h + 1];
#pragma unroll
            for (int j = 0; j < 4; ++j) { y0[j] = y0[j] * sigmoidf_(y0[j]) * z0[j]; y1[j] = y1[j] * sigmoidf_(y1[j]) * z1[j]; }
            bst16(rQZ, vz, so + h * 1024, pack8(y0, y1)); }
    }
}
__device__ __forceinline__ void p2_tile_prompt(const Ptrs& P, LAS unsigned char* lds, int tile, int tid, int lane, int wave) {
    const rsrc_t rQZ = mkrsrc(P.ws + WS_QZ), rS = mkrsrc(P.ws + WS_S), rWb = mkrsrc(P.w_conv_b), rOut = mkrsrc(P.out);
    const unsigned b = tile >> 6, t0 = (tile & 63) * 32, R0 = b * SEQ + t0;
    const bool lastt = (t0 == SEQ - 32), first = (t0 == 0);
    {
        const unsigned char* Vb = P.ws + WS_V;
#pragma unroll 1
        for (int hr = wave; hr < 124; hr += 8) { const int row = hr >> 1, half = hr & 1;
            if (first && row < 30) { *(LAS u32x4*)(lds + row * 2048 + half * 1024 + lane * 16) = (u32x4){0u, 0u, 0u, 0u}; }
            else __builtin_amdgcn_global_load_lds((const unsigned*)(Vb + (size_t)(R0 - 30 + row) * 2048 + half * 1024 + lane * 16), (LAS unsigned*)(lds + row * 2048 + half * 1024), 16, 0, 0); }
    }
    {
        const unsigned cg = tid & 127, tq = tid >> 7, vo = cg * 16u, r0 = R0 + tq * 8;
        f32x4 w0[2], w1[2], w2[2];
#pragma unroll
        for (int q = 0; q < 2; ++q) { w0[q] = *(const f32x4*)(P.w_conv_a + cg * 8 + q * 4); w1[q] = *(const f32x4*)(P.w_conv_a + 1024 + cg * 8 + q * 4); w2[q] = *(const f32x4*)(P.w_conv_a + 2048 + cg * 8 + q * 4); }
        u32x4 sr[10];
#pragma unroll
        for (int i = 0; i < 10; ++i) { const bool neg = first && tq == 0 && i < 2; sr[i] = bld16(rS, vo, neg ? 0u : (r0 - 2 + i) * 2048u); if (neg) sr[i] = (u32x4){0u, 0u, 0u, 0u}; }
        u32x4 qr[8];
#pragma unroll
        for (int i = 0; i < 8; ++i) qr[i] = bld16(rQZ, vo, (r0 + i) * 4096u);
#pragma unroll
        for (int i = 0; i < 8; ++i) { f32x4 a0, a1, b0, b1, c0, c1, q0, q1; unpack8(sr[i], a0, a1); unpack8(sr[i + 1], b0, b1); unpack8(sr[i + 2], c0, c1); unpack8(qr[i], q0, q1);
            const f32x4 y0 = q0 * (w0[0] * a0 + w1[0] * b0 + w2[0] * c0), y1 = q1 * (w0[1] * a1 + w1[1] * b1 + w2[1] * c1);
            bst16(rQZ, vo, (r0 + i) * 4096u, pack8(y0, y1)); }
        if (lastt && tq == 3) {
#pragma unroll
            for (int j = 0; j < 2; ++j) { f32x4 a0, a1; unpack8(sr[8 + j], a0, a1);
                bst16(rOut, cg * 32u, (unsigned)(OFF_NAP + (size_t)(b * 2 + j) * 1024) * 4u, as_u(a0)); bst16(rOut, cg * 32u, (unsigned)(OFF_NAP + (size_t)(b * 2 + j) * 1024) * 4u + 16u, as_u(a1)); } }
    }
    asm volatile("s_waitcnt vmcnt(0)" ::: "memory");
    __syncthreads();
    {
        const unsigned v8 = (unsigned)tid * 8u;
        const f32x2 bias = *(const f32x2*)(P.b_conv_b + 2 * tid);
        f32x2 win[62];
#pragma unroll
        for (int i = 0; i < 62; ++i) win[i] = up2(*(const LAS unsigned*)(lds + i * 2048 + tid * 4));
        asm volatile("s_waitcnt lgkmcnt(0)" ::: "memory");
        __syncthreads();
        LAS f32x2* cl2 = (LAS f32x2*)lds;
#pragma unroll
        for (int hh = 0; hh < 2; ++hh) {
            f32x2 c[16];
#pragma unroll
            for (int i = 0; i < 16; ++i) c[i] = bias;
#pragma unroll
            for (int k = 0; k < 31; ++k) { const f32x2 w = bld8f(rWb, v8, k * 4096u);
#pragma unroll
                for (int i = 0; i < 16; ++i) c[i] += w * win[hh * 16 + i + k]; }
#pragma unroll
            for (int i = 0; i < 16; ++i) cl2[(hh * 16 + i) * 512 + tid] = c[i];
        }
        if (lastt) {
#pragma unroll
            for (int j = 0; j < 30; ++j) bst8f(rOut, v8, (unsigned)(OFF_NBP + (size_t)(b * 30 + j) * 1024) * 4u, win[32 + j]); }
    }
    __syncthreads();
    p2_ln_part<4>(P, lds, rQZ, R0, lane, wave);
    __syncthreads();
}
__device__ __forceinline__ void p2_seq_sample(const Ptrs& P, LAS unsigned char* lds, int n, int tid, int lane, int wave) {
    const rsrc_t rQZ = mkrsrc(P.ws + WS_QZ), rS = mkrsrc(P.ws + WS_S), rV = mkrsrc(P.ws + WS_V), rWb = mkrsrc(P.w_conv_b), rOut = mkrsrc(P.out);
    const rsrc_t rSa = mkrsrc(P.st_a), rSb = mkrsrc(P.st_b);
    const unsigned v4 = (unsigned)tid * 4u, v8 = (unsigned)tid * 8u, r0 = NP + n * DSEQ;
    LAS f32x2* cl2 = (LAS f32x2*)lds;
    const f32x2 wA0 = *(const f32x2*)(P.w_conv_a + 2 * tid), wA1 = *(const f32x2*)(P.w_conv_a + 1024 + 2 * tid), wA2 = *(const f32x2*)(P.w_conv_a + 2048 + 2 * tid);
    const f32x2 bias = *(const f32x2*)(P.b_conv_b + 2 * tid);
    {
        f32x2 sw[10];
#pragma unroll
        for (int i = 0; i < 2; ++i) sw[i] = bld8f(rSa, v8, (n * 2 + i) * 4096u);
#pragma unroll
        for (int i = 0; i < 8; ++i) sw[2 + i] = up2(bld4(rS, v4, (r0 + i) * 2048u));
#pragma unroll
        for (int i = 0; i < 8; ++i) { const f32x2 q = up2(bld4(rQZ, v4, (r0 + i) * 4096u));
            const f32x2 cv = wA0 * sw[i] + wA1 * sw[i + 1] + wA2 * sw[i + 2]; const f32x2 ya = q * cv; bst4(rQZ, v4, (r0 + i) * 4096u, cvt_pk_bf16(ya.x, ya.y)); }
#pragma unroll
        for (int j = 0; j < 2; ++j) bst8f(rOut, v8, (unsigned)(OFF_NAS + (size_t)(n * 2 + j) * 1024) * 4u, sw[8 + j]);
    }
    {
        f32x2 win[38];
#pragma unroll
        for (int i = 0; i < 30; ++i) win[i] = bld8f(rSb, v8, (n * 30 + i) * 4096u);
#pragma unroll
        for (int i = 0; i < 8; ++i) win[30 + i] = up2(bld4(rV, v4, (r0 + i) * 2048u));
        f32x2 c[8];
#pragma unroll
        for (int i = 0; i < 8; ++i) c[i] = bias;
#pragma unroll
        for (int k = 0; k < 31; ++k) { const f32x2 w = bld8f(rWb, v8, k * 4096u);
#pragma unroll
            for (int i = 0; i < 8; ++i) c[i] += w * win[i + k]; }
#pragma unroll
        for (int i = 0; i < 8; ++i) cl2[i * 512 + tid] = c[i];
#pragma unroll
        for (int j = 0; j < 30; ++j) bst8f(rOut, v8, (unsigned)(OFF_NBS + (size_t)(n * 30 + j) * 1024) * 4u, win[8 + j]);
    }
    __syncthreads();
    p2_ln_part<1>(P, lds, rQZ, r0, lane, wave);
    __syncthreads();
}

struct Args { Ptrs p; int ph_lo, ph_hi; };

__global__ void __launch_bounds__(NWAVES * 64, 2) fwd_megakernel(Args args) {
    extern __shared__ __attribute__((aligned(16))) unsigned char lds_raw[];
    LAS unsigned char* lds = (LAS unsigned char*)lds_raw;
    typedef const __attribute__((address_space(4))) Ptrs* KPtrs;
    const KPtrs Pk = (KPtrs)__builtin_amdgcn_kernarg_segment_ptr();
#define PHASE_PTRS() KPtrs Pq_ = Pk; asm volatile("" : "+s"(Pq_)); const Ptrs P = load_ptrs(Pq_); int tid = threadIdx.x; asm volatile("" : "+v"(tid)); const int lane = tid & 63; (void)lane
    const int tid0 = threadIdx.x, wave = __builtin_amdgcn_readfirstlane(tid0 >> 6);
    const int G = gridDim.x, bx = blockIdx.x;
    const int gw = bx * NWAVES + wave, NGW = G * NWAVES;
    volatile LAS unsigned* MISC = (volatile LAS unsigned*)(lds + MISC_OFF);
    for (int u = tid0; u < (LDS_BYTES - LDSCTL_OFF) / 4; u += NWAVES * 64) ((LAS unsigned*)(lds + LDSCTL_OFF))[u] = 0u;
    __syncthreads();
    unsigned* ctl;
    { PHASE_PTRS(); ctl = (unsigned*)(P.ws + WS_CTL); }
    XcdBarrier bar; bar.bar = ctl + CW_BAR; bar.x = 0; bar.st = nullptr;
#if !MK_PER_PHASE
    bar = xcd_barrier_post(ctl + CW_BAR, MISC + 8);
#endif
    const int lo = args.ph_lo, hi = args.ph_hi;
#define WSP(off) ((pg8::bf16_t*)(P.ws + (off)))

#define RUN0 { PHASE_PTRS(); p0_prologue(P, lds, gw, NGW, lane, wave); }
#define RUN1 { PHASE_PTRS(); \
            pg8::Gemm g{WSP(WS_XB), WSP(WS_WIN), T, DIN, DM}; pg8::StaticOrder S; S.init(T, DIN, G, bx); \
            pg8::EpiInProj E{WSP(WS_QZ), WSP(WS_S), WSP(WS_V), (pg8::bf16_t*)P.out, (pg8::bf16_t*)P.out + (size_t)T * DM}; \
            pg8::gemm_phase<pg8::EpiInProj, pg8::StaticOrder, PG8_ALIGN, PG8_SP2>(lds, g, S, E); \
              \
            { pg8::Gemm g2{WSP(WS_PB), WSP(WS_WPE), T, DM, PLE}; pg8::StaticOrder S2; S2.init(T, DM, G - 144, bx - 144); \
              pg8::EpiPlain E2{WSP(WS_PE), DM}; \
              pg8::gemm_phase<pg8::EpiPlain, pg8::StaticOrder, PG8_ALIGN, PG8_SP2>(lds, g2, S2, E2); } }
#define RUN2 { PHASE_PTRS(); \
            for (int tile = bx; tile < 512; tile += G) p2_tile_prompt(P, lds, tile, tid, lane, wave); \
            for (int n = bx; n < 128; n += G) p2_seq_sample(P, lds, n, tid, lane, wave); }
#define RUN3 { PHASE_PTRS(); \
            pg8::Gemm g{WSP(WS_QZ), WSP(WS_WAB), NP, DM, 2 * DM}; pg8::StaticOrder S; S.init(NP, DM, G, bx); \
            pg8::EpiOutGate E{(const pg8::bf16_t*)P.out, (const pg8::bf16_t*)P.out + (size_t)T * DM, WSP(WS_S)}; \
            pg8::gemm_phase<pg8::EpiOutGate, pg8::StaticOrder, PG8_ALIGN, PG8_SP2>(lds, g, S, E); \
            pg8::MiniOutGate ME{(const pg8::bf16_t*)P.out, (const pg8::bf16_t*)P.out + (size_t)T * DM, WSP(WS_S)}; \
            pg8::mini_gemm(lds, WSP(WS_QZ), WSP(WS_WAB), 2 * DM, NP + (bx >> 4) * 64, (bx & 15) * 64, ME); }
#define RUN4 { \
            { PHASE_PTRS(); pg8::Gemm g{WSP(WS_S), WSP(WS_WO), NP, DM, DM}; pg8::StaticOrder S; S.init(NP, DM, G, bx); \
              pg8::EpiWo E{P.x_p, P.x_s, P.out, WSP(WS_V), (float*)(P.ws + WS_PART)}; \
              pg8::gemm_phase<pg8::EpiWo, pg8::StaticOrder, PG8_ALIGN, PG8_SP2>(lds, g, S, E); \
              pg8::MiniWo ME{P.x_s, P.out, WSP(WS_V), (float*)(P.ws + WS_PART)}; \
              pg8::mini_gemm(lds, WSP(WS_S), WSP(WS_WO), DM, NP + (bx >> 4) * 64, (bx & 15) * 64, ME); } }
#define RUN5 { PHASE_PTRS(); \
            pg8::Gemm g{WSP(WS_V), WSP(WS_WPG), NP, DM, DM}; pg8::StaticOrder S; S.init(NP, DM, G, bx); \
            pg8::EpiPgFinal E{P.out, WSP(WS_V), WSP(WS_PE), (const float*)(P.ws + WS_PART), P.g_final, (float*)(P.ws + WS_X2), ctl + CW_GRP}; \
            pg8::gemm_phase<pg8::EpiPgFinal, pg8::StaticOrder, PG8_ALIGN, PG8_SP2>(lds, g, S, E); \
            pg8::MiniPg ME{P.out, WSP(WS_V), WSP(WS_PE), (const float*)(P.ws + WS_PART), P.g_final, (float*)(P.ws + WS_X2S), ctl + CW_GRP + 64 * (64 + (bx >> 4))}; \
            pg8::mini_gemm(lds, WSP(WS_V), WSP(WS_WPG), DM, NP + (bx >> 4) * 64, (bx & 15) * 64, ME); }
#define RUN6 { PHASE_PTRS(); \
            float* H = P.out; \
            f32x4 gf[4]; \
            _Pragma("unroll") for (int j = 0; j < 4; ++j) gf[j] = *(const f32x4*)(P.g_final + j * 256 + lane * 4); \
            for (int m = gw; m < T; m += NGW) { \
                GAS f32x4* hr = (GAS f32x4*)(H + (size_t)m * DM) + lane; \
                f32x4 v[4]; float sq = 0.f; \
                _Pragma("unroll") for (int j = 0; j < 4; ++j) { v[j] = hr[64 * j]; sq += (v[j].x * v[j].x + v[j].y * v[j].y) + (v[j].z * v[j].z + v[j].w * v[j].w); } \
                const float rstd = 1.0f / sqrtf(wave_sum(sq) * (1.0f / DM) + EPS); \
                _Pragma("unroll") for (int j = 0; j < 4; ++j) hr[64 * j] = v[j] * rstd * gf[j]; \
            } }
#define RUN7 { PHASE_PTRS(); \
            float* H = P.out; \
            for (int m = gw; m < T; m += NGW) { \
                GAS f32x4* hr = (GAS f32x4*)(H + (size_t)m * DM) + lane; \
                f32x4 v[4]; float sq = 0.f; \
                _Pragma("unroll") for (int j = 0; j < 4; ++j) { v[j] = hr[64 * j]; sq += (v[j].x * v[j].x + v[j].y * v[j].y) + (v[j].z * v[j].z + v[j].w * v[j].w); } \
                const float one = wave_sum(sq) >= 0.f ? 1.0f : 0.0f; \
                _Pragma("unroll") for (int j = 0; j < 4; ++j) hr[64 * j] = v[j] * one; \
            } }
#ifndef PROG_STEPS
#define PROG_STEPS X(0) X(1) X(2) X(3) X(4) X(5)
#endif
    enum { STEP_BASE = __COUNTER__ + 1 };
#if MK_PER_PHASE
#define X(k) { const int si_ = __COUNTER__ - STEP_BASE; if (lo == si_) RUN##k }
#else
#define X(k) { const int si_ = __COUNTER__ - STEP_BASE; if (si_ > 0) xcd_barrier(bar); RUN##k }
#endif
    PROG_STEPS
#undef X
#undef WSP
}

extern "C" void kernel_launch(void* const* d_in, const int* in_sizes, int n_in, void* d_out, int out_size, void* d_ws, size_t ws_size, hipStream_t stream) {
    static int grid = 0;
    if (grid == 0) {
        if (n_in != 20 || ws_size < WS_END) { fprintf(stderr, "kernel_launch: unexpected n_in %d / ws %zu\n", n_in, ws_size); grid = -1; return; }
        int dev = 0, cus = 0, per_cu = 0;
        if (hipGetDevice(&dev) != hipSuccess || hipDeviceGetAttribute(&cus, hipDeviceAttributeMultiprocessorCount, dev) != hipSuccess) { grid = -1; return; }
        if (hipFuncSetAttribute((const void*)fwd_megakernel, hipFuncAttributeMaxDynamicSharedMemorySize, LDS_BYTES) != hipSuccess) { fprintf(stderr, "kernel_launch: hipFuncSetAttribute failed\n"); grid = -1; return; }
        if (hipOccupancyMaxActiveBlocksPerMultiprocessor(&per_cu, (const void*)fwd_megakernel, NWAVES * 64, LDS_BYTES) != hipSuccess || per_cu < 1) { fprintf(stderr, "kernel_launch: occupancy query says %d\n", per_cu); (void)hipGetLastError(); per_cu = 1; }
        grid = cus;
    }
    if (grid < 0) return;
    (void)hipMemsetAsync((char*)d_ws + WS_CTL, 0, CTL_ZERO_BYTES, stream);
    Args a{};
    const float** pp = (const float**)&a.p;
    for (int i = 0; i < 20; ++i) pp[i] = (const float*)d_in[i];
    a.p.out = (float*)d_out; a.p.ws = (unsigned char*)d_ws;
#if MK_PER_PHASE
    for (int ph = 0; ph < 64; ++ph) { a.ph_lo = ph; a.ph_hi = ph + 1; hipLaunchKernelGGL(fwd_megakernel, dim3(grid), dim3(NWAVES * 64), LDS_BYTES, stream, a); }
#else
    a.ph_lo = 0; a.ph_hi = 64;
    void* kargs[] = {&a};
    hipError_t e = hipLaunchCooperativeKernel((const void*)fwd_megakernel, dim3(grid), dim3(NWAVES * 64), kargs, LDS_BYTES, stream);
    if (e != hipSuccess) fprintf(stderr, "kernel_launch: cooperative launch failed: %s (grid %d)\n", hipGetErrorString(e), grid);
#endif
}
```

```cpp
#include <hip/hip_runtime.h>
#include <cstdio>
#include <cstdint>

#ifndef MK_PER_PHASE
#define MK_PER_PHASE 0
#endif

namespace pg8 {
#define PG8_LAS __attribute__((address_space(3)))
typedef unsigned short bf16_t;
typedef short bf16x8 __attribute__((ext_vector_type(8)));
typedef float f32x4 __attribute__((ext_vector_type(4)));
typedef unsigned u32x4 __attribute__((ext_vector_type(4)));
typedef unsigned u32x2 __attribute__((ext_vector_type(2)));
constexpr int BM = 256, BK = 64, HALF = 128, HTB = HALF * BK * 2, STAGE_BYTES = 8 * HTB, NXCD = 8, WGM = 4;

__host__ __device__ __forceinline__ int lds_byte(int r, int c) { const int st = (r >> 4) * 2 + (c >> 5), rr = r & 15, cc = c & 31, ob = rr * 64 + cc * 2; return st * 1024 + (ob ^ (((ob >> 9) & 1) << 5)); }
__host__ __device__ __forceinline__ void stage_rc(int b, int& R, int& C) { const int st = b / 1024, sb = b % 1024, swz = sb ^ (((sb >> 9) & 1) << 5); R = (st >> 1) * 16 + swz / 64; C = (st & 1) * 32 + (swz % 64) / 2; }
__host__ __device__ __forceinline__ int perm32(int rho) { const int n = rho >> 4, i = rho & 15; return 8 * (i >> 2) + 4 * n + (i & 3); }

struct Unit { int pm, pn; };
struct Gemm { const bf16_t* A; const bf16_t* Bt; int M, N, K; };

__device__ __forceinline__ int lane_id_() { int l = (int)__builtin_amdgcn_mbcnt_hi(~0u, __builtin_amdgcn_mbcnt_lo(~0u, 0u)); asm volatile("" : "+v"(l)); return l; }
struct StaticOrder {
    int nM, nN, nwg, G, c, pm0;
    __host__ __device__ void init(int M, int N, int G_, int c_, int pm0_ = 0) { nM = M / BM; nN = N / BM; nwg = nM * nN; G = G_; c = c_; pm0 = pm0_; }
    __host__ __device__ void map(int L, Unit& u) const {
        int wgid = L; { const int q = nwg / NXCD, r = nwg % NXCD, xcd = wgid % NXCD, off = wgid / NXCD; wgid = (xcd < r ? xcd * (q + 1) : r * (q + 1) + (xcd - r) * q) + off; }
        const int nig = WGM * nN, gid = wgid / nig, fm = gid * WGM, gsz = (nM - fm) < WGM ? (nM - fm) : WGM;
        u.pm = pm0 + fm + ((wgid % nig) % gsz); u.pn = (wgid % nig) / gsz;
    }
    __host__ __device__ bool next(int i, Unit& u) const {
        const long L = (long)i * G + c; if (c < 0 || L >= nwg) return false;
        map((int)L, u); return true;
    }
    __device__ __forceinline__ void a_ready(const Unit&) const {}
    __device__ __forceinline__ void done(const Unit&) const {}
    __device__ __forceinline__ void begin() {}
    __device__ __forceinline__ void issue(int) {}
    __device__ __forceinline__ void commit(int) {}
};
struct DynOrder : StaticOrder {
    int NS, NLAB, x, w; unsigned* cq; volatile PG8_LAS int* tk; unsigned pend;
    __device__ __forceinline__ bool t0() const { return w == 0 && lane_id_() == 0; }
    __device__ __forceinline__ int tail_count(int y) const { const int rem = nwg - NS * G - y; return rem <= 0 ? 0 : (rem + NLAB - 1) / NLAB; }
    __device__ __forceinline__ int resolve(unsigned t) const {
        if ((int)t < tail_count(x)) return NS * G + NLAB * (int)t + x;
        for (int d = 1; d < NLAB; ++d) { const int y = (x + d) % NLAB; const unsigned s = __hip_atomic_fetch_add(cq + 64 * y, 1u, __ATOMIC_RELAXED, __HIP_MEMORY_SCOPE_AGENT); if ((int)s < tail_count(y)) return NS * G + NLAB * (int)s + y; }
        return -1;
    }
    __device__ __forceinline__ bool next(int i, Unit& u) const {
        if (i < NS) return StaticOrder::next(i, u);
        const int L = tk[(i - NS) & 1]; if (L < 0) return false;
        map(L, u); return true;
    }
    __device__ __forceinline__ void begin() {
        if (NS < 2) { if (t0()) { for (int j = 0; j < 2 - NS; ++j) tk[j] = resolve(__hip_atomic_fetch_add(cq + 64 * x, 1u, __ATOMIC_RELAXED, __HIP_MEMORY_SCOPE_AGENT)); } __syncthreads(); }
    }
    __device__ __forceinline__ void issue(int ui) { if (ui + 2 >= NS && t0()) pend = __hip_atomic_fetch_add(cq + 64 * x, 1u, __ATOMIC_RELAXED, __HIP_MEMORY_SCOPE_AGENT); }
    __device__ __forceinline__ void commit(int ui) { if (ui + 2 >= NS && t0()) tk[(ui + 2 - NS) & 1] = resolve(pend); }
};

typedef __bf16 bf16x2_n __attribute__((ext_vector_type(2)));
typedef float f32x2_n __attribute__((ext_vector_type(2)));
__device__ __forceinline__ unsigned cvt_pk_bf16(float lo, float hi) { unsigned r; asm volatile("s_nop 0\n\tv_cvt_pk_bf16_f32 %0, %1, %2" : "=v"(r) : "v"(lo), "v"(hi)); return r; }
__device__ __forceinline__ float bf_lo(unsigned u) { return __uint_as_float(u << 16); }
__device__ __forceinline__ float bf_hi(unsigned u) { return __uint_as_float(u & 0xffff0000u); }
__device__ __forceinline__ float sigmoidf_(float x) { return __builtin_amdgcn_rcpf(1.0f + __expf(-x)); }
__device__ __forceinline__ f32x4 exp2m4(const f32x4 x) { const f32x4 t = x * (-1.4426950408889634f); f32x4 e; e[0] = __builtin_amdgcn_exp2f(t[0]); e[1] = __builtin_amdgcn_exp2f(t[1]); e[2] = __builtin_amdgcn_exp2f(t[2]); e[3] = __builtin_amdgcn_exp2f(t[3]); return e; }
__device__ __forceinline__ f32x4 rcp4(const f32x4 d) { f32x4 r; r[0] = __builtin_amdgcn_rcpf(d[0]); r[1] = __builtin_amdgcn_rcpf(d[1]); r[2] = __builtin_amdgcn_rcpf(d[2]); r[3] = __builtin_amdgcn_rcpf(d[3]); return r; }
__device__ __forceinline__ f32x4 sigmoid4(const f32x4 x) { return rcp4(exp2m4(x) + 1.0f); }
__device__ __forceinline__ u32x4 pack8(const f32x4 a, const f32x4 b) { u32x4 w; w.x = cvt_pk_bf16(a[0], a[1]); w.y = cvt_pk_bf16(a[2], a[3]); w.z = cvt_pk_bf16(b[0], b[1]); w.w = cvt_pk_bf16(b[2], b[3]); return w; }
__device__ __forceinline__ void unpack8(const u32x4 w, f32x4& a, f32x4& b) { a[0] = bf_lo(w.x); a[1] = bf_hi(w.x); a[2] = bf_lo(w.y); a[3] = bf_hi(w.y); b[0] = bf_lo(w.z); b[1] = bf_hi(w.z); b[2] = bf_lo(w.w); b[3] = bf_hi(w.w); }


typedef __amdgpu_buffer_rsrc_t rsrc_t;
__device__ __forceinline__ rsrc_t mkrsrc(const void* p) { return __builtin_amdgcn_make_buffer_rsrc(const_cast<void*>(p), 0, 0x7fffffff, 0x00020000); }
__device__ __forceinline__ u32x4 bld16(rsrc_t r, unsigned voff, unsigned soff) { return __builtin_amdgcn_raw_buffer_load_b128(r, (int)voff, (int)soff, 0); }
__device__ __forceinline__ u32x4 bld16nt(rsrc_t r, unsigned voff, unsigned soff) { return __builtin_amdgcn_raw_buffer_load_b128(r, (int)voff, (int)soff, 2); }
__device__ __forceinline__ void bst16(rsrc_t r, unsigned voff, unsigned soff, u32x4 v) { unsigned vo = voff + soff; asm volatile("" : "+v"(vo)); __builtin_amdgcn_raw_buffer_store_b128(v, r, (int)vo, 0, 0); }
__device__ __forceinline__ f32x4 as_f(u32x4 v) { return __builtin_bit_cast(f32x4, v); }
__device__ __forceinline__ u32x4 as_u(f32x4 v) { return __builtin_bit_cast(u32x4, v); }

constexpr int XOFF = 131072 + 8192;
constexpr int SLV_ROW0 = 16384;
struct EpiInProj {
    static constexpr bool PERM = true, AFTER_DRAIN = false, MID = false;
    bf16_t *QZ, *S, *V, *GA, *GB;
    __device__ __forceinline__ void mid(f32x4 (&)[2][2][4][2], const Unit&, int, int, int, int) const {}
    template <int TYPE> __device__ __forceinline__ void pair(const f32x4 (&acc)[2][2][4][2], rsrc_t r, unsigned sbase, unsigned voff, unsigned ldb) const {
#pragma unroll
        for (int ai = 0; ai < 2; ++ai)
#pragma unroll
            for (int m = 0; m < 4; ++m) {
                f32x4 o[2];
#pragma unroll
                for (int bj = 0; bj < 2; ++bj) { const f32x4 X = acc[ai][bj][m][0], Y = acc[ai][bj][m][1];
                    if (TYPE == 1) o[bj] = X * Y; else { const f32x4 sg = sigmoid4(Y); o[bj] = TYPE == 0 ? X * Y * sg : X * sg; } }
                bst16(r, voff, sbase + (unsigned)(ai * HALF + m * 16) * ldb, pack8(o[0], o[1]));
            }
    }
    template <int TYPE> __device__ __forceinline__ void single(const f32x4 (&acc)[2][2][4][2], rsrc_t r, unsigned sbase, unsigned voff, unsigned ldb) const {
#pragma unroll
        for (int ai = 0; ai < 2; ++ai)
#pragma unroll
            for (int m = 0; m < 4; ++m)
#pragma unroll
                for (int bj = 0; bj < 2; ++bj) { f32x4 v0 = acc[ai][bj][m][0], v1 = acc[ai][bj][m][1];
                    { const f32x4 s0 = sigmoid4(v0), s1 = sigmoid4(v1); v0 = TYPE == 0 ? v0 * s0 : s0; v1 = TYPE == 0 ? v1 * s1 : s1; }
                    bst16(r, voff, sbase + (unsigned)(ai * HALF + m * 16) * ldb + bj * (HALF * 2), pack8(v0, v1)); }
    }
    __device__ __forceinline__ void operator()(const f32x4 (&acc)[2][2][4][2], const Unit& u, int wr, int wc, int fr, int fq) const {
        const unsigned urow = u.pm * BM + wr * 64, pn = u.pn;
        if (pn < 24) {
            const unsigned type = pn >> 3, ucb = (pn & 7) * 128 + 32 * wc;
            if (type == 0) pair<0>(acc, mkrsrc(QZ), (urow * 2048 + ucb) * 2, (unsigned)(fr * 2048 + 8 * fq) * 2u, 4096);
            else if (type == 1) pair<1>(acc, mkrsrc(S), (urow * 1024 + ucb) * 2, (unsigned)(fr * 1024 + 8 * fq) * 2u, 2048);
            else pair<2>(acc, mkrsrc(V), (urow * 1024 + ucb) * 2, (unsigned)(fr * 1024 + 8 * fq) * 2u, 2048);
        } else if (pn < 28) {
            const unsigned ucb = (pn - 24) * 256 + wc * 32;
            single<0>(acc, mkrsrc(QZ), (urow * 2048 + 1024 + ucb) * 2, (unsigned)(fr * 2048 + 8 * fq) * 2u, 4096);
        } else {
            const unsigned ucb = (pn - 28) * 128 + 32 * wc; const rsrc_t ra = mkrsrc(GA), rb = mkrsrc(GB); const unsigned sbase = (urow * 1024 + ucb) * 2, voff = (unsigned)(fr * 1024 + 8 * fq) * 2u;
#pragma unroll
            for (int ai = 0; ai < 2; ++ai)
#pragma unroll
                for (int m = 0; m < 4; ++m) { f32x4 ro[2], go[2];
#pragma unroll
                    for (int bj = 0; bj < 2; ++bj) { const f32x4 X = acc[ai][bj][m][0], Y = acc[ai][bj][m][1];
                        const f32x4 da = exp2m4(X) + 1.0f; f32x4 eb = exp2m4(Y);
#pragma unroll
                        for (int j = 0; j < 4; ++j) eb[j] = fminf(eb[j], 1e30f);
                        const f32x4 db = eb + 1.0f; go[bj] = rcp4(db); ro[bj] = db * rcp4(da); }
                    bst16(ra, voff, sbase + (unsigned)(ai * HALF + m * 16) * 2048, pack8(ro[0], ro[1])); bst16(rb, voff, sbase + (unsigned)(ai * HALF + m * 16) * 2048, pack8(go[0], go[1])); }
        }
    }
};
struct EpiPlain {
    static constexpr bool PERM = true, AFTER_DRAIN = false, MID = false;
    bf16_t* O; int ldc;
    __device__ __forceinline__ void mid(f32x4 (&)[2][2][4][2], const Unit&, int, int, int, int) const {}
    __device__ __forceinline__ void operator()(const f32x4 (&acc)[2][2][4][2], const Unit& u, int wr, int wc, int fr, int fq) const {
        const rsrc_t r = mkrsrc(O); const unsigned sb = ((unsigned)(u.pm * BM + wr * 64) * ldc + u.pn * BM + wc * 32) * 2, voff = (unsigned)(fr * ldc + 8 * fq) * 2u;
        asm volatile("s_nop 7\n\ts_nop 7" ::: "memory");
#pragma unroll
        for (int ai = 0; ai < 2; ++ai)
#pragma unroll
            for (int m = 0; m < 4; ++m)
#pragma unroll
                for (int bj = 0; bj < 2; ++bj) bst16(r, voff, sb + (unsigned)(ai * HALF + m * 16) * ldc * 2 + bj * (HALF * 2), pack8(acc[ai][bj][m][0], acc[ai][bj][m][1]));
    }
};
struct EpiOutGate {
    static constexpr bool PERM = true, AFTER_DRAIN = false, MID = true;
    const bf16_t *GA, *GB; bf16_t* Mo;
    __device__ __forceinline__ void mid(f32x4 (&acc)[2][2][4][2], const Unit& u, int wr, int wc, int fr, int fq) const {
        const rsrc_t ra = mkrsrc(GA);
        const unsigned sb = ((unsigned)(u.pm * BM + wr * 64) * 1024 + u.pn * BM + wc * 32) * 2, voff = (unsigned)(fr * 1024 + 8 * fq) * 2u;
        u32x4 ga[2][2];
#pragma unroll
        for (int bj = 0; bj < 2; ++bj) ga[0][bj] = bld16nt(ra, voff, sb + bj * 256);
#pragma unroll
        for (int g = 0; g < 8; ++g) { const int ai = g >> 2, m = g & 3;
            if (g + 1 < 8) { const unsigned so = sb + (unsigned)(((g + 1) >> 2) * HALF + ((g + 1) & 3) * 16) * 2048;
#pragma unroll
                for (int bj = 0; bj < 2; ++bj) ga[(g + 1) & 1][bj] = bld16nt(ra, voff, so + bj * 256); }
#pragma unroll
            for (int bj = 0; bj < 2; ++bj) { f32x4 a0, a1; unpack8(ga[g & 1][bj], a0, a1); acc[ai][bj][m][0] *= a0; acc[ai][bj][m][1] *= a1; }
            asm volatile("" ::: "memory"); }
    }
    __device__ __forceinline__ unsigned slv_so(const Unit& u, int wr, int wc) const { return ((unsigned)(SLV_ROW0 + 16 * u.pm) * 1024 + u.pn * BM + wr * HALF + wc * 32) * 2; }
    __device__ __forceinline__ u32x4 slv_mid_pre(const Unit& u, int wr, int wc, int fr, int fq) const { return bld16nt(mkrsrc(GA), (unsigned)(fr * 1024 + 8 * fq) * 2u, slv_so(u, wr, wc)); }
    __device__ __forceinline__ void slv_mid(f32x4 (&x)[2], const u32x4 ga) const { f32x4 a0, a1; unpack8(ga, a0, a1); x[0] *= a0; x[1] *= a1; }
    __device__ __forceinline__ u32x4 slv_pre(const Unit& u, int wr, int wc, int fr, int fq) const { return bld16nt(mkrsrc(GB), (unsigned)(fr * 1024 + 8 * fq) * 2u, slv_so(u, wr, wc)); }
    __device__ __forceinline__ void slv(const f32x4 (&x)[2], const u32x4 gb, const Unit& u, int wr, int wc, int fr, int fq) const {
        f32x4 b0, b1; unpack8(gb, b0, b1); bst16(mkrsrc(Mo), (unsigned)(fr * 1024 + 8 * fq) * 2u, slv_so(u, wr, wc), pack8(x[0] * b0, x[1] * b1));
    }
    __device__ __forceinline__ void operator()(const f32x4 (&acc)[2][2][4][2], const Unit& u, int wr, int wc, int fr, int fq) const {
        const rsrc_t rb = mkrsrc(GB), ro = mkrsrc(Mo);
        const unsigned sb = ((unsigned)(u.pm * BM + wr * 64) * 1024 + u.pn * BM + wc * 32) * 2, voff = (unsigned)(fr * 1024 + 8 * fq) * 2u;
        u32x4 gb[2][2];
#pragma unroll
        for (int bj = 0; bj < 2; ++bj) gb[0][bj] = bld16nt(rb, voff, sb + bj * 256);
#pragma unroll
        for (int g = 0; g < 8; ++g) { const int ai = g >> 2, m = g & 3; const unsigned so0 = sb + (unsigned)(ai * HALF + m * 16) * 2048;
            if (g + 1 < 8) { const unsigned so = sb + (unsigned)(((g + 1) >> 2) * HALF + ((g + 1) & 3) * 16) * 2048;
#pragma unroll
                for (int bj = 0; bj < 2; ++bj) gb[(g + 1) & 1][bj] = bld16nt(rb, voff, so + bj * 256); }
#pragma unroll
            for (int bj = 0; bj < 2; ++bj) { f32x4 b0, b1; unpack8(gb[g & 1][bj], b0, b1);
                bst16(ro, voff, so0 + bj * 256, pack8(acc[ai][bj][m][0] * b0, acc[ai][bj][m][1] * b1)); }
            asm volatile("" ::: "memory"); }
    }
};
struct EpiWo {
    static constexpr bool PERM = true, AFTER_DRAIN = false, MID = false;
    const bf16_t* XBn; const float* irs; bf16_t* HB; float* part; float* partS;
    __device__ __forceinline__ void mid(f32x4 (&)[2][2][4][2], const Unit&, int, int, int, int) const {}
    struct XPre { u32x4 xb; float ir; };
    __device__ __forceinline__ unsigned slv_so(const Unit& u, int wr, int wc) const { return ((unsigned)(SLV_ROW0 + 16 * u.pm) * 1024 + u.pn * BM + wr * HALF + wc * 32) * 2; }
    __device__ __forceinline__ XPre slv_pre(const Unit& u, int wr, int wc, int fr, int fq) const { XPre p; p.xb = bld16nt(mkrsrc(XBn), (unsigned)(fr * 1024 + 8 * fq) * 2u, slv_so(u, wr, wc)); p.ir = irs[SLV_ROW0 + 16 * u.pm + fr]; return p; }
    __device__ __forceinline__ void slv(const f32x4 (&x)[2], const XPre& p, const Unit& u, int wr, int wc, int fr, int fq) const {
        f32x4 x0, x1; unpack8(p.xb, x0, x1); const f32x4 h0 = x0 * p.ir + x[0], h1 = x1 * p.ir + x[1];
        bst16(mkrsrc(HB), (unsigned)(fr * 1024 + 8 * fq) * 2u, slv_so(u, wr, wc), pack8(h0, h1));
        float ss = (h0[0] * h0[0] + h0[1] * h0[1]) + (h0[2] * h0[2] + h0[3] * h0[3]) + (h1[0] * h1[0] + h1[1] * h1[1]) + (h1[2] * h1[2] + h1[3] * h1[3]);
        ss += __shfl_xor(ss, 16); ss += __shfl_xor(ss, 32);
        if (fq == 0) partS[(size_t)(16 * u.pm + fr) * 32 + u.pn * 8 + wr * 4 + wc] = ss;
    }
    __device__ __forceinline__ void operator()(const f32x4 (&acc)[2][2][4][2], const Unit& u, int wr, int wc, int fr, int fq) const {
        const unsigned urow = u.pm * BM + wr * 64, ucol = u.pn * BM + wc * 32;
        const rsrc_t rx = mkrsrc(XBn), rb = mkrsrc(HB);
        const unsigned ue = urow * 1024 + ucol, ve = (unsigned)(fr * 1024 + 8 * fq);
        float* pq = part + (size_t)(urow + fr) * 16 + u.pn * 4 + wc; const float* iq = irs + urow + fr;
        u32x4 xb[2][2]; float ir[2];
#pragma unroll
        for (int bj = 0; bj < 2; ++bj) xb[0][bj] = bld16nt(rx, ve * 2u, ue * 2u + bj * 256);
        ir[0] = iq[0];
#pragma unroll
        for (int g = 0; g < 8; ++g) { const int ai = g >> 2, m = g & 3; const unsigned ro = (unsigned)(ai * HALF + m * 16) * 1024; float ss = 0.f;
            if (g + 1 < 8) { const unsigned rn = (unsigned)(((g + 1) >> 2) * HALF + ((g + 1) & 3) * 16);
#pragma unroll
                for (int bj = 0; bj < 2; ++bj) xb[(g + 1) & 1][bj] = bld16nt(rx, ve * 2u, (ue + rn * 1024) * 2u + bj * 256);
                ir[(g + 1) & 1] = iq[rn]; }
#pragma unroll
            for (int bj = 0; bj < 2; ++bj) { f32x4 x0, x1; unpack8(xb[g & 1][bj], x0, x1);
                const f32x4 h0 = x0 * ir[g & 1] + acc[ai][bj][m][0], h1 = x1 * ir[g & 1] + acc[ai][bj][m][1];
                bst16(rb, ve * 2u, (ue + ro) * 2u + bj * 256, pack8(h0, h1));
                ss += (h0[0] * h0[0] + h0[1] * h0[1]) + (h0[2] * h0[2] + h0[3] * h0[3]) + (h1[0] * h1[0] + h1[1] * h1[1]) + (h1[2] * h1[2] + h1[3] * h1[3]); }
            ss += __shfl_xor(ss, 16); ss += __shfl_xor(ss, 32);
            if (fq == 0) pq[(ai * HALF + m * 16) * 16] = ss;
            asm volatile("" ::: "memory"); }
    }
};
struct EpiPg {
    static constexpr bool PERM = true, AFTER_DRAIN = false, MID = false;
    float* H; const bf16_t* HB; const bf16_t* PE; const float* part;
    __device__ __forceinline__ void mid(f32x4 (&)[2][2][4][2], const Unit&, int, int, int, int) const {}
    __device__ __forceinline__ void operator()(const f32x4 (&acc)[2][2][4][2], const Unit& u, int wr, int wc, int fr, int fq) const {
        const unsigned urow = u.pm * BM + wr * 64, ucol = u.pn * BM + wc * 32;
        const rsrc_t rh = mkrsrc(H), rp = mkrsrc(PE), rhb = mkrsrc(HB);
        const unsigned ue = urow * 1024 + ucol, ve = (unsigned)(fr * 1024 + 8 * fq);
        const float* pq = part + (size_t)(urow + fr) * 16 + 4 * fq;
#pragma unroll
        for (int ai = 0; ai < 2; ++ai)
#pragma unroll
            for (int m = 0; m < 4; ++m) { const unsigned ro = (unsigned)(ai * HALF + m * 16) * 1024;
                float rs; { const f32x4 pv = *(const f32x4*)(pq + (ai * HALF + m * 16) * 16); rs = (pv[0] + pv[1]) + (pv[2] + pv[3]); rs += __shfl_xor(rs, 16); rs += __shfl_xor(rs, 32); }
                const float rstd = 1.0f / sqrtf(rs * (1.0f / 1024.0f) + 1e-6f);
#pragma unroll
                for (int bj = 0; bj < 2; ++bj) {
                    f32x4 h0, h1; unpack8(bld16(rhb, ve * 2u, (ue + ro) * 2u + bj * 256), h0, h1); const u32x4 pe = bld16(rp, ve * 2u, (ue + ro) * 2u + bj * 256); f32x4 p0, p1; unpack8(pe, p0, p1);
#pragma unroll
                    for (int j = 0; j < 4; ++j) { h0[j] += sigmoidf_(acc[ai][bj][m][0][j] * rstd) * p0[j]; h1[j] += sigmoidf_(acc[ai][bj][m][1][j] * rstd) * p1[j]; }
                    bst16(rh, ve * 4u, (ue + ro) * 4u + bj * 512, as_u(h0)); bst16(rh, ve * 4u, (ue + ro) * 4u + bj * 512 + 16, as_u(h1)); }
                asm volatile("" ::: "memory"); }
    }
};

__device__ __forceinline__ void agent_store_f32(float* p, float v) { __hip_atomic_store(p, v, __ATOMIC_RELAXED, __HIP_MEMORY_SCOPE_AGENT); }
__device__ __forceinline__ float agent_load_f32(const float* p) { return __hip_atomic_load(p, __ATOMIC_RELAXED, __HIP_MEMORY_SCOPE_AGENT); }
__device__ __forceinline__ void wait_count(unsigned* cnt, unsigned want) {
    unsigned sp = 0;
    while ((unsigned)__builtin_amdgcn_readfirstlane(__hip_atomic_load(cnt, __ATOMIC_RELAXED, __HIP_MEMORY_SCOPE_AGENT)) < want) { __builtin_amdgcn_s_sleep(2); if (++sp > (1u << 21)) break; }
    asm volatile("" ::: "memory");
}
struct EpiPgFinal {
    static constexpr bool PERM = true, AFTER_DRAIN = true, MID = false;
    float* Y; const bf16_t* HB; const bf16_t* PE; const float* part; const float* gfin; float* xs; unsigned* cnt;
    const float* partS; float* xsS;
    __device__ __forceinline__ void mid(f32x4 (&)[2][2][4][2], const Unit&, int, int, int, int) const {}
    __device__ __forceinline__ void fused(f32x4 (&acc)[2][2][4][2], f32x4 (&x)[2], const Unit& u, int wr, int wc, int fr, int fq, PG8_LAS unsigned char* lds, int wid, int lane) const {
        const unsigned urow = u.pm * BM + wr * 64, ucol = u.pn * BM + wc * 32;
        const rsrc_t ry = mkrsrc(Y), rp = mkrsrc(PE), rhb = mkrsrc(HB);
        const unsigned ue = urow * 1024 + ucol, ve = (unsigned)(fr * 1024 + 8 * fq);
        const float* pq = part + (size_t)(urow + fr) * 16 + 4 * fq;
        PG8_LAS float* Pt = (PG8_LAS float*)lds;
        PG8_LAS float* St = (PG8_LAS float*)(lds + 4096);
        PG8_LAS float* PtS = (PG8_LAS float*)(lds + 6144);
        PG8_LAS float* StS = (PG8_LAS float*)(lds + 6656);
        const unsigned xe = (unsigned)(SLV_ROW0 + 16 * u.pm) * 1024 + u.pn * BM + wr * HALF + wc * 32;
        const u32x4 xhb = bld16nt(rhb, ve * 2u, xe * 2u), xpe = bld16nt(rp, ve * 2u, xe * 2u);
        const f32x4 xpv0 = *(const f32x4*)(partS + (size_t)(16 * u.pm + fr) * 32 + 8 * fq), xpv1 = *(const f32x4*)(partS + (size_t)(16 * u.pm + fr) * 32 + 8 * fq + 4);
#pragma unroll
        for (int ai = 0; ai < 2; ++ai)
#pragma unroll
            for (int m = 0; m < 4; ++m) { const unsigned ro = (unsigned)(ai * HALF + m * 16) * 1024;
                float rs; { const f32x4 pv = *(const f32x4*)(pq + (ai * HALF + m * 16) * 16); rs = (pv[0] + pv[1]) + (pv[2] + pv[3]); rs += __shfl_xor(rs, 16); rs += __shfl_xor(rs, 32); }
                const float rstd = 1.0f / sqrtf(rs * (1.0f / 1024.0f) + 1e-6f); float ss = 0.f;
#pragma unroll
                for (int bj = 0; bj < 2; ++bj) {
                    f32x4 h0, h1; unpack8(bld16nt(rhb, ve * 2u, (ue + ro) * 2u + bj * 256), h0, h1); const u32x4 pe = bld16nt(rp, ve * 2u, (ue + ro) * 2u + bj * 256); f32x4 p0, p1; unpack8(pe, p0, p1);
#pragma unroll
                    for (int j = 0; j < 4; ++j) { h0[j] += sigmoidf_(acc[ai][bj][m][0][j] * rstd) * p0[j]; h1[j] += sigmoidf_(acc[ai][bj][m][1][j] * rstd) * p1[j]; }
                    acc[ai][bj][m][0] = h0; acc[ai][bj][m][1] = h1;
                    ss += (h0[0] * h0[0] + h0[1] * h0[1]) + (h0[2] * h0[2] + h0[3] * h0[3]) + (h1[0] * h1[0] + h1[1] * h1[1]) + (h1[2] * h1[2] + h1[3] * h1[3]); }
                ss += __shfl_xor(ss, 16); ss += __shfl_xor(ss, 32);
                if (fq == 0) Pt[(ai * HALF + wr * 64 + m * 16 + fr) * 4 + wc] = ss;
                asm volatile("" ::: "memory"); }
        {
            float rs = ((xpv0[0] + xpv0[1]) + (xpv0[2] + xpv0[3])) + ((xpv1[0] + xpv1[1]) + (xpv1[2] + xpv1[3])); rs += __shfl_xor(rs, 16); rs += __shfl_xor(rs, 32);
            const float rstd = 1.0f / sqrtf(rs * (1.0f / 1024.0f) + 1e-6f);
            f32x4 h0, h1, p0, p1; unpack8(xhb, h0, h1); unpack8(xpe, p0, p1);
#pragma unroll
            for (int j = 0; j < 4; ++j) { h0[j] += sigmoidf_(x[0][j] * rstd) * p0[j]; h1[j] += sigmoidf_(x[1][j] * rstd) * p1[j]; }
            x[0] = h0; x[1] = h1;
            float ss = (h0[0] * h0[0] + h0[1] * h0[1]) + (h0[2] * h0[2] + h0[3] * h0[3]) + (h1[0] * h1[0] + h1[1] * h1[1]) + (h1[2] * h1[2] + h1[3] * h1[3]);
            ss += __shfl_xor(ss, 16); ss += __shfl_xor(ss, 32);
            if (fq == 0) PtS[fr * 8 + wid] = ss;
        }
        asm volatile("s_waitcnt lgkmcnt(0)" ::: "memory"); __builtin_amdgcn_s_barrier(); asm volatile("" ::: "memory");
        const int row = wid * 32 + (lane & 31);
        if (lane < 32) { const f32x4 pv = *(const PG8_LAS f32x4*)(Pt + row * 4); agent_store_f32(xs + (size_t)(u.pm * BM + row) * 4 + u.pn, (pv[0] + pv[1]) + (pv[2] + pv[3])); }
        else if (wid == 0 && lane < 48) { const f32x4 a = *(const PG8_LAS f32x4*)(PtS + (lane - 32) * 8), b = *(const PG8_LAS f32x4*)(PtS + (lane - 32) * 8 + 4);
            agent_store_f32(xsS + (size_t)(16 * u.pm + lane - 32) * 4 + u.pn, ((a[0] + a[1]) + (a[2] + a[3])) + ((b[0] + b[1]) + (b[2] + b[3]))); }
        asm volatile("s_waitcnt vmcnt(0)" ::: "memory");
        if (lane == 0) __hip_atomic_fetch_add(cnt + 64 * u.pm, 1u, __ATOMIC_RELAXED, __HIP_MEMORY_SCOPE_AGENT);
        if (wid == 0) wait_count(cnt + 64 * u.pm, 32u);
        asm volatile("s_waitcnt vmcnt(0) lgkmcnt(0)" ::: "memory"); __builtin_amdgcn_s_barrier(); asm volatile("" ::: "memory");
        if (lane < 32) { const float* sp = xs + (size_t)(u.pm * BM + row) * 4; const float q = (agent_load_f32(sp) + agent_load_f32(sp + 1)) + (agent_load_f32(sp + 2) + agent_load_f32(sp + 3));
            St[row] = 1.0f / sqrtf(q * (1.0f / 1024.0f) + 1e-6f); }
        else if (wid == 0 && lane < 48) { const float* sp = xsS + (size_t)(16 * u.pm + lane - 32) * 4; const float q = (agent_load_f32(sp) + agent_load_f32(sp + 1)) + (agent_load_f32(sp + 2) + agent_load_f32(sp + 3));
            StS[lane - 32] = 1.0f / sqrtf(q * (1.0f / 1024.0f) + 1e-6f); }
        asm volatile("s_waitcnt lgkmcnt(0)" ::: "memory"); __builtin_amdgcn_s_barrier(); asm volatile("" ::: "memory");
        f32x4 g[2][2];
#pragma unroll
        for (int bj = 0; bj < 2; ++bj)
#pragma unroll
            for (int n = 0; n < 2; ++n) g[bj][n] = *(const f32x4*)(gfin + ucol + bj * HALF + 8 * fq + 4 * n);
#pragma unroll
        for (int ai = 0; ai < 2; ++ai)
#pragma unroll
            for (int m = 0; m < 4; ++m) { const unsigned ro = (unsigned)(ai * HALF + m * 16) * 1024; const float r3 = St[ai * HALF + wr * 64 + m * 16 + fr];
#pragma unroll
                for (int bj = 0; bj < 2; ++bj) { bst16(ry, ve * 4u, (ue + ro) * 4u + bj * 512, as_u(acc[ai][bj][m][0] * r3 * g[bj][0])); bst16(ry, ve * 4u, (ue + ro) * 4u + bj * 512 + 16, as_u(acc[ai][bj][m][1] * r3 * g[bj][1])); } }
        {
            const float r3 = StS[fr]; const f32x4 g0 = wr == 0 ? g[0][0] : g[1][0], g1 = wr == 0 ? g[0][1] : g[1][1];
            bst16(ry, ve * 4u, xe * 4u, as_u(x[0] * r3 * g0)); bst16(ry, ve * 4u, xe * 4u + 16, as_u(x[1] * r3 * g1));
        }
    }
};

template <class Epi, class Sched, bool ALIGN_EPI = false, bool SP2 = false, bool SLV = false>
__device__ __forceinline__ void gemm_phase(PG8_LAS unsigned char* lds, const Gemm g, Sched& S, const Epi& E, const int wid) {
    static_assert(!SLV || SP2, "the sliver is scheduled into the two-super-phase loop only");
    const int lane = lane_id_(), tid = wid * 64 + lane, wr = wid >> 2, wc = wid & 3, fr = lane & 15, fq = lane >> 4;
    const int K = g.K, nt = K / BK;
    unsigned voffA[2], voffB[2];
#pragma unroll
    for (int i = 0; i < 2; ++i) { int R, C; stage_rc(tid * 16 + i * 8192, R, C); const int Rb = Epi::PERM ? ((R & ~31) + perm32(R & 31)) : R;
        voffA[i] = (unsigned)(R * K + C) * 2u; voffB[i] = (unsigned)(Rb * K + C) * 2u; }
    const size_t kstep = (size_t)(BK * 2);
    const size_t hstep = (size_t)HALF * K * 2;
    const size_t tstep = 2 * hstep;
    const unsigned ldsw = (unsigned)wid * 1024u;
    const int aoff = lds_byte(wr * 64 + fr, fq * 8), boff = lds_byte(wc * 32 + fr, fq * 8);
    const unsigned voffX = (unsigned)((lane >> 2) * K * 2 + wid * 16 + (lane & 3) * 4);
#define PG8_STAGE_X(b, gbase) __builtin_amdgcn_global_load_lds((const unsigned*)((const char*)(gbase) + voffX), (PG8_LAS unsigned*)(lds + XOFF + (b) * 2048 + wid * 256), 4, 0, 0)
#define PG8_LDX(b) do { _Pragma("unroll") for (int k = 0; k < 2; ++k) Xt[k] = *(const PG8_LAS bf16x8*)(lds + XOFF + (b) * 2048 + k * 1024 + lane * 16); } while (0)
#define PG8_XMMA() do { __builtin_amdgcn_s_setprio(1); if (wr == 0) { _Pragma("unroll") for (int n = 0; n < 2; ++n) _Pragma("unroll") for (int k = 0; k < 2; ++k) xacc[n] = __builtin_amdgcn_mfma_f32_16x16x32_bf16(B0[n][k], Xt[k], xacc[n], 0, 0, 0); } \
        else { _Pragma("unroll") for (int n = 0; n < 2; ++n) _Pragma("unroll") for (int k = 0; k < 2; ++k) xacc[n] = __builtin_amdgcn_mfma_f32_16x16x32_bf16(B1[n][k], Xt[k], xacc[n], 0, 0, 0); } __builtin_amdgcn_s_setprio(0); } while (0)
#define PG8_WAIT_VS() do { if constexpr (SLV) PG8_WAIT_V(9); else PG8_WAIT_V(8); } while (0)
#define PG8_SA(b, h) (((b) * 2 + (h)) * HTB)
#define PG8_SB(b, h) ((4 + (b) * 2 + (h)) * HTB)
#define PG8_STAGE(bufoff, gbase, voff) do { _Pragma("unroll") for (int _i = 0; _i < 2; ++_i) \
        __builtin_amdgcn_global_load_lds((const unsigned*)((const char*)(gbase) + (voff)[_i]), (PG8_LAS unsigned*)(lds + (bufoff) + ldsw + _i * 8192), 16, 0, 0); } while (0)
#define PG8_LDA(dst, b, h) do { _Pragma("unroll") for (int m = 0; m < 4; ++m) _Pragma("unroll") for (int k = 0; k < 2; ++k) dst[m][k] = *(const PG8_LAS bf16x8*)(lds + PG8_SA(b, h) + aoff + m * 2048 + k * 1024); } while (0)
#define PG8_LDB(dst, b, h) do { _Pragma("unroll") for (int n = 0; n < 2; ++n) _Pragma("unroll") for (int k = 0; k < 2; ++k) dst[n][k] = *(const PG8_LAS bf16x8*)(lds + PG8_SB(b, h) + boff + n * 2048 + k * 1024); } while (0)
#define PG8_MMA(ai, bj, At, Bt) do { __builtin_amdgcn_s_setprio(1); _Pragma("unroll") for (int m = 0; m < 4; ++m) _Pragma("unroll") for (int n = 0; n < 2; ++n) _Pragma("unroll") for (int k = 0; k < 2; ++k) \
        acc[ai][bj][m][n] = __builtin_amdgcn_mfma_f32_16x16x32_bf16(Bt[n][k], At[m][k], acc[ai][bj][m][n], 0, 0, 0); __builtin_amdgcn_s_setprio(0); } while (0)
#define PG8_WAIT_V(n) asm volatile("s_waitcnt vmcnt(" #n ")" ::: "memory")
#define PG8_WAIT_L(n) asm volatile("s_waitcnt lgkmcnt(" #n ")" ::: "memory")
#define PG8_BAR __builtin_amdgcn_s_barrier()
#define PG8_SCHED __builtin_amdgcn_sched_barrier(0)
    Unit cur, nxt; int ui = 0;
    S.begin();
    if (!S.next(0, cur)) return;
    f32x4 acc[2][2][4][2];
#pragma unroll
    for (int a = 0; a < 2; ++a)
#pragma unroll
        for (int b = 0; b < 2; ++b)
#pragma unroll
            for (int m = 0; m < 4; ++m)
#pragma unroll
                for (int n = 0; n < 2; ++n) acc[a][b][m][n] = (f32x4){0.f, 0.f, 0.f, 0.f};
    bf16x8 At[4][2], B0[2][2], B1[2][2];
    f32x4 xacc[2] = {(f32x4){0.f, 0.f, 0.f, 0.f}, (f32x4){0.f, 0.f, 0.f, 0.f}}; bf16x8 Xt[2];
    const char* cA = (const char*)g.A + (size_t)cur.pm * tstep; const char* cB = (const char*)g.Bt + (size_t)cur.pn * tstep;
    const char* cX = (const char*)g.A + ((size_t)g.M + 16 * cur.pm) * K * 2;
    S.a_ready(cur);
    if constexpr (SP2) {
        PG8_STAGE(PG8_SB(0, 0), cB, voffB); PG8_STAGE(PG8_SB(0, 1), cB + hstep, voffB); PG8_STAGE(PG8_SA(0, 0), cA, voffA); if constexpr (SLV) PG8_STAGE_X(0, cX); PG8_STAGE(PG8_SA(0, 1), cA + hstep, voffA);
        if (wr == 1) PG8_BAR;
        PG8_WAIT_V(2); PG8_BAR;
        PG8_STAGE(PG8_SB(1, 0), cB + kstep, voffB); PG8_STAGE(PG8_SA(1, 0), cA + kstep, voffA); PG8_STAGE(PG8_SB(1, 1), cB + hstep + kstep, voffB); if constexpr (SLV) PG8_STAGE_X(1, cX + kstep);
        if constexpr (SLV) PG8_WAIT_V(7); else PG8_WAIT_V(6);
        PG8_BAR;
    } else {
        PG8_STAGE(PG8_SB(0, 0), cB, voffB); PG8_STAGE(PG8_SA(0, 0), cA, voffA); PG8_STAGE(PG8_SB(0, 1), cB + hstep, voffB); PG8_STAGE(PG8_SA(0, 1), cA + hstep, voffA);
        if (wr == 1) PG8_BAR;
        PG8_WAIT_V(4); PG8_BAR;
        PG8_STAGE(PG8_SB(1, 0), cB + kstep, voffB); PG8_STAGE(PG8_SA(1, 0), cA + kstep, voffA); PG8_STAGE(PG8_SB(1, 1), cB + hstep + kstep, voffB);
        PG8_WAIT_V(6); PG8_BAR;
    }
    for (;;) {
        const bool has_next = S.next(ui + 1, nxt);
        S.issue(ui);
        const char* nA = has_next ? (const char*)g.A + (size_t)nxt.pm * tstep : cA; const char* nB = has_next ? (const char*)g.Bt + (size_t)nxt.pn * tstep : cB;
        const char* nX = has_next ? (const char*)g.A + ((size_t)g.M + 16 * nxt.pm) * K * 2 : cX;
        for (int th = 0; th < (Epi::MID ? 2 : 1); ++th) {
        if constexpr (Epi::MID) { if (th == 1) { const int le = lane_id_(), fr = le & 15, fq = le >> 4;
            if constexpr (SLV) { const auto xp = E.slv_mid_pre(cur, wr, wc, fr, fq); E.mid(acc, cur, wr, wc, fr, fq); E.slv_mid(xacc, xp); } else E.mid(acc, cur, wr, wc, fr, fq); } }
        const int t_lo = Epi::MID ? th * (nt >> 1) : 0, t_hi = Epi::MID ? (th + 1) * (nt >> 1) : nt;
#pragma unroll 1
        for (int t = t_lo; t < t_hi; t += 2) {
            const bool last = (t == nt - 2);
            const char* a1 = cA + (size_t)(t + 1) * kstep;
            const char* a2 = last ? nA : cA + (size_t)(t + 2) * kstep; const char* b2 = last ? nB : cB + (size_t)(t + 2) * kstep;
            const char* a3 = a2 + kstep; const char* b3 = b2 + kstep;
            const char* x2 = last ? nX : cX + (size_t)(t + 2) * kstep;
            if (last && has_next) S.a_ready(nxt);
            if constexpr (SP2) {
            PG8_LDB(B0, 0, 0); PG8_LDB(B1, 0, 1); PG8_SCHED; PG8_LDA(At, 0, 0); if constexpr (SLV) PG8_LDX(0); PG8_STAGE(PG8_SA(1, 1), a1 + hstep, voffA);
            PG8_WAIT_VS(); PG8_WAIT_L(0); PG8_BAR; PG8_MMA(0, 0, At, B0); PG8_MMA(0, 1, At, B1); if constexpr (SLV) PG8_XMMA(); PG8_BAR; PG8_SCHED;
            PG8_LDA(At, 0, 1); PG8_STAGE(PG8_SB(0, 0), b2, voffB); PG8_STAGE(PG8_SB(0, 1), b2 + hstep, voffB); PG8_STAGE(PG8_SA(0, 0), a2, voffA); if constexpr (SLV) PG8_STAGE_X(0, x2);
            PG8_WAIT_VS(); PG8_WAIT_L(0); PG8_BAR; PG8_MMA(1, 0, At, B0); PG8_MMA(1, 1, At, B1); PG8_BAR; PG8_SCHED;
            PG8_LDB(B0, 1, 0); PG8_LDB(B1, 1, 1); PG8_SCHED; PG8_LDA(At, 1, 0); if constexpr (SLV) PG8_LDX(1); PG8_STAGE(PG8_SA(0, 1), a2 + hstep, voffA);
            PG8_WAIT_VS(); PG8_WAIT_L(0); PG8_BAR; PG8_MMA(0, 0, At, B0); PG8_MMA(0, 1, At, B1); if constexpr (SLV) PG8_XMMA(); PG8_BAR; PG8_SCHED;
            PG8_LDA(At, 1, 1); PG8_STAGE(PG8_SB(1, 0), b3, voffB); PG8_STAGE(PG8_SB(1, 1), b3 + hstep, voffB); PG8_STAGE(PG8_SA(1, 0), a3, voffA); if constexpr (SLV) PG8_STAGE_X(1, x2 + kstep);
            PG8_WAIT_VS(); PG8_WAIT_L(0); PG8_BAR; PG8_MMA(1, 0, At, B0); PG8_MMA(1, 1, At, B1); PG8_BAR; PG8_SCHED;
            } else {
            PG8_LDB(B0, 0, 0); PG8_SCHED; PG8_LDA(At, 0, 0); PG8_STAGE(PG8_SA(1, 1), a1 + hstep, voffA);
            PG8_WAIT_L(8); PG8_BAR; PG8_WAIT_L(0); PG8_MMA(0, 0, At, B0); PG8_BAR; PG8_SCHED;
            PG8_LDB(B1, 0, 1); PG8_STAGE(PG8_SB(0, 0), b2, voffB);
            PG8_BAR; PG8_WAIT_L(0); PG8_MMA(0, 1, At, B1); PG8_BAR;
            PG8_LDA(At, 0, 1); PG8_STAGE(PG8_SA(0, 0), a2, voffA);
            PG8_BAR; PG8_WAIT_L(0); PG8_MMA(1, 0, At, B0); PG8_BAR; PG8_SCHED;
            PG8_STAGE(PG8_SB(0, 1), b2 + hstep, voffB);
            PG8_WAIT_V(6); PG8_BAR; PG8_MMA(1, 1, At, B1); PG8_BAR;
            PG8_LDB(B0, 1, 0); PG8_SCHED; PG8_LDA(At, 1, 0); PG8_STAGE(PG8_SA(0, 1), a2 + hstep, voffA);
            PG8_WAIT_L(8); PG8_BAR; PG8_WAIT_L(0); PG8_MMA(0, 0, At, B0); PG8_BAR; PG8_SCHED;
            PG8_LDB(B1, 1, 1); PG8_STAGE(PG8_SB(1, 0), b3, voffB);
            PG8_BAR; PG8_WAIT_L(0); PG8_MMA(0, 1, At, B1); PG8_BAR;
            PG8_LDA(At, 1, 1); PG8_STAGE(PG8_SA(1, 0), a3, voffA);
            PG8_BAR; PG8_WAIT_L(0); PG8_MMA(1, 0, At, B0); PG8_BAR; PG8_SCHED;
            PG8_STAGE(PG8_SB(1, 1), b3 + hstep, voffB);
            PG8_WAIT_V(6); PG8_BAR; PG8_MMA(1, 1, At, B1); PG8_BAR;
            }
        }
        }
        S.commit(ui);
        if constexpr (ALIGN_EPI) { if (wr == 0) PG8_BAR; }
        if constexpr (!Epi::AFTER_DRAIN) { const int le = lane_id_(), fr = le & 15, fq = le >> 4;
            if constexpr (SLV) { const auto xp = E.slv_pre(cur, wr, wc, fr, fq); E(acc, cur, wr, wc, fr, fq); E.slv(xacc, xp, cur, wr, wc, fr, fq); } else E(acc, cur, wr, wc, fr, fq);
            S.done(cur); }
        if (!has_next) break;
        xacc[0] = (f32x4){0.f, 0.f, 0.f, 0.f}; xacc[1] = (f32x4){0.f, 0.f, 0.f, 0.f};
#pragma unroll
        for (int a = 0; a < 2; ++a)
#pragma unroll
            for (int b = 0; b < 2; ++b)
#pragma unroll
                for (int m = 0; m < 4; ++m)
#pragma unroll
                    for (int n = 0; n < 2; ++n) acc[a][b][m][n] = (f32x4){0.f, 0.f, 0.f, 0.f};
        cur = nxt; cA = nA; cB = nB; cX = nX; ++ui;
        if constexpr (ALIGN_EPI) { if (wr == 1) PG8_BAR; }
    }
    PG8_WAIT_V(0);
    if constexpr (!ALIGN_EPI) { if (wr == 0) PG8_BAR; }
    PG8_BAR;
    if constexpr (Epi::AFTER_DRAIN) { const int le = lane_id_(); E.fused(acc, xacc, cur, wr, wc, le & 15, le >> 4, lds, wid, le); }
#undef PG8_STAGE_X
#undef PG8_LDX
#undef PG8_XMMA
#undef PG8_WAIT_VS
#undef PG8_SA
#undef PG8_SB
#undef PG8_STAGE
#undef PG8_LDA
#undef PG8_LDB
#undef PG8_MMA
#undef PG8_WAIT_V
#undef PG8_WAIT_L
#undef PG8_BAR
#undef PG8_SCHED
}

}

#ifndef PG8_SP2
#define PG8_SP2 true
#endif
#ifndef PG8_ALIGN
#define PG8_ALIGN true
#endif

constexpr int NWAVES = 8;
constexpr int DM = 1024, NP = 16384, NS = 1024, T = NP + NS, SEQ = 2048, DSEQ = 8, DIN = 9216, PLE = 256;
constexpr float EPS = 1e-6f, LN_EPS = 1e-5f;
constexpr size_t OFF_NAP = (size_t)T * DM, OFF_NBP = OFF_NAP + 8 * 2 * 1024, OFF_NAS = OFF_NBP + 8 * 30 * 1024, OFF_NBS = OFF_NAS + 128 * 2 * 1024;
constexpr size_t MiB = 1u << 20;
constexpr size_t WS_CTL = 0, CTL_ZERO_BYTES = 64 * 1024;
constexpr size_t WS_WIN = 2 * MiB, WS_WAB = 20 * MiB, WS_WO = 24 * MiB, WS_WPG = 26 * MiB, WS_WPE = 28 * MiB;
constexpr size_t WS_PB = 29 * MiB;
constexpr size_t WS_XB = 38 * MiB;
constexpr size_t WS_QZ = 72 * MiB;
constexpr size_t WS_S = 140 * MiB;
constexpr size_t WS_V = 174 * MiB;
constexpr size_t WS_PART = 208 * MiB;
constexpr size_t WS_PARTS = 211 * MiB + 512 * 1024;
static_assert(pg8::SLV_ROW0 == NP && pg8::XOFF + 4096 <= 147456, "sliver constants");
constexpr size_t WS_X2 = 210 * MiB, WS_X2S = 211 * MiB;
constexpr size_t WS_IRS = 212 * MiB;
constexpr size_t WS_PE = 214 * MiB;
constexpr size_t WS_END = 248 * MiB;
constexpr int CW_BAR = 4096, CW_GRP = 8192, CW_DYN = 14336, CW_XID = 15360, CW_OK = 15360 + 512, CW_TEAM = 13312;
constexpr int RING_BYTES = 131072, LDSCTL_OFF = RING_BYTES, MISC_OFF = LDSCTL_OFF + 320, LDS_BYTES = 147456;

#define GAS __attribute__((address_space(1)))
#define LAS __attribute__((address_space(3)))
typedef unsigned short bf16;
typedef unsigned v4u __attribute__((ext_vector_type(4)));
typedef unsigned v2u __attribute__((ext_vector_type(2)));
typedef float f32x4 __attribute__((ext_vector_type(4)));
typedef float f32x2 __attribute__((ext_vector_type(2)));
#define LDS_WAIT() asm volatile("s_waitcnt lgkmcnt(0)" ::: "memory")
using pg8::cvt_pk_bf16; using pg8::bf_lo; using pg8::bf_hi; using pg8::sigmoidf_;

#define XB_TMO      128
#define XB_XCNT(j)  (256  + 64 * (j))
#define XB_XSUB(j)  (1280 + 64 * (j))
#define XB_XGEN(j)  (2304 + 64 * (j))
#define XB_TOP      3328
#define XB_TOPGEN   3392
#define XCD_BAR_WORDS 3456
#define XB_SPIN_CAP (1u << 18)
__device__ __forceinline__ unsigned xb_ld(unsigned* p)              { return __hip_atomic_load(p, __ATOMIC_RELAXED, __HIP_MEMORY_SCOPE_AGENT); }
__device__ __forceinline__ unsigned xb_add(unsigned* p, unsigned v) { return __hip_atomic_fetch_add(p, v, __ATOMIC_RELAXED, __HIP_MEMORY_SCOPE_AGENT); }
__device__ __forceinline__ unsigned xb_xcc_id() { return (unsigned)__builtin_amdgcn_s_getreg((3 << 11) | 20) & 0xFu; }
#define XB_SPIN(cond, bar) do { unsigned _sp = 0; while (cond) { __builtin_amdgcn_s_sleep(1); \
    if ((++_sp & 255u) == 0u) { if (xb_ld(&(bar)[XB_TMO])) break; if (_sp > XB_SPIN_CAP) { atomicAdd(&(bar)[XB_TMO], 1u); break; } } } } while (0)
struct XcdBarrier { unsigned* bar; unsigned x; volatile LAS unsigned* st; int w; };
__device__ __forceinline__ XcdBarrier xcd_barrier_post(unsigned* bar, volatile LAS unsigned* st) {
    XcdBarrier b; b.bar = bar; b.x = xb_xcc_id(); b.st = st;
    if (threadIdx.x == 0) (void)xb_add(&bar[XB_XCNT(b.x)], 1u);
    return b;
}
__device__ __forceinline__ void xcd_barrier_complete(unsigned* bar, unsigned x, unsigned& nloc, unsigned& nx) {
    const unsigned G = gridDim.x * gridDim.y * gridDim.z;
    unsigned sum, cnt, mine, sp = 0u;
    for (;;) {
        sum = 0u; cnt = 0u; mine = 0u;
#pragma unroll
        for (unsigned j = 0; j < 16; ++j) { const unsigned c = xb_ld(&bar[XB_XCNT(j)]); sum += c; cnt += (c > 0u) ? 1u : 0u; mine = (j == x) ? c : mine; }
        if (sum == G) break;
        __builtin_amdgcn_s_sleep(1);
        if ((++sp & 255u) == 0u) { if (xb_ld(&bar[XB_TMO])) break; if (sp > XB_SPIN_CAP) { atomicAdd(&bar[XB_TMO], 1u); break; } }
    }
    nloc = mine > 0u ? mine : 1u; nx = cnt > 0u ? cnt : 1u;
}
template <class F>
__device__ __forceinline__ void xcd_barrier(const XcdBarrier& b, F hook) {
    asm volatile("s_waitcnt vmcnt(0)" ::: "memory");
    __syncthreads();
    const bool t0 = (b.w == 0 && pg8::lane_id_() == 0);
    unsigned* bar = b.bar; unsigned waitgen = 0u; bool spin = false;
    if (t0) {
        __builtin_amdgcn_s_waitcnt(0);
        unsigned nloc = b.st[0], nx = b.st[1];
        if (nloc == 0u) { xcd_barrier_complete(bar, b.x, nloc, nx); b.st[0] = nloc; b.st[1] = nx; }
        const unsigned old = xb_add(&bar[XB_XSUB(b.x)], 1u);
        const unsigned gen = old / nloc;
        if (old + 1u == (gen + 1u) * nloc) {
            __builtin_amdgcn_fence(__ATOMIC_RELEASE, "agent");
            asm volatile("s_waitcnt vmcnt(0)" ::: "memory");
            const unsigned og = xb_add(&bar[XB_TOP], 1u);
            const unsigned tg = og / nx;
            if (og + 1u == (tg + 1u) * nx) xb_add(&bar[XB_TOPGEN], 1u);
            else { spin = true; waitgen = tg; }
        } else { spin = true; waitgen = gen; }
    }
    hook();
    if (t0) {
        asm volatile("buffer_inv sc1" ::: "memory");
        if (spin) XB_SPIN(xb_ld(&bar[XB_TOPGEN]) == waitgen, bar);
        asm volatile("s_waitcnt vmcnt(0)" ::: "memory");
    }
    __syncthreads();
}
struct NoHook { __device__ __forceinline__ void operator()() const {} };
__device__ __forceinline__ void xcd_barrier(const XcdBarrier& b) { xcd_barrier(b, NoHook()); }

__device__ __forceinline__ void team_barrier(unsigned* cnt, unsigned target, unsigned* tmo, int wave) {
    asm volatile("s_waitcnt vmcnt(0)" ::: "memory");
    __syncthreads();
    if (wave == 0 && pg8::lane_id_() == 0) {
        __builtin_amdgcn_s_waitcnt(0);
        (void)xb_add(cnt, 1u);
        asm volatile("buffer_inv sc1" ::: "memory");
        unsigned sp = 0;
        while (xb_ld(cnt) < target) { __builtin_amdgcn_s_sleep(1); if ((++sp & 255u) == 0u) { if (xb_ld(tmo)) break; if (sp > XB_SPIN_CAP) { atomicAdd(tmo, 1u); break; } } }
        asm volatile("s_waitcnt vmcnt(0)" ::: "memory");
    }
    __syncthreads();
}

__device__ __forceinline__ float wave_sum(float v) {
#pragma unroll
    for (int o = 1; o < 64; o <<= 1) v += __shfl_xor(v, o);
    return v;
}

template <class RowMap>
__device__ __forceinline__ void p0_transpose_item(const float* W, int N, bf16* WT, int ldk, int koff, const float* gk, RowMap rm, LAS float* scr, int item, int lane) {
    const int nblk = N / 32, kb = item / nblk, nb = item % nblk, k0 = 64 * kb, n0 = 32 * nb;
#pragma unroll
    for (int i = 0; i < 8; ++i) { const int kk = 8 * i + (lane >> 3), n4 = (lane & 7) * 4; f32x4 w = __builtin_nontemporal_load((const f32x4*)(W + (size_t)(k0 + kk) * N + n0 + n4));     if (gk) w = w * gk[k0 + kk];
        LAS float* d = scr + kk * 33 + n4; d[0] = w.x; d[1] = w.y; d[2] = w.z; d[3] = w.w; }
    LDS_WAIT(); asm volatile("" ::: "memory");
    const int c = lane & 7;
#pragma unroll
    for (int j = 0; j < 4; ++j) { const int n = (lane >> 3) + 8 * j; const LAS float* s = scr + (8 * c) * 33 + n;
        v4u o; o.x = cvt_pk_bf16(s[0 * 33], s[1 * 33]); o.y = cvt_pk_bf16(s[2 * 33], s[3 * 33]); o.z = cvt_pk_bf16(s[4 * 33], s[5 * 33]); o.w = cvt_pk_bf16(s[6 * 33], s[7 * 33]);
        *(GAS v4u*)(WT + (size_t)rm(n0 + n) * ldk + koff + k0 + 8 * c) = o; }
    LDS_WAIT(); asm volatile("" ::: "memory");
}
struct RowId { __device__ __forceinline__ int operator()(int n) const { return n; } };
struct RowInProj { __device__ __forceinline__ int operator()(int sc) const {
    const int g = sc >> 10, ch = sc & 1023;
    if (g == 6) return 256 * (24 + (ch >> 8)) + (ch & 255);
    int base, isY;
    switch (g) { case 0: base = 0; isY = 0; break; case 3: base = 0; isY = 1; break; case 1: base = 8; isY = 0; break; case 2: base = 8; isY = 1; break; case 4: base = 16; isY = 0; break; case 5: base = 16; isY = 1; break;
                 case 7: base = 28; isY = 0; break; default: base = 28; isY = 1; break; }
    const int cl = ch & 127, grp = cl >> 3, r8 = cl & 7, bj = r8 >> 2, j = r8 & 3;
    return 256 * (base + (ch >> 7)) + 128 * bj + 8 * grp + 4 * isY + j; } };

struct Ptrs {
    const float *x_p, *x_s, *st_a, *st_b, *p_p, *p_s, *g_mix, *w_in, *w_conv_a, *w_out_a, *w_conv_b, *b_conv_b, *ln_g, *ln_b, *w_out_b, *w_o, *w_pe, *g_ple, *w_pg, *g_final;
    float* out; unsigned char* ws;
};

typedef const __attribute__((address_space(4))) Ptrs* KPtrsT;
__device__ __forceinline__ Ptrs load_ptrs(KPtrsT k) {
    Ptrs P;
    P.x_p = k->x_p; P.x_s = k->x_s; P.st_a = k->st_a; P.st_b = k->st_b; P.p_p = k->p_p; P.p_s = k->p_s; P.g_mix = k->g_mix; P.w_in = k->w_in; P.w_conv_a = k->w_conv_a; P.w_out_a = k->w_out_a;
    P.w_conv_b = k->w_conv_b; P.b_conv_b = k->b_conv_b; P.ln_g = k->ln_g; P.ln_b = k->ln_b; P.w_out_b = k->w_out_b; P.w_o = k->w_o; P.w_pe = k->w_pe; P.g_ple = k->g_ple; P.w_pg = k->w_pg; P.g_final = k->g_final;
    P.out = k->out; P.ws = k->ws; return P;
}
struct P0Item { const float* W; bf16* WT; const float* gk; int N, ldk, koff, perm, r; };
__device__ __forceinline__ void p0_item_load(const P0Item& d, int lane, f32x4 (&w)[8]) {
    const int nblk = d.N / 32, kb = d.r / nblk, nb = d.r % nblk, k0 = 64 * kb, n0 = 32 * nb;
#pragma unroll
    for (int i = 0; i < 8; ++i) { const int kk = 8 * i + (lane >> 3), n4 = (lane & 7) * 4; w[i] = __builtin_nontemporal_load((const f32x4*)(d.W + (size_t)(k0 + kk) * d.N + n0 + n4)); if (d.gk) w[i] = w[i] * d.gk[k0 + kk]; }
}
__device__ __forceinline__ void p0_item_store(const P0Item& d, int lane, LAS float* scr, const f32x4 (&w)[8]) {
    const int nblk = d.N / 32, kb = d.r / nblk, nb = d.r % nblk, k0 = 64 * kb, n0 = 32 * nb;
#pragma unroll
    for (int i = 0; i < 8; ++i) { const int kk = 8 * i + (lane >> 3), n4 = (lane & 7) * 4; LAS float* q = scr + kk * 33 + n4; q[0] = w[i].x; q[1] = w[i].y; q[2] = w[i].z; q[3] = w[i].w; }
    LDS_WAIT(); asm volatile("" ::: "memory");
    const int c = lane & 7;
#pragma unroll
    for (int j = 0; j < 4; ++j) { const int n = (lane >> 3) + 8 * j; const LAS float* t = scr + (8 * c) * 33 + n;
        v4u o; o.x = cvt_pk_bf16(t[0 * 33], t[1 * 33]); o.y = cvt_pk_bf16(t[2 * 33], t[3 * 33]); o.z = cvt_pk_bf16(t[4 * 33], t[5 * 33]); o.w = cvt_pk_bf16(t[6 * 33], t[7 * 33]);
        const int row = d.perm ? RowInProj()(n0 + n) : n0 + n;
        *(GAS v4u*)(d.WT + (size_t)row * d.ldk + d.koff + k0 + 8 * c) = o; }
    LDS_WAIT(); asm volatile("" ::: "memory");
}
struct P0Rows { f32x4 v[2][4], pv[2]; };
__device__ __forceinline__ void p0_rows_load(const Ptrs& P, int m0, int lane, P0Rows& R) {
#pragma unroll
    for (int r = 0; r < 2; ++r) { const int m = m0 + r;
        const float* xrow = m < NP ? P.x_p + (size_t)m * DM : P.x_s + (size_t)(m - NP) * DM;
        const float* prow = m < NP ? P.p_p + (size_t)m * PLE : P.p_s + (size_t)(m - NP) * PLE;
        const GAS f32x4* xr = (const GAS f32x4*)xrow + lane;
#pragma unroll
        for (int j = 0; j < 4; ++j) R.v[r][j] = __builtin_nontemporal_load(xr + 64 * j);
        R.pv[r] = __builtin_nontemporal_load((const GAS f32x4*)prow + lane); }
}
__device__ __forceinline__ void p0_rows_store(const Ptrs& P, int m0, int lane, const P0Rows& R) {
    bf16* XB = (bf16*)(P.ws + WS_XB); bf16* PB = (bf16*)(P.ws + WS_PB);
#pragma unroll
    for (int r = 0; r < 2; ++r) { const int m = m0 + r; float s = 0.f;
#pragma unroll
        for (int j = 0; j < 4; ++j) s += (R.v[r][j].x * R.v[r][j].x + R.v[r][j].y * R.v[r][j].y) + (R.v[r][j].z * R.v[r][j].z + R.v[r][j].w * R.v[r][j].w);
        const float ms = wave_sum(s) * (1.0f / DM) + EPS; const float rstd = 1.0f / sqrtf(ms);
        if (lane == 0) ((float*)(P.ws + WS_IRS))[m] = sqrtf(ms);
        GAS v2u* o8 = (GAS v2u*)(XB + (size_t)m * DM) + lane;
#pragma unroll
        for (int j = 0; j < 4; ++j) { v2u w; w.x = cvt_pk_bf16(R.v[r][j].x * rstd, R.v[r][j].y * rstd); w.y = cvt_pk_bf16(R.v[r][j].z * rstd, R.v[r][j].w * rstd); o8[64 * j] = w; }
        v2u w; w.x = cvt_pk_bf16(R.pv[r].x, R.pv[r].y); w.y = cvt_pk_bf16(R.pv[r].z, R.pv[r].w);
        ((GAS v2u*)(PB + (size_t)m * PLE))[lane] = w; }
}
__device__ __forceinline__ void p0_prologue(const Ptrs& P, LAS unsigned char* lds, int gw, int NGW, int lane, int wave) {
    LAS float* scr = (LAS float*)(lds + wave * 16384);
    constexpr int I_IN = (DM / 64) * (DIN / 32), I_SQ = (DM / 64) * (DM / 32), I_PE = (PLE / 64) * (DM / 32);
    constexpr int NITEMS = I_IN + 4 * I_SQ + I_PE;
    auto decode = [&](int it) { P0Item d; int r = it; d.gk = nullptr; d.perm = 0; d.koff = 0; d.N = DM; d.ldk = DM;
        if (r < I_IN) { d.W = P.w_in; d.N = DIN; d.WT = (bf16*)(P.ws + WS_WIN); d.gk = P.g_mix; d.perm = 1; d.r = r; return d; } r -= I_IN;
        if (r < I_SQ) { d.W = P.w_out_a; d.WT = (bf16*)(P.ws + WS_WAB); d.ldk = 2 * DM; d.r = r; return d; } r -= I_SQ;
        if (r < I_SQ) { d.W = P.w_out_b; d.WT = (bf16*)(P.ws + WS_WAB); d.ldk = 2 * DM; d.koff = DM; d.r = r; return d; } r -= I_SQ;
        if (r < I_SQ) { d.W = P.w_o; d.WT = (bf16*)(P.ws + WS_WO); d.r = r; return d; } r -= I_SQ;
        if (r < I_SQ) { d.W = P.w_pg; d.WT = (bf16*)(P.ws + WS_WPG); d.gk = P.g_ple; d.r = r; return d; } r -= I_SQ;
        d.W = P.w_pe; d.WT = (bf16*)(P.ws + WS_WPE); d.ldk = PLE; d.r = r; return d; };
    const int NTRIP = T / 2, sh = NITEMS % NGW; int trip = gw - sh; if (trip < 0) trip += NGW;
    {
        P0Item cur; f32x4 w0[8], w1[8]; int it = gw;
        if (it < NITEMS) { cur = decode(it); p0_item_load(cur, lane, w0); }
#pragma unroll 1
        for (; it < NITEMS; it += NGW) { const int nit = it + NGW; P0Item nxt = cur;
            if (nit < NITEMS) { nxt = decode(nit); p0_item_load(nxt, lane, w1); }
            p0_item_store(cur, lane, scr, w0); cur = nxt;
#pragma unroll
            for (int i = 0; i < 8; ++i) w0[i] = w1[i]; }
    }
    {
        P0Rows R0, R1;
        if (trip < NTRIP) p0_rows_load(P, 2 * trip, lane, R0);
#pragma unroll 1
        for (; trip < NTRIP; trip += NGW) { const int nt = trip + NGW;
            if (nt < NTRIP) p0_rows_load(P, 2 * nt, lane, R1);
            p0_rows_store(P, 2 * trip, lane, R0); R0 = R1; }
    }
}

using pg8::rsrc_t; using pg8::mkrsrc;
__device__ __forceinline__ unsigned bld4(rsrc_t r, unsigned voff, unsigned soff) { return __builtin_amdgcn_raw_buffer_load_b32(r, (int)voff, (int)soff, 0); }
__device__ __forceinline__ void bst4(rsrc_t r, unsigned voff, unsigned soff, unsigned v) { __builtin_amdgcn_raw_buffer_store_b32(v, r, (int)voff, (int)soff, 0); }
__device__ __forceinline__ f32x2 bld8f(rsrc_t r, unsigned voff, unsigned soff) { return __builtin_bit_cast(f32x2, __builtin_amdgcn_raw_buffer_load_b64(r, (int)voff, (int)soff, 0)); }
__device__ __forceinline__ void bst8f(rsrc_t r, unsigned voff, unsigned soff, f32x2 v) { __builtin_amdgcn_raw_buffer_store_b64(__builtin_bit_cast(v2u, v), r, (int)voff, (int)soff, 0); }
__device__ __forceinline__ f32x2 up2(unsigned u) { return (f32x2){bf_lo(u), bf_hi(u)}; }
using pg8::bld16; using pg8::bst16; using pg8::u32x4; using pg8::pack8; using pg8::unpack8; using pg8::as_f; using pg8::as_u;
__device__ __forceinline__ void p2_window_dma(const Ptrs& P, LAS unsigned char* lds, unsigned R0, bool first, int lane, int wave) {
    const unsigned char* Vb = P.ws + WS_V;
#pragma unroll 1
    for (int hr = wave; hr < 124; hr += 8) { const int row = hr >> 1, half = hr & 1;
        if (first && row < 30) { *(LAS u32x4*)(lds + row * 2048 + half * 1024 + lane * 16) = (u32x4){0u, 0u, 0u, 0u}; }
        else __builtin_amdgcn_global_load_lds((const unsigned*)(Vb + (size_t)(R0 - 30 + row) * 2048 + half * 1024 + lane * 16), (LAS unsigned*)(lds + row * 2048 + half * 1024), 16, 0, 0); }
}
__device__ __forceinline__ void p2_state_dma(const Ptrs& P, LAS unsigned char* lds, int n, int lane, int wave) {
    const unsigned char* Sb = (const unsigned char*)(P.st_b + (size_t)n * 30 * 1024);
#pragma unroll 1
    for (int q = wave; q < 120; q += 8) __builtin_amdgcn_global_load_lds((const unsigned*)(Sb + q * 1024 + lane * 16), (LAS unsigned*)(lds + q * 1024), 16, 0, 0);
}
template <int NTW, bool PF>
__device__ __forceinline__ void p2_ln_part(const Ptrs& P, LAS unsigned char* lds, rsrc_t rQZ, unsigned R0, int lane, int wave, int nkind, int nseq) {
    const LAS f32x4* cl4 = (const LAS f32x4*)lds;
    const unsigned vz = (unsigned)lane * 16u;
    u32x4 z[NTW][2];
#pragma unroll
    for (int t = 0; t < NTW; ++t)
#pragma unroll
        for (int h = 0; h < 2; ++h) z[t][h] = bld16(rQZ, vz, (R0 + wave * NTW + t) * 4096u + 2048u + h * 1024);
    f32x4 lg[4], lb[4];
#pragma unroll
    for (int h = 0; h < 2; ++h)
#pragma unroll
        for (int q = 0; q < 2; ++q) { lg[2 * h + q] = *(const f32x4*)(P.ln_g + h * 512 + lane * 8 + q * 4); lb[2 * h + q] = *(const f32x4*)(P.ln_b + h * 512 + lane * 8 + q * 4); }
    f32x4 x[NTW][4]; float s[NTW], qq[NTW];
#pragma unroll
    for (int t = 0; t < NTW; ++t) { const int i = wave * NTW + t; s[t] = 0.f;
#pragma unroll
        for (int h = 0; h < 2; ++h)
#pragma unroll
            for (int q = 0; q < 2; ++q) { x[t][2 * h + q] = cl4[i * 256 + h * 128 + lane * 2 + q]; s[t] += (x[t][2 * h + q].x + x[t][2 * h + q].y) + (x[t][2 * h + q].z + x[t][2 * h + q].w); } }
    if constexpr (PF) { LDS_WAIT(); __syncthreads();
        if (nkind == 1) p2_window_dma(P, lds, R0 + 32, false, lane, wave); else if (nkind == 2) p2_state_dma(P, lds, nseq, lane, wave); }
#pragma unroll
    for (int o = 1; o < 64; o <<= 1)
#pragma unroll
        for (int t = 0; t < NTW; ++t) s[t] += __shfl_xor(s[t], o);
#pragma unroll
    for (int t = 0; t < NTW; ++t) { const float mean = s[t] * (1.0f / 1024.0f); qq[t] = 0.f;
#pragma unroll
        for (int j = 0; j < 4; ++j) { x[t][j] = x[t][j] - mean; qq[t] += (x[t][j].x * x[t][j].x + x[t][j].y * x[t][j].y) + (x[t][j].z * x[t][j].z + x[t][j].w * x[t][j].w); } }
#pragma unroll
    for (int o = 1; o < 64; o <<= 1)
#pragma unroll
        for (int t = 0; t < NTW; ++t) qq[t] += __shfl_xor(qq[t], o);
#pragma unroll
    for (int t = 0; t < NTW; ++t) { const float rstd = 1.0f / sqrtf(qq[t] * (1.0f / 1024.0f) + LN_EPS); const unsigned so = (R0 + wave * NTW + t) * 4096u + 2048u;
#pragma unroll
        for (int h = 0; h < 2; ++h) { f32x4 z0, z1; unpack8(z[t][h], z0, z1);
            f32x4 y0 = x[t][2 * h] * rstd * lg[2 * h] + lb[2 * h], y1 = x[t][2 * h + 1] * rstd * lg[2 * h + 1] + lb[2 * h + 1];
#pragma unroll
            for (int j = 0; j < 4; ++j) { y0[j] = y0[j] * sigmoidf_(y0[j]) * z0[j]; y1[j] = y1[j] * sigmoidf_(y1[j]) * z1[j]; }
            bst16(rQZ, vz, so + h * 1024, pack8(y0, y1)); } }
}
template <bool PF>
__device__ __forceinline__ void p2_tile_prompt(const Ptrs& P, LAS unsigned char* lds, int tile, int tid, int lane, int wave, bool dma_at_start, int nkind, int nseq) {
    const rsrc_t rQZ = mkrsrc(P.ws + WS_QZ), rS = mkrsrc(P.ws + WS_S), rWb = mkrsrc(P.w_conv_b), rOut = mkrsrc(P.out);
    const unsigned b = tile >> 6, t0 = (tile & 63) * 32, R0 = b * SEQ + t0;
    const bool lastt = (t0 == SEQ - 32), first = (t0 == 0);
    const unsigned cg = tid & 127, tq = tid >> 7, vo = cg * 16u, r0 = R0 + tq * 8;
    u32x4 sr[10], qr[8];
#pragma unroll
    for (int i = 0; i < 10; ++i) { const bool neg = first && tq == 0 && i < 2; sr[i] = bld16(rS, vo, neg ? 0u : (r0 - 2 + i) * 2048u); if (neg) sr[i] = (u32x4){0u, 0u, 0u, 0u}; }
#pragma unroll
    for (int i = 0; i < 8; ++i) qr[i] = bld16(rQZ, vo, (r0 + i) * 4096u);
    if (dma_at_start) p2_window_dma(P, lds, R0, first, lane, wave);
    {
        f32x4 w0[2], w1[2], w2[2];
#pragma unroll
        for (int q = 0; q < 2; ++q) { w0[q] = *(const f32x4*)(P.w_conv_a + cg * 8 + q * 4); w1[q] = *(const f32x4*)(P.w_conv_a + 1024 + cg * 8 + q * 4); w2[q] = *(const f32x4*)(P.w_conv_a + 2048 + cg * 8 + q * 4); }
#pragma unroll
        for (int i = 0; i < 8; ++i) { f32x4 a0, a1, b0, b1, c0, c1, q0, q1; unpack8(sr[i], a0, a1); unpack8(sr[i + 1], b0, b1); unpack8(sr[i + 2], c0, c1); unpack8(qr[i], q0, q1);
            const f32x4 y0 = q0 * (w0[0] * a0 + w1[0] * b0 + w2[0] * c0), y1 = q1 * (w0[1] * a1 + w1[1] * b1 + w2[1] * c1);
            bst16(rQZ, vo, (r0 + i) * 4096u, pack8(y0, y1)); }
        if (lastt && tq == 3) {
#pragma unroll
            for (int j = 0; j < 2; ++j) { f32x4 a0, a1; unpack8(sr[8 + j], a0, a1);
                bst16(rOut, cg * 32u, (unsigned)(OFF_NAP + (size_t)(b * 2 + j) * 1024) * 4u, as_u(a0)); bst16(rOut, cg * 32u, (unsigned)(OFF_NAP + (size_t)(b * 2 + j) * 1024) * 4u + 16u, as_u(a1)); } }
    }
    asm volatile("s_waitcnt vmcnt(0)" ::: "memory");
    __syncthreads();
    {
        const unsigned v8 = (unsigned)tid * 8u;
        const f32x2 bias = *(const f32x2*)(P.b_conv_b + 2 * tid);
        f32x2 win[62];
#pragma unroll
        for (int i = 0; i < 62; ++i) win[i] = up2(*(const LAS unsigned*)(lds + i * 2048 + tid * 4));
        asm volatile("s_waitcnt lgkmcnt(0)" ::: "memory");
        __syncthreads();
        LAS f32x2* cl2 = (LAS f32x2*)lds;
#pragma unroll
        for (int hh = 0; hh < 2; ++hh) {
            f32x2 c[16];
#pragma unroll
            for (int i = 0; i < 16; ++i) c[i] = bias;
#pragma unroll
            for (int k = 0; k < 31; ++k) { const f32x2 w = bld8f(rWb, v8, k * 4096u);
#pragma unroll
                for (int i = 0; i < 16; ++i) c[i] += w * win[hh * 16 + i + k]; }
#pragma unroll
            for (int i = 0; i < 16; ++i) cl2[(hh * 16 + i) * 512 + tid] = c[i];
        }
        if (lastt) {
#pragma unroll
            for (int j = 0; j < 30; ++j) bst8f(rOut, v8, (unsigned)(OFF_NBP + (size_t)(b * 30 + j) * 1024) * 4u, win[32 + j]); }
    }
    __syncthreads();
    p2_ln_part<4, PF>(P, lds, rQZ, R0, lane, wave, nkind, nseq);
    __syncthreads();
}
__device__ __forceinline__ void p2_state_copy(const Ptrs& P, int n, int tid) {
    const rsrc_t rSb = mkrsrc(P.st_b), rOut = mkrsrc(P.out); const unsigned v8 = (unsigned)tid * 8u;
    f32x2 r[22];
#pragma unroll
    for (int j = 0; j < 22; ++j) r[j] = __builtin_bit_cast(f32x2, __builtin_amdgcn_raw_buffer_load_b64(rSb, (int)v8, (int)((n * 30 + 8 + j) * 4096u), 2));
#pragma unroll
    for (int j = 0; j < 22; ++j) bst8f(rOut, v8, (unsigned)(OFF_NBS + (size_t)(n * 30 + j) * 1024) * 4u, r[j]);
}
template <bool PRE, bool PF = false, bool COPIED = false>
__device__ __forceinline__ void p2_seq_sample(const Ptrs& P, LAS unsigned char* lds, int n, int tid, int lane, int wave, int wtile = 0) {
    const rsrc_t rQZ = mkrsrc(P.ws + WS_QZ), rS = mkrsrc(P.ws + WS_S), rV = mkrsrc(P.ws + WS_V), rWb = mkrsrc(P.w_conv_b), rOut = mkrsrc(P.out);
    const rsrc_t rSa = mkrsrc(P.st_a), rSb = mkrsrc(P.st_b);
    const unsigned v4 = (unsigned)tid * 4u, v8 = (unsigned)tid * 8u, r0 = NP + n * DSEQ;
    LAS f32x2* cl2 = (LAS f32x2*)lds;
    f32x2 sw[10], win[38]; unsigned qu[8];
#pragma unroll
    for (int i = 0; i < 2; ++i) sw[i] = bld8f(rSa, v8, (n * 2 + i) * 4096u);
    if constexpr (!PRE) {
#pragma unroll
        for (int i = 0; i < 30; ++i) win[i] = bld8f(rSb, v8, (n * 30 + i) * 4096u); }
    unsigned su[8], vu[8];
#pragma unroll
    for (int i = 0; i < 8; ++i) { su[i] = bld4(rS, v4, (r0 + i) * 2048u); vu[i] = bld4(rV, v4, (r0 + i) * 2048u); qu[i] = bld4(rQZ, v4, (r0 + i) * 4096u); }
    const u32x4 z0 = bld16(rQZ, (unsigned)lane * 16u, (r0 + wave) * 4096u + 2048u), z1 = bld16(rQZ, (unsigned)lane * 16u, (r0 + wave) * 4096u + 2048u + 1024u);
    const f32x2 wA0 = *(const f32x2*)(P.w_conv_a + 2 * tid), wA1 = *(const f32x2*)(P.w_conv_a + 1024 + 2 * tid), wA2 = *(const f32x2*)(P.w_conv_a + 2048 + 2 * tid);
    const f32x2 bias = *(const f32x2*)(P.b_conv_b + 2 * tid);
    if constexpr (PRE) { asm volatile("s_waitcnt vmcnt(0)" ::: "memory"); __syncthreads();
#pragma unroll
        for (int i = 0; i < 30; ++i) win[i] = *(const LAS f32x2*)(lds + i * 4096 + tid * 8);
        LDS_WAIT(); __syncthreads(); }
    f32x2 c[8];
#pragma unroll
    for (int i = 0; i < 8; ++i) { sw[2 + i] = up2(su[i]); win[30 + i] = up2(vu[i]); c[i] = bias; }
#pragma unroll
    for (int k = 0; k < 31; ++k) { const f32x2 w = bld8f(rWb, v8, k * 4096u);
#pragma unroll
        for (int i = 0; i < 8; ++i) c[i] += w * win[i + k]; }
#pragma unroll
    for (int i = 0; i < 8; ++i) cl2[i * 512 + tid] = c[i];
#pragma unroll
    for (int i = 0; i < 8; ++i) { const f32x2 q = up2(qu[i]); const f32x2 cv = wA0 * sw[i] + wA1 * sw[i + 1] + wA2 * sw[i + 2]; const f32x2 ya = q * cv; bst4(rQZ, v4, (r0 + i) * 4096u, cvt_pk_bf16(ya.x, ya.y)); }
#pragma unroll
    for (int j = 0; j < 2; ++j) bst8f(rOut, v8, (unsigned)(OFF_NAS + (size_t)(n * 2 + j) * 1024) * 4u, sw[8 + j]);
#pragma unroll
    for (int j = COPIED ? 22 : 0; j < 30; ++j) bst8f(rOut, v8, (unsigned)(OFF_NBS + (size_t)(n * 30 + j) * 1024) * 4u, win[8 + j]);
    __syncthreads();
    {
        const LAS f32x4* cl4 = (const LAS f32x4*)lds;
        f32x4 lg[4], lb[4], x[4]; float s = 0.f;
#pragma unroll
        for (int h = 0; h < 2; ++h)
#pragma unroll
            for (int q = 0; q < 2; ++q) { lg[2 * h + q] = *(const f32x4*)(P.ln_g + h * 512 + lane * 8 + q * 4); lb[2 * h + q] = *(const f32x4*)(P.ln_b + h * 512 + lane * 8 + q * 4);
                x[2 * h + q] = cl4[wave * 256 + h * 128 + lane * 2 + q]; s += (x[2 * h + q].x + x[2 * h + q].y) + (x[2 * h + q].z + x[2 * h + q].w); }
        if constexpr (PF) { LDS_WAIT(); __syncthreads(); const unsigned wb_ = wtile >> 6, wt0_ = (wtile & 63) * 32; p2_window_dma(P, lds, wb_ * SEQ + wt0_, wt0_ == 0, lane, wave); }
        const float mean = wave_sum(s) * (1.0f / 1024.0f); float qq = 0.f;
#pragma unroll
        for (int j = 0; j < 4; ++j) { x[j] = x[j] - mean; qq += (x[j].x * x[j].x + x[j].y * x[j].y) + (x[j].z * x[j].z + x[j].w * x[j].w); }
        const float rstd = 1.0f / sqrtf(wave_sum(qq) * (1.0f / 1024.0f) + LN_EPS);
#pragma unroll
        for (int h = 0; h < 2; ++h) { f32x4 a0, a1; unpack8(h ? z1 : z0, a0, a1);
            f32x4 y0 = x[2 * h] * rstd * lg[2 * h] + lb[2 * h], y1 = x[2 * h + 1] * rstd * lg[2 * h + 1] + lb[2 * h + 1];
#pragma unroll
            for (int j = 0; j < 4; ++j) { y0[j] = y0[j] * sigmoidf_(y0[j]) * a0[j]; y1[j] = y1[j] * sigmoidf_(y1[j]) * a1[j]; }
            bst16(rQZ, (unsigned)lane * 16u, (r0 + wave) * 4096u + 2048u + h * 1024, pack8(y0, y1)); }
    }
    __syncthreads();
}

struct Args { Ptrs p; int ph_lo, ph_hi; };

__global__ void __launch_bounds__(NWAVES * 64, 2) fwd_megakernel(Args args) {
    extern __shared__ __attribute__((aligned(16))) unsigned char lds_raw[];
    LAS unsigned char* lds = (LAS unsigned char*)lds_raw;
    typedef const __attribute__((address_space(4))) Ptrs* KPtrs;
    const KPtrs Pk = (KPtrs)__builtin_amdgcn_kernarg_segment_ptr();
#define PHASE_PTRS() KPtrs Pq_ = Pk; asm volatile("" : "+s"(Pq_)); const Ptrs P = load_ptrs(Pq_); const int lane = pg8::lane_id_(), tid = wave * 64 + lane; (void)tid
    const int tid0 = threadIdx.x, wave = __builtin_amdgcn_readfirstlane(tid0 >> 6);
    const int G = gridDim.x, bx = blockIdx.x;
    const int gw = bx * NWAVES + wave, NGW = G * NWAVES;
    volatile LAS unsigned* MISC = (volatile LAS unsigned*)(lds + MISC_OFF);
    for (int u = tid0; u < (LDS_BYTES - LDSCTL_OFF) / 4; u += NWAVES * 64) ((LAS unsigned*)(lds + LDSCTL_OFF))[u] = 0u;
    __syncthreads();
    unsigned* ctl;
    { PHASE_PTRS(); ctl = (unsigned*)(P.ws + WS_CTL); }
    XcdBarrier bar; bar.bar = ctl + CW_BAR; bar.x = 0; bar.st = nullptr; bar.w = wave;
#if !MK_PER_PHASE
    bar = xcd_barrier_post(ctl + CW_BAR, MISC + 8); bar.w = wave;
    if (tid0 == 0) __hip_atomic_store(ctl + CW_XID + bx, bar.x + 1u, __ATOMIC_RELAXED, __HIP_MEMORY_SCOPE_AGENT);
#endif
    bool all_local = false; int team_pm = 0, team_pn = 0;
    const int lo = args.ph_lo, hi = args.ph_hi;
#define WSP(off) ((pg8::bf16_t*)(P.ws + (off)))

#define RUN0 { PHASE_PTRS(); p0_prologue(P, lds, gw, NGW, lane, wave); }
#define RUN1 { PHASE_PTRS(); \
            if (G == (NP / 256) * (DM / 256)) {     \
                pg8::StaticOrder St_; pg8::Unit me_, ot_; St_.init(NP, DM, G, bx); St_.next(0, me_); team_pm = me_.pm; team_pn = me_.pn; \
                int ok_ = 1; if (tid < G) { pg8::StaticOrder So_; So_.init(NP, DM, G, tid); if (So_.next(0, ot_) && ot_.pm == me_.pm) ok_ = (xb_ld(ctl + CW_XID + tid) == bar.x + 1u) ? 1 : 0; } \
                if (__syncthreads_and(ok_) && tid == 0) (void)xb_add(ctl + CW_OK, 1u); } \
            pg8::Gemm g{WSP(WS_XB), WSP(WS_WIN), T, DIN, DM}; pg8::DynOrder S; S.init(T, DIN, G, bx); S.NS = 8; S.NLAB = 8; S.x = bx & 7; S.cq = ctl + CW_DYN; S.tk = (volatile LAS int*)(MISC + 12); S.pend = 0; S.w = wave; \
            pg8::EpiInProj E{WSP(WS_QZ), WSP(WS_S), WSP(WS_V), (pg8::bf16_t*)P.out, (pg8::bf16_t*)P.out + (size_t)T * DM}; \
            pg8::gemm_phase<pg8::EpiInProj, pg8::DynOrder, PG8_ALIGN, PG8_SP2>(lds, g, S, E, wave); \
              \
            { pg8::Gemm g2{WSP(WS_PB), WSP(WS_WPE), T, DM, PLE}; pg8::DynOrder S2; S2.init(T, DM, G, bx); S2.NS = 0; S2.NLAB = 1; S2.x = 0; S2.cq = ctl + CW_DYN + 64 * 8; S2.tk = (volatile LAS int*)(MISC + 14); S2.pend = 0; S2.w = wave; \
              pg8::EpiPlain E2{WSP(WS_PE), DM}; \
              pg8::gemm_phase<pg8::EpiPlain, pg8::DynOrder, PG8_ALIGN, PG8_SP2>(lds, g2, S2, E2, wave); } }
#define RUN2 { PHASE_PTRS(); \
            if (G == (NP / 256) * (DM / 256)) {     \
                  \
                  \
                const int sq_ = 2 * team_pm + team_pn, tl_ = 8 * team_pm + 2 * team_pn; const bool hs_ = team_pn < 2; \
                if (hs_) p2_seq_sample<true, true, true>(P, lds, sq_, tid, lane, wave, tl_); \
                p2_tile_prompt<true>(P, lds, tl_, tid, lane, wave, !hs_, 1, 0); \
                p2_tile_prompt<true>(P, lds, tl_ + 1, tid, lane, wave, false, 0, 0); \
            } else { \
                for (int tile = bx; tile < 512; tile += G) p2_tile_prompt<false>(P, lds, 2 * (tile & 255) + (tile >> 8), tid, lane, wave, true, 0, 0); \
                for (int n = bx; n < 128; n += G) p2_seq_sample<false>(P, lds, n, tid, lane, wave); } }
#define RUN3 { PHASE_PTRS(); \
            pg8::Gemm g{WSP(WS_QZ), WSP(WS_WAB), NP, DM, 2 * DM}; pg8::StaticOrder S; S.init(NP, DM, G, bx); \
            pg8::EpiOutGate E{(const pg8::bf16_t*)P.out, (const pg8::bf16_t*)P.out + (size_t)T * DM, WSP(WS_S)}; \
            pg8::gemm_phase<pg8::EpiOutGate, pg8::StaticOrder, PG8_ALIGN, PG8_SP2, true>(lds, g, S, E, wave); }
#define RUN4 { \
            { PHASE_PTRS(); pg8::Gemm g{WSP(WS_S), WSP(WS_WO), NP, DM, DM}; pg8::StaticOrder S; S.init(NP, DM, G, bx); \
              pg8::EpiWo E{WSP(WS_XB), (const float*)(P.ws + WS_IRS), WSP(WS_V), (float*)(P.ws + WS_PART), (float*)(P.ws + WS_PARTS)}; \
              pg8::gemm_phase<pg8::EpiWo, pg8::StaticOrder, PG8_ALIGN, PG8_SP2, true>(lds, g, S, E, wave); } }
#define RUN5 { PHASE_PTRS(); \
            pg8::Gemm g{WSP(WS_V), WSP(WS_WPG), NP, DM, DM}; pg8::StaticOrder S; S.init(NP, DM, G, bx); \
            pg8::EpiPgFinal E{P.out, WSP(WS_V), WSP(WS_PE), (const float*)(P.ws + WS_PART), P.g_final, (float*)(P.ws + WS_X2), ctl + CW_GRP, (const float*)(P.ws + WS_PARTS), (float*)(P.ws + WS_X2S)}; \
            pg8::gemm_phase<pg8::EpiPgFinal, pg8::StaticOrder, PG8_ALIGN, PG8_SP2, true>(lds, g, S, E, wave); }
#define RUN6 { PHASE_PTRS(); \
            float* H = P.out; \
            f32x4 gf[4]; \
            _Pragma("unroll") for (int j = 0; j < 4; ++j) gf[j] = *(const f32x4*)(P.g_final + j * 256 + lane * 4); \
            for (int m = gw; m < T; m += NGW) { \
                GAS f32x4* hr = (GAS f32x4*)(H + (size_t)m * DM) + lane; \
                f32x4 v[4]; float sq = 0.f; \
                _Pragma("unroll") for (int j = 0; j < 4; ++j) { v[j] = hr[64 * j]; sq += (v[j].x * v[j].x + v[j].y * v[j].y) + (v[j].z * v[j].z + v[j].w * v[j].w); } \
                const float rstd = 1.0f / sqrtf(wave_sum(sq) * (1.0f / DM) + EPS); \
                _Pragma("unroll") for (int j = 0; j < 4; ++j) hr[64 * j] = v[j] * rstd * gf[j]; \
            } }
#define RUN7 { PHASE_PTRS(); \
            float* H = P.out; \
            for (int m = gw; m < T; m += NGW) { \
                GAS f32x4* hr = (GAS f32x4*)(H + (size_t)m * DM) + lane; \
                f32x4 v[4]; float sq = 0.f; \
                _Pragma("unroll") for (int j = 0; j < 4; ++j) { v[j] = hr[64 * j]; sq += (v[j].x * v[j].x + v[j].y * v[j].y) + (v[j].z * v[j].z + v[j].w * v[j].w); } \
                const float one = wave_sum(sq) >= 0.f ? 1.0f : 0.0f; \
                _Pragma("unroll") for (int j = 0; j < 4; ++j) hr[64 * j] = v[j] * one; \
            } }
#ifndef PROG_STEPS
#define PROG_STEPS X(0) X(1) X(2) X(3) X(4) X(5)
#endif
    enum { STEP_BASE = __COUNTER__ + 1 };
#if MK_PER_PHASE
#define X(k) { const int si_ = __COUNTER__ - STEP_BASE; if (lo == si_) RUN##k }
#else
#ifdef DBG_TIME_A
#define STAMP_(i) { if (bx == 0 && tid0 == 0) { const unsigned long long t_ = __builtin_amdgcn_s_memrealtime(); MISC[16 + 2 * (i)] = (unsigned)t_; MISC[17 + 2 * (i)] = (unsigned)(t_ >> 32); } }
#else
#define STAMP_(i)
#endif
#define X(k) { const int si_ = __COUNTER__ - STEP_BASE; \
        if (si_ > 0) { if ((k == 3 || k == 4 || k == 5) && all_local) team_barrier(ctl + CW_TEAM + 16 * team_pm, 4u * (k - 2), ctl + CW_BAR + XB_TMO, wave); \
            else if (k == 2) { PHASE_PTRS(); const bool pre_ = (G == (NP / 256) * (DM / 256)) && team_pn < 2; const int sqb_ = 2 * team_pm + team_pn; \
                               const bool cpy_ = (G == (NP / 256) * (DM / 256)) && team_pn >= 2; \
                               xcd_barrier(bar, [&]() { if (pre_) p2_state_dma(P, lds, sqb_, lane, wave); if (cpy_) p2_state_copy(P, 2 * team_pm + team_pn - 2, tid); }); } \
            else xcd_barrier(bar); } \
        if (k == 2) all_local = (xb_ld(ctl + CW_OK) == (unsigned)G); \
        STAMP_(si_) RUN##k }
#endif
    PROG_STEPS
#undef X
#ifdef DBG_TIME_A
    xcd_barrier(bar); STAMP_(7)
    if (bx == 0) { __syncthreads();
        const unsigned long long ta = ((unsigned long long)MISC[17 + 2 * (DBG_TIME_A)] << 32) | MISC[16 + 2 * (DBG_TIME_A)], tb = ((unsigned long long)MISC[17 + 2 * (DBG_TIME_B)] << 32) | MISC[16 + 2 * (DBG_TIME_B)];
        const float sc = 1.0f + (float)(tb - ta) * 1e-5f;
        PHASE_PTRS(); for (int i = tid; i < 16384; i += NWAVES * 64) P.out[OFF_NAP + i] *= sc; }
#endif
#undef WSP
}

extern "C" void kernel_launch(void* const* d_in, const int* in_sizes, int n_in, void* d_out, int out_size, void* d_ws, size_t ws_size, hipStream_t stream) {
    static int grid = 0;
    if (grid == 0) {
        if (n_in != 20 || ws_size < WS_END) { fprintf(stderr, "kernel_launch: unexpected n_in %d / ws %zu\n", n_in, ws_size); grid = -1; return; }
        int dev = 0, cus = 0, per_cu = 0;
        if (hipGetDevice(&dev) != hipSuccess || hipDeviceGetAttribute(&cus, hipDeviceAttributeMultiprocessorCount, dev) != hipSuccess) { grid = -1; return; }
        if (hipFuncSetAttribute((const void*)fwd_megakernel, hipFuncAttributeMaxDynamicSharedMemorySize, LDS_BYTES) != hipSuccess) { fprintf(stderr, "kernel_launch: hipFuncSetAttribute failed\n"); grid = -1; return; }
        if (hipOccupancyMaxActiveBlocksPerMultiprocessor(&per_cu, (const void*)fwd_megakernel, NWAVES * 64, LDS_BYTES) != hipSuccess || per_cu < 1) { fprintf(stderr, "kernel_launch: occupancy query says %d\n", per_cu); (void)hipGetLastError(); per_cu = 1; }
        grid = cus;
    }
    if (grid < 0) return;
    (void)hipMemsetAsync((char*)d_ws + WS_CTL, 0, CTL_ZERO_BYTES, stream);
    Args a{};
    const float** pp = (const float**)&a.p;
    for (int i = 0; i < 20; ++i) pp[i] = (const float*)d_in[i];
    a.p.out = (float*)d_out; a.p.ws = (unsigned char*)d_ws;
#if MK_PER_PHASE
    for (int ph = 0; ph < 64; ++ph) { a.ph_lo = ph; a.ph_hi = ph + 1; hipLaunchKernelGGL(fwd_megakernel, dim3(grid), dim3(NWAVES * 64), LDS_BYTES, stream, a); }
#else
    a.ph_lo = 0; a.ph_hi = 64;
    void* kargs[] = {&a};
    hipError_t e = hipLaunchCooperativeKernel((const void*)fwd_megakernel, dim3(grid), dim3(NWAVES * 64), kargs, LDS_BYTES, stream);
    if (e != hipSuccess) fprintf(stderr, "kernel_launch: cooperative launch failed: %s (grid %d)\n", hipGetErrorString(e), grid);
#endif
}
```

```cpp
#include <hip/hip_runtime.h>
#include <cstdio>
#include <cstdint>

#ifndef MK_PER_PHASE
#define MK_PER_PHASE 0
#endif

namespace pg8 {
#define PG8_LAS __attribute__((address_space(3)))
typedef unsigned short bf16_t;
typedef short bf16x8 __attribute__((ext_vector_type(8)));
typedef float f32x4 __attribute__((ext_vector_type(4)));
typedef unsigned u32x4 __attribute__((ext_vector_type(4)));
typedef unsigned u32x2 __attribute__((ext_vector_type(2)));
constexpr int BM = 256, BK = 64, HALF = 128, HTB = HALF * BK * 2, STAGE_BYTES = 8 * HTB, NXCD = 8, WGM = 4;

__host__ __device__ __forceinline__ int lds_byte(int r, int c) { const int st = (r >> 4) * 2 + (c >> 5), rr = r & 15, cc = c & 31, ob = rr * 64 + cc * 2; return st * 1024 + (ob ^ (((ob >> 9) & 1) << 5)); }
__host__ __device__ __forceinline__ void stage_rc(int b, int& R, int& C) { const int st = b / 1024, sb = b % 1024, swz = sb ^ (((sb >> 9) & 1) << 5); R = (st >> 1) * 16 + swz / 64; C = (st & 1) * 32 + (swz % 64) / 2; }
__host__ __device__ __forceinline__ int perm32(int rho) { const int n = rho >> 4, i = rho & 15; return 8 * (i >> 2) + 4 * n + (i & 3); }

struct Unit { int pm, pn; };
struct Gemm { const bf16_t* A; const bf16_t* Bt; int M, N, K; };

__device__ __forceinline__ int lane_id_() { int l = (int)__builtin_amdgcn_mbcnt_hi(~0u, __builtin_amdgcn_mbcnt_lo(~0u, 0u)); asm volatile("" : "+v"(l)); return l; }
struct StaticOrder {
    int nM, nN, nwg, G, c, pm0;
    __host__ __device__ void init(int M, int N, int G_, int c_, int pm0_ = 0) { nM = M / BM; nN = N / BM; nwg = nM * nN; G = G_; c = c_; pm0 = pm0_; }
    __host__ __device__ void map(int L, Unit& u) const {
        int wgid = L; { const int q = nwg / NXCD, r = nwg % NXCD, xcd = wgid % NXCD, off = wgid / NXCD; wgid = (xcd < r ? xcd * (q + 1) : r * (q + 1) + (xcd - r) * q) + off; }
        const int nig = WGM * nN, gid = wgid / nig, fm = gid * WGM, gsz = (nM - fm) < WGM ? (nM - fm) : WGM;
        u.pm = pm0 + fm + ((wgid % nig) % gsz); u.pn = (wgid % nig) / gsz;
    }
    __host__ __device__ bool next(int i, Unit& u) const {
        const long L = (long)i * G + c; if (c < 0 || L >= nwg) return false;
        map((int)L, u); return true;
    }
    __device__ __forceinline__ void a_ready(const Unit&) const {}
    __device__ __forceinline__ void done(const Unit&) const {}
    __device__ __forceinline__ void begin() {}
    __device__ __forceinline__ void issue(int) {}
    __device__ __forceinline__ void commit(int) {}
};
struct DynOrder : StaticOrder {
    int NS, NLAB, x, w; unsigned* cq; volatile PG8_LAS int* tk; unsigned pend;
    __device__ __forceinline__ bool t0() const { return w == 0 && lane_id_() == 0; }
    __device__ __forceinline__ int tail_count(int y) const { const int rem = nwg - NS * G - y; return rem <= 0 ? 0 : (rem + NLAB - 1) / NLAB; }
    __device__ __forceinline__ int resolve(unsigned t) const {
        if ((int)t < tail_count(x)) return NS * G + NLAB * (int)t + x;
        for (int d = 1; d < NLAB; ++d) { const int y = (x + d) % NLAB; const unsigned s = __hip_atomic_fetch_add(cq + 64 * y, 1u, __ATOMIC_RELAXED, __HIP_MEMORY_SCOPE_AGENT); if ((int)s < tail_count(y)) return NS * G + NLAB * (int)s + y; }
        return -1;
    }
    __device__ __forceinline__ bool next(int i, Unit& u) const {
        if (i < NS) return StaticOrder::next(i, u);
        const int L = tk[(i - NS) & 1]; if (L < 0) return false;
        map(L, u); return true;
    }
    __device__ __forceinline__ void begin() {
        if (NS < 2) { if (t0()) { for (int j = 0; j < 2 - NS; ++j) tk[j] = resolve(__hip_atomic_fetch_add(cq + 64 * x, 1u, __ATOMIC_RELAXED, __HIP_MEMORY_SCOPE_AGENT)); } __syncthreads(); }
    }
    __device__ __forceinline__ void issue(int ui) { if (ui + 2 >= NS && t0()) pend = __hip_atomic_fetch_add(cq + 64 * x, 1u, __ATOMIC_RELAXED, __HIP_MEMORY_SCOPE_AGENT); }
    __device__ __forceinline__ void commit(int ui) { if (ui + 2 >= NS && t0()) tk[(ui + 2 - NS) & 1] = resolve(pend); }
};
struct DynOrderGate : DynOrder {
    unsigned* gate; unsigned gate_n; unsigned* peek; volatile PG8_LAS unsigned* peekw;
    __device__ __forceinline__ void begin() {
        if (t0()) {
            const unsigned pv = __hip_atomic_load(peek, __ATOMIC_RELAXED, __HIP_MEMORY_SCOPE_AGENT);
            unsigned gv = __hip_atomic_load(gate, __ATOMIC_RELAXED, __HIP_MEMORY_SCOPE_AGENT);
            const unsigned t = __hip_atomic_fetch_add(cq, 2u, __ATOMIC_RELAXED, __HIP_MEMORY_SCOPE_AGENT);
            tk[0] = resolve(t); tk[1] = resolve(t + 1u); *peekw = pv;
            unsigned sp = 0; while (gv < gate_n && ++sp < (1u << 18)) { __builtin_amdgcn_s_sleep(1); gv = __hip_atomic_load(gate, __ATOMIC_RELAXED, __HIP_MEMORY_SCOPE_AGENT); }
        }
        __syncthreads();
    }
};

typedef __bf16 bf16x2_n __attribute__((ext_vector_type(2)));
typedef float f32x2_n __attribute__((ext_vector_type(2)));
__device__ __forceinline__ unsigned cvt_pk_bf16(float lo, float hi) { unsigned r; asm volatile("s_nop 0\n\tv_cvt_pk_bf16_f32 %0, %1, %2" : "=v"(r) : "v"(lo), "v"(hi)); return r; }
__device__ __forceinline__ float bf_lo(unsigned u) { return __uint_as_float(u << 16); }
__device__ __forceinline__ float bf_hi(unsigned u) { return __uint_as_float(u & 0xffff0000u); }
__device__ __forceinline__ float sigmoidf_(float x) { return __builtin_amdgcn_rcpf(1.0f + __expf(-x)); }
__device__ __forceinline__ f32x4 exp2m4(const f32x4 x) { const f32x4 t = x * (-1.4426950408889634f); f32x4 e; e[0] = __builtin_amdgcn_exp2f(t[0]); e[1] = __builtin_amdgcn_exp2f(t[1]); e[2] = __builtin_amdgcn_exp2f(t[2]); e[3] = __builtin_amdgcn_exp2f(t[3]); return e; }
__device__ __forceinline__ f32x4 rcp4(const f32x4 d) { f32x4 r; r[0] = __builtin_amdgcn_rcpf(d[0]); r[1] = __builtin_amdgcn_rcpf(d[1]); r[2] = __builtin_amdgcn_rcpf(d[2]); r[3] = __builtin_amdgcn_rcpf(d[3]); return r; }
__device__ __forceinline__ f32x4 sigmoid4(const f32x4 x) { return rcp4(exp2m4(x) + 1.0f); }
__device__ __forceinline__ u32x4 pack8(const f32x4 a, const f32x4 b) { u32x4 w; w.x = cvt_pk_bf16(a[0], a[1]); w.y = cvt_pk_bf16(a[2], a[3]); w.z = cvt_pk_bf16(b[0], b[1]); w.w = cvt_pk_bf16(b[2], b[3]); return w; }
__device__ __forceinline__ void unpack8(const u32x4 w, f32x4& a, f32x4& b) { a[0] = bf_lo(w.x); a[1] = bf_hi(w.x); a[2] = bf_lo(w.y); a[3] = bf_hi(w.y); b[0] = bf_lo(w.z); b[1] = bf_hi(w.z); b[2] = bf_lo(w.w); b[3] = bf_hi(w.w); }


typedef __amdgpu_buffer_rsrc_t rsrc_t;
__device__ __forceinline__ rsrc_t mkrsrc(const void* p) { return __builtin_amdgcn_make_buffer_rsrc(const_cast<void*>(p), 0, 0x7fffffff, 0x00020000); }
__device__ __forceinline__ u32x4 bld16(rsrc_t r, unsigned voff, unsigned soff) { return __builtin_amdgcn_raw_buffer_load_b128(r, (int)voff, (int)soff, 0); }
__device__ __forceinline__ u32x4 bld16nt(rsrc_t r, unsigned voff, unsigned soff) { return __builtin_amdgcn_raw_buffer_load_b128(r, (int)voff, (int)soff, 2); }
__device__ __forceinline__ void bst16s(rsrc_t r, unsigned voff, unsigned soff, u32x4 v) { unsigned vo = voff + soff; asm volatile("" : "+v"(vo)); __builtin_amdgcn_raw_buffer_store_b128(v, r, (int)vo, 0, 2); }
__device__ __forceinline__ void bst16(rsrc_t r, unsigned voff, unsigned soff, u32x4 v) { unsigned vo = voff + soff; asm volatile("" : "+v"(vo)); __builtin_amdgcn_raw_buffer_store_b128(v, r, (int)vo, 0, 0); }
__device__ __forceinline__ f32x4 as_f(u32x4 v) { return __builtin_bit_cast(f32x4, v); }
__device__ __forceinline__ u32x4 as_u(f32x4 v) { return __builtin_bit_cast(u32x4, v); }

constexpr int XOFF = 131072 + 8192;
constexpr int SLV_ROW0 = 16384;
struct EpiInProj {
    static constexpr bool PERM = true, AFTER_DRAIN = false, MID = false;
    bf16_t *QZ, *S, *V, *GA, *GB;
    __device__ __forceinline__ void mid(f32x4 (&)[2][2][4][2], const Unit&, int, int, int, int) const {}
    template <int TYPE> __device__ __forceinline__ void pair(const f32x4 (&acc)[2][2][4][2], rsrc_t r, unsigned sbase, unsigned voff, unsigned ldb) const {
#pragma unroll
        for (int ai = 0; ai < 2; ++ai)
#pragma unroll
            for (int m = 0; m < 4; ++m) {
                f32x4 o[2];
#pragma unroll
                for (int bj = 0; bj < 2; ++bj) { const f32x4 X = acc[ai][bj][m][0], Y = acc[ai][bj][m][1];
                    if (TYPE == 1) o[bj] = X * Y; else { const f32x4 sg = sigmoid4(Y); o[bj] = TYPE == 0 ? X * Y * sg : X * sg; } }
                bst16s(r, voff, sbase + (unsigned)(ai * HALF + m * 16) * ldb, pack8(o[0], o[1]));
            }
    }
    template <int TYPE> __device__ __forceinline__ void single(const f32x4 (&acc)[2][2][4][2], rsrc_t r, unsigned sbase, unsigned voff, unsigned ldb) const {
#pragma unroll
        for (int ai = 0; ai < 2; ++ai)
#pragma unroll
            for (int m = 0; m < 4; ++m)
#pragma unroll
                for (int bj = 0; bj < 2; ++bj) { f32x4 v0 = acc[ai][bj][m][0], v1 = acc[ai][bj][m][1];
                    { const f32x4 s0 = sigmoid4(v0), s1 = sigmoid4(v1); v0 = TYPE == 0 ? v0 * s0 : s0; v1 = TYPE == 0 ? v1 * s1 : s1; }
                    bst16s(r, voff, sbase + (unsigned)(ai * HALF + m * 16) * ldb + bj * (HALF * 2), pack8(v0, v1)); }
    }
    __device__ __forceinline__ void operator()(const f32x4 (&acc)[2][2][4][2], const Unit& u, int wr, int wc, int fr, int fq) const {
        const unsigned urow = u.pm * BM + wr * 64, pn = u.pn;
        if (pn < 24) {
            const unsigned type = pn >> 3, ucb = (pn & 7) * 128 + 32 * wc;
            if (type == 0) pair<0>(acc, mkrsrc(QZ), (urow * 2048 + ucb) * 2, (unsigned)(fr * 2048 + 8 * fq) * 2u, 4096);
            else if (type == 1) pair<1>(acc, mkrsrc(S), (urow * 1024 + ucb) * 2, (unsigned)(fr * 1024 + 8 * fq) * 2u, 2048);
            else pair<2>(acc, mkrsrc(V), (urow * 1024 + ucb) * 2, (unsigned)(fr * 1024 + 8 * fq) * 2u, 2048);
        } else if (pn < 28) {
            const unsigned ucb = (pn - 24) * 256 + wc * 32;
            single<0>(acc, mkrsrc(QZ), (urow * 2048 + 1024 + ucb) * 2, (unsigned)(fr * 2048 + 8 * fq) * 2u, 4096);
        } else {
            const unsigned ucb = (pn - 28) * 128 + 32 * wc; const rsrc_t ra = mkrsrc(GA), rb = mkrsrc(GB); const unsigned sbase = (urow * 1024 + ucb) * 2, voff = (unsigned)(fr * 1024 + 8 * fq) * 2u;
#pragma unroll
            for (int ai = 0; ai < 2; ++ai)
#pragma unroll
                for (int m = 0; m < 4; ++m) { f32x4 ro[2], go[2];
#pragma unroll
                    for (int bj = 0; bj < 2; ++bj) { const f32x4 X = acc[ai][bj][m][0], Y = acc[ai][bj][m][1];
                        const f32x4 da = exp2m4(X) + 1.0f; f32x4 eb = exp2m4(Y);
#pragma unroll
                        for (int j = 0; j < 4; ++j) eb[j] = fminf(eb[j], 1e30f);
                        const f32x4 db = eb + 1.0f; go[bj] = rcp4(db); ro[bj] = db * rcp4(da); }
                    bst16s(ra, voff, sbase + (unsigned)(ai * HALF + m * 16) * 2048, pack8(ro[0], ro[1])); bst16s(rb, voff, sbase + (unsigned)(ai * HALF + m * 16) * 2048, pack8(go[0], go[1])); }
        }
    }
};
struct EpiPlain {
    static constexpr bool PERM = true, AFTER_DRAIN = false, MID = false;
    bf16_t* O; int ldc;
    __device__ __forceinline__ void mid(f32x4 (&)[2][2][4][2], const Unit&, int, int, int, int) const {}
    __device__ __forceinline__ void operator()(const f32x4 (&acc)[2][2][4][2], const Unit& u, int wr, int wc, int fr, int fq) const {
        const rsrc_t r = mkrsrc(O); const unsigned sb = ((unsigned)(u.pm * BM + wr * 64) * ldc + u.pn * BM + wc * 32) * 2, voff = (unsigned)(fr * ldc + 8 * fq) * 2u;
        asm volatile("s_nop 7\n\ts_nop 7" ::: "memory");
#pragma unroll
        for (int ai = 0; ai < 2; ++ai)
#pragma unroll
            for (int m = 0; m < 4; ++m)
#pragma unroll
                for (int bj = 0; bj < 2; ++bj) { unsigned vo = voff + sb + (unsigned)(ai * HALF + m * 16) * ldc * 2 + bj * (HALF * 2); asm volatile("" : "+v"(vo));
                    __builtin_amdgcn_raw_buffer_store_b128(pack8(acc[ai][bj][m][0], acc[ai][bj][m][1]), r, (int)vo, 0, 2); }
    }
};
struct EpiOutGate {
    static constexpr bool PERM = true, AFTER_DRAIN = false, MID = true;
    const bf16_t *GA, *GB; bf16_t* Mo;
    __device__ __forceinline__ void mid(f32x4 (&acc)[2][2][4][2], const Unit& u, int wr, int wc, int fr, int fq) const {
        const rsrc_t ra = mkrsrc(GA);
        const unsigned sb = ((unsigned)(u.pm * BM + wr * 64) * 1024 + u.pn * BM + wc * 32) * 2, voff = (unsigned)(fr * 1024 + 8 * fq) * 2u;
        u32x4 ga[2][2];
#pragma unroll
        for (int bj = 0; bj < 2; ++bj) ga[0][bj] = bld16nt(ra, voff, sb + bj * 256);
#pragma unroll
        for (int g = 0; g < 8; ++g) { const int ai = g >> 2, m = g & 3;
            if (g + 1 < 8) { const unsigned so = sb + (unsigned)(((g + 1) >> 2) * HALF + ((g + 1) & 3) * 16) * 2048;
#pragma unroll
                for (int bj = 0; bj < 2; ++bj) ga[(g + 1) & 1][bj] = bld16nt(ra, voff, so + bj * 256); }
#pragma unroll
            for (int bj = 0; bj < 2; ++bj) { f32x4 a0, a1; unpack8(ga[g & 1][bj], a0, a1); acc[ai][bj][m][0] *= a0; acc[ai][bj][m][1] *= a1; }
            asm volatile("" ::: "memory"); }
    }
    __device__ __forceinline__ unsigned slv_so(const Unit& u, int wr, int wc) const { return ((unsigned)(SLV_ROW0 + 16 * u.pm) * 1024 + u.pn * BM + wr * HALF + wc * 32) * 2; }
    __device__ __forceinline__ u32x4 slv_mid_pre(const Unit& u, int wr, int wc, int fr, int fq) const { return bld16nt(mkrsrc(GA), (unsigned)(fr * 1024 + 8 * fq) * 2u, slv_so(u, wr, wc)); }
    __device__ __forceinline__ void slv_mid(f32x4 (&x)[2], const u32x4 ga) const { f32x4 a0, a1; unpack8(ga, a0, a1); x[0] *= a0; x[1] *= a1; }
    __device__ __forceinline__ u32x4 slv_pre(const Unit& u, int wr, int wc, int fr, int fq) const { return bld16nt(mkrsrc(GB), (unsigned)(fr * 1024 + 8 * fq) * 2u, slv_so(u, wr, wc)); }
    __device__ __forceinline__ void slv(const f32x4 (&x)[2], const u32x4 gb, const Unit& u, int wr, int wc, int fr, int fq) const {
        f32x4 b0, b1; unpack8(gb, b0, b1); bst16(mkrsrc(Mo), (unsigned)(fr * 1024 + 8 * fq) * 2u, slv_so(u, wr, wc), pack8(x[0] * b0, x[1] * b1));
    }
    __device__ __forceinline__ void operator()(const f32x4 (&acc)[2][2][4][2], const Unit& u, int wr, int wc, int fr, int fq) const {
        const rsrc_t rb = mkrsrc(GB), ro = mkrsrc(Mo);
        const unsigned sb = ((unsigned)(u.pm * BM + wr * 64) * 1024 + u.pn * BM + wc * 32) * 2, voff = (unsigned)(fr * 1024 + 8 * fq) * 2u;
        u32x4 gb[2][2];
#pragma unroll
        for (int bj = 0; bj < 2; ++bj) gb[0][bj] = bld16nt(rb, voff, sb + bj * 256);
#pragma unroll
        for (int g = 0; g < 8; ++g) { const int ai = g >> 2, m = g & 3; const unsigned so0 = sb + (unsigned)(ai * HALF + m * 16) * 2048;
            if (g + 1 < 8) { const unsigned so = sb + (unsigned)(((g + 1) >> 2) * HALF + ((g + 1) & 3) * 16) * 2048;
#pragma unroll
                for (int bj = 0; bj < 2; ++bj) gb[(g + 1) & 1][bj] = bld16nt(rb, voff, so + bj * 256); }
#pragma unroll
            for (int bj = 0; bj < 2; ++bj) { f32x4 b0, b1; unpack8(gb[g & 1][bj], b0, b1);
                bst16(ro, voff, so0 + bj * 256, pack8(acc[ai][bj][m][0] * b0, acc[ai][bj][m][1] * b1)); }
            asm volatile("" ::: "memory"); }
    }
};
struct EpiWo {
    static constexpr bool PERM = true, AFTER_DRAIN = false, MID = false;
    const bf16_t* XBn; const float* irs; bf16_t* HB; float* part; float* partS;
    __device__ __forceinline__ void mid(f32x4 (&)[2][2][4][2], const Unit&, int, int, int, int) const {}
    struct XPre { u32x4 xb; float ir; };
    __device__ __forceinline__ unsigned slv_so(const Unit& u, int wr, int wc) const { return ((unsigned)(SLV_ROW0 + 16 * u.pm) * 1024 + u.pn * BM + wr * HALF + wc * 32) * 2; }
    __device__ __forceinline__ XPre slv_pre(const Unit& u, int wr, int wc, int fr, int fq) const { XPre p; p.xb = bld16nt(mkrsrc(XBn), (unsigned)(fr * 1024 + 8 * fq) * 2u, slv_so(u, wr, wc)); p.ir = irs[SLV_ROW0 + 16 * u.pm + fr]; return p; }
    __device__ __forceinline__ void slv(const f32x4 (&x)[2], const XPre& p, const Unit& u, int wr, int wc, int fr, int fq) const {
        f32x4 x0, x1; unpack8(p.xb, x0, x1); const f32x4 h0 = x0 * p.ir + x[0], h1 = x1 * p.ir + x[1];
        bst16(mkrsrc(HB), (unsigned)(fr * 1024 + 8 * fq) * 2u, slv_so(u, wr, wc), pack8(h0, h1));
        float ss = (h0[0] * h0[0] + h0[1] * h0[1]) + (h0[2] * h0[2] + h0[3] * h0[3]) + (h1[0] * h1[0] + h1[1] * h1[1]) + (h1[2] * h1[2] + h1[3] * h1[3]);
        ss += __shfl_xor(ss, 16); ss += __shfl_xor(ss, 32);
        if (fq == 0) partS[(size_t)(16 * u.pm + fr) * 32 + u.pn * 8 + wr * 4 + wc] = ss;
    }
    __device__ __forceinline__ void operator()(const f32x4 (&acc)[2][2][4][2], const Unit& u, int wr, int wc, int fr, int fq) const {
        const unsigned urow = u.pm * BM + wr * 64, ucol = u.pn * BM + wc * 32;
        const rsrc_t rx = mkrsrc(XBn), rb = mkrsrc(HB);
        const unsigned ue = urow * 1024 + ucol, ve = (unsigned)(fr * 1024 + 8 * fq);
        float* pq = part + (size_t)(urow + fr) * 16 + u.pn * 4 + wc; const float* iq = irs + urow + fr;
        u32x4 xb[2][2]; float ir[2];
#pragma unroll
        for (int bj = 0; bj < 2; ++bj) xb[0][bj] = bld16nt(rx, ve * 2u, ue * 2u + bj * 256);
        ir[0] = iq[0];
#pragma unroll
        for (int g = 0; g < 8; ++g) { const int ai = g >> 2, m = g & 3; const unsigned ro = (unsigned)(ai * HALF + m * 16) * 1024; float ss = 0.f;
            if (g + 1 < 8) { const unsigned rn = (unsigned)(((g + 1) >> 2) * HALF + ((g + 1) & 3) * 16);
#pragma unroll
                for (int bj = 0; bj < 2; ++bj) xb[(g + 1) & 1][bj] = bld16nt(rx, ve * 2u, (ue + rn * 1024) * 2u + bj * 256);
                ir[(g + 1) & 1] = iq[rn]; }
#pragma unroll
            for (int bj = 0; bj < 2; ++bj) { f32x4 x0, x1; unpack8(xb[g & 1][bj], x0, x1);
                const f32x4 h0 = x0 * ir[g & 1] + acc[ai][bj][m][0], h1 = x1 * ir[g & 1] + acc[ai][bj][m][1];
                bst16(rb, ve * 2u, (ue + ro) * 2u + bj * 256, pack8(h0, h1));
                ss += (h0[0] * h0[0] + h0[1] * h0[1]) + (h0[2] * h0[2] + h0[3] * h0[3]) + (h1[0] * h1[0] + h1[1] * h1[1]) + (h1[2] * h1[2] + h1[3] * h1[3]); }
            ss += __shfl_xor(ss, 16); ss += __shfl_xor(ss, 32);
            if (fq == 0) pq[(ai * HALF + m * 16) * 16] = ss;
            asm volatile("" ::: "memory"); }
    }
};
struct EpiPg {
    static constexpr bool PERM = true, AFTER_DRAIN = false, MID = false;
    float* H; const bf16_t* HB; const bf16_t* PE; const float* part;
    __device__ __forceinline__ void mid(f32x4 (&)[2][2][4][2], const Unit&, int, int, int, int) const {}
    __device__ __forceinline__ void operator()(const f32x4 (&acc)[2][2][4][2], const Unit& u, int wr, int wc, int fr, int fq) const {
        const unsigned urow = u.pm * BM + wr * 64, ucol = u.pn * BM + wc * 32;
        const rsrc_t rh = mkrsrc(H), rp = mkrsrc(PE), rhb = mkrsrc(HB);
        const unsigned ue = urow * 1024 + ucol, ve = (unsigned)(fr * 1024 + 8 * fq);
        const float* pq = part + (size_t)(urow + fr) * 16 + 4 * fq;
#pragma unroll
        for (int ai = 0; ai < 2; ++ai)
#pragma unroll
            for (int m = 0; m < 4; ++m) { const unsigned ro = (unsigned)(ai * HALF + m * 16) * 1024;
                float rs; { const f32x4 pv = *(const f32x4*)(pq + (ai * HALF + m * 16) * 16); rs = (pv[0] + pv[1]) + (pv[2] + pv[3]); rs += __shfl_xor(rs, 16); rs += __shfl_xor(rs, 32); }
                const float rstd = 1.0f / sqrtf(rs * (1.0f / 1024.0f) + 1e-6f);
#pragma unroll
                for (int bj = 0; bj < 2; ++bj) {
                    f32x4 h0, h1; unpack8(bld16(rhb, ve * 2u, (ue + ro) * 2u + bj * 256), h0, h1); const u32x4 pe = bld16(rp, ve * 2u, (ue + ro) * 2u + bj * 256); f32x4 p0, p1; unpack8(pe, p0, p1);
#pragma unroll
                    for (int j = 0; j < 4; ++j) { h0[j] += sigmoidf_(acc[ai][bj][m][0][j] * rstd) * p0[j]; h1[j] += sigmoidf_(acc[ai][bj][m][1][j] * rstd) * p1[j]; }
                    bst16(rh, ve * 4u, (ue + ro) * 4u + bj * 512, as_u(h0)); bst16(rh, ve * 4u, (ue + ro) * 4u + bj * 512 + 16, as_u(h1)); }
                asm volatile("" ::: "memory"); }
    }
};

__device__ __forceinline__ void agent_store_f32(float* p, float v) { __hip_atomic_store(p, v, __ATOMIC_RELAXED, __HIP_MEMORY_SCOPE_AGENT); }
__device__ __forceinline__ float agent_load_f32(const float* p) { return __hip_atomic_load(p, __ATOMIC_RELAXED, __HIP_MEMORY_SCOPE_AGENT); }
__device__ __forceinline__ void wait_count(unsigned* cnt, unsigned want) {
    unsigned sp = 0;
    while ((unsigned)__builtin_amdgcn_readfirstlane(__hip_atomic_load(cnt, __ATOMIC_RELAXED, __HIP_MEMORY_SCOPE_AGENT)) < want) { __builtin_amdgcn_s_sleep(2); if (++sp > (1u << 21)) break; }
    asm volatile("" ::: "memory");
}
struct EpiPgFinal {
    static constexpr bool PERM = true, AFTER_DRAIN = true, MID = false;
    float* Y; const bf16_t* HB; const bf16_t* PE; const float* part; const float* gfin; float* xs; unsigned* cnt;
    const float* partS; float* xsS;
    __device__ __forceinline__ void mid(f32x4 (&)[2][2][4][2], const Unit&, int, int, int, int) const {}
    __device__ __forceinline__ void fused(f32x4 (&acc)[2][2][4][2], f32x4 (&x)[2], const Unit& u, int wr, int wc, int fr, int fq, PG8_LAS unsigned char* lds, int wid, int lane) const {
        const unsigned urow = u.pm * BM + wr * 64, ucol = u.pn * BM + wc * 32;
        const rsrc_t ry = mkrsrc(Y), rp = mkrsrc(PE), rhb = mkrsrc(HB);
        const unsigned ue = urow * 1024 + ucol, ve = (unsigned)(fr * 1024 + 8 * fq);
        const float* pq = part + (size_t)(urow + fr) * 16 + 4 * fq;
        PG8_LAS float* Pt = (PG8_LAS float*)lds;
        PG8_LAS float* St = (PG8_LAS float*)(lds + 4096);
        PG8_LAS float* PtS = (PG8_LAS float*)(lds + 6144);
        PG8_LAS float* StS = (PG8_LAS float*)(lds + 6656);
        const unsigned xe = (unsigned)(SLV_ROW0 + 16 * u.pm) * 1024 + u.pn * BM + wr * HALF + wc * 32;
        const u32x4 xhb = bld16nt(rhb, ve * 2u, xe * 2u), xpe = bld16nt(rp, ve * 2u, xe * 2u);
        const f32x4 xpv0 = *(const f32x4*)(partS + (size_t)(16 * u.pm + fr) * 32 + 8 * fq), xpv1 = *(const f32x4*)(partS + (size_t)(16 * u.pm + fr) * 32 + 8 * fq + 4);
#pragma unroll
        for (int ai = 0; ai < 2; ++ai)
#pragma unroll
            for (int m = 0; m < 4; ++m) { const unsigned ro = (unsigned)(ai * HALF + m * 16) * 1024;
                float rs; { const f32x4 pv = *(const f32x4*)(pq + (ai * HALF + m * 16) * 16); rs = (pv[0] + pv[1]) + (pv[2] + pv[3]); rs += __shfl_xor(rs, 16); rs += __shfl_xor(rs, 32); }
                const float rstd = 1.0f / sqrtf(rs * (1.0f / 1024.0f) + 1e-6f); float ss = 0.f;
#pragma unroll
                for (int bj = 0; bj < 2; ++bj) {
                    f32x4 h0, h1; unpack8(bld16nt(rhb, ve * 2u, (ue + ro) * 2u + bj * 256), h0, h1); const u32x4 pe = bld16nt(rp, ve * 2u, (ue + ro) * 2u + bj * 256); f32x4 p0, p1; unpack8(pe, p0, p1);
#pragma unroll
                    for (int j = 0; j < 4; ++j) { h0[j] += sigmoidf_(acc[ai][bj][m][0][j] * rstd) * p0[j]; h1[j] += sigmoidf_(acc[ai][bj][m][1][j] * rstd) * p1[j]; }
                    acc[ai][bj][m][0] = h0; acc[ai][bj][m][1] = h1;
                    ss += (h0[0] * h0[0] + h0[1] * h0[1]) + (h0[2] * h0[2] + h0[3] * h0[3]) + (h1[0] * h1[0] + h1[1] * h1[1]) + (h1[2] * h1[2] + h1[3] * h1[3]); }
                ss += __shfl_xor(ss, 16); ss += __shfl_xor(ss, 32);
                if (fq == 0) Pt[(ai * HALF + wr * 64 + m * 16 + fr) * 4 + wc] = ss;
                asm volatile("" ::: "memory"); }
        {
            float rs = ((xpv0[0] + xpv0[1]) + (xpv0[2] + xpv0[3])) + ((xpv1[0] + xpv1[1]) + (xpv1[2] + xpv1[3])); rs += __shfl_xor(rs, 16); rs += __shfl_xor(rs, 32);
            const float rstd = 1.0f / sqrtf(rs * (1.0f / 1024.0f) + 1e-6f);
            f32x4 h0, h1, p0, p1; unpack8(xhb, h0, h1); unpack8(xpe, p0, p1);
#pragma unroll
            for (int j = 0; j < 4; ++j) { h0[j] += sigmoidf_(x[0][j] * rstd) * p0[j]; h1[j] += sigmoidf_(x[1][j] * rstd) * p1[j]; }
            x[0] = h0; x[1] = h1;
            float ss = (h0[0] * h0[0] + h0[1] * h0[1]) + (h0[2] * h0[2] + h0[3] * h0[3]) + (h1[0] * h1[0] + h1[1] * h1[1]) + (h1[2] * h1[2] + h1[3] * h1[3]);
            ss += __shfl_xor(ss, 16); ss += __shfl_xor(ss, 32);
            if (fq == 0) PtS[fr * 8 + wid] = ss;
        }
        asm volatile("s_waitcnt lgkmcnt(0)" ::: "memory"); __builtin_amdgcn_s_barrier(); asm volatile("" ::: "memory");
        const int row = wid * 32 + (lane & 31);
        if (lane < 32) { const f32x4 pv = *(const PG8_LAS f32x4*)(Pt + row * 4); agent_store_f32(xs + (size_t)(u.pm * BM + row) * 4 + u.pn, (pv[0] + pv[1]) + (pv[2] + pv[3])); }
        else if (wid == 0 && lane < 48) { const f32x4 a = *(const PG8_LAS f32x4*)(PtS + (lane - 32) * 8), b = *(const PG8_LAS f32x4*)(PtS + (lane - 32) * 8 + 4);
            agent_store_f32(xsS + (size_t)(16 * u.pm + lane - 32) * 4 + u.pn, ((a[0] + a[1]) + (a[2] + a[3])) + ((b[0] + b[1]) + (b[2] + b[3]))); }
        asm volatile("s_waitcnt vmcnt(0)" ::: "memory");
        if (lane == 0) __hip_atomic_fetch_add(cnt + 64 * u.pm, 1u, __ATOMIC_RELAXED, __HIP_MEMORY_SCOPE_AGENT);
        if (wid == 0) wait_count(cnt + 64 * u.pm, 32u);
        asm volatile("s_waitcnt vmcnt(0) lgkmcnt(0)" ::: "memory"); __builtin_amdgcn_s_barrier(); asm volatile("" ::: "memory");
        if (lane < 32) { const float* sp = xs + (size_t)(u.pm * BM + row) * 4; const float q = (agent_load_f32(sp) + agent_load_f32(sp + 1)) + (agent_load_f32(sp + 2) + agent_load_f32(sp + 3));
            St[row] = 1.0f / sqrtf(q * (1.0f / 1024.0f) + 1e-6f); }
        else if (wid == 0 && lane < 48) { const float* sp = xsS + (size_t)(16 * u.pm + lane - 32) * 4; const float q = (agent_load_f32(sp) + agent_load_f32(sp + 1)) + (agent_load_f32(sp + 2) + agent_load_f32(sp + 3));
            StS[lane - 32] = 1.0f / sqrtf(q * (1.0f / 1024.0f) + 1e-6f); }
        asm volatile("s_waitcnt lgkmcnt(0)" ::: "memory"); __builtin_amdgcn_s_barrier(); asm volatile("" ::: "memory");
        f32x4 g[2][2];
#pragma unroll
        for (int bj = 0; bj < 2; ++bj)
#pragma unroll
            for (int n = 0; n < 2; ++n) g[bj][n] = *(const f32x4*)(gfin + ucol + bj * HALF + 8 * fq + 4 * n);
#pragma unroll
        for (int ai = 0; ai < 2; ++ai)
#pragma unroll
            for (int m = 0; m < 4; ++m) { const unsigned ro = (unsigned)(ai * HALF + m * 16) * 1024; const float r3 = St[ai * HALF + wr * 64 + m * 16 + fr];
#pragma unroll
                for (int bj = 0; bj < 2; ++bj) { bst16(ry, ve * 4u, (ue + ro) * 4u + bj * 512, as_u(acc[ai][bj][m][0] * r3 * g[bj][0])); bst16(ry, ve * 4u, (ue + ro) * 4u + bj * 512 + 16, as_u(acc[ai][bj][m][1] * r3 * g[bj][1])); } }
        {
            const float r3 = StS[fr]; const f32x4 g0 = wr == 0 ? g[0][0] : g[1][0], g1 = wr == 0 ? g[0][1] : g[1][1];
            bst16(ry, ve * 4u, xe * 4u, as_u(x[0] * r3 * g0)); bst16(ry, ve * 4u, xe * 4u + 16, as_u(x[1] * r3 * g1));
        }
    }
};

template <class Epi, class Sched, bool ALIGN_EPI = false, bool SP2 = false, bool SLV = false>
__device__ __forceinline__ void gemm_phase(PG8_LAS unsigned char* lds, const Gemm g, Sched& S, const Epi& E, const int wid) {
    static_assert(!SLV || SP2, "the sliver is scheduled into the two-super-phase loop only");
    const int lane = lane_id_(), tid = wid * 64 + lane, wr = wid >> 2, wc = wid & 3, fr = lane & 15, fq = lane >> 4;
    const int K = g.K, nt = K / BK;
    unsigned voffA[2], voffB[2];
#pragma unroll
    for (int i = 0; i < 2; ++i) { int R, C; stage_rc(tid * 16 + i * 8192, R, C); const int Rb = Epi::PERM ? ((R & ~31) + perm32(R & 31)) : R;
        voffA[i] = (unsigned)(R * K + C) * 2u; voffB[i] = (unsigned)(Rb * K + C) * 2u; }
    const size_t kstep = (size_t)(BK * 2);
    const size_t hstep = (size_t)HALF * K * 2;
    const size_t tstep = 2 * hstep;
    const unsigned ldsw = (unsigned)wid * 1024u;
    const int aoff = lds_byte(wr * 64 + fr, fq * 8), boff = lds_byte(wc * 32 + fr, fq * 8);
    const unsigned voffX = (unsigned)((lane >> 2) * K * 2 + wid * 16 + (lane & 3) * 4);
#define PG8_STAGE_X(b, gbase) __builtin_amdgcn_global_load_lds((const unsigned*)((const char*)(gbase) + voffX), (PG8_LAS unsigned*)(lds + XOFF + (b) * 2048 + wid * 256), 4, 0, 0)
#define PG8_LDX(b) do { _Pragma("unroll") for (int k = 0; k < 2; ++k) Xt[k] = *(const PG8_LAS bf16x8*)(lds + XOFF + (b) * 2048 + k * 1024 + lane * 16); } while (0)
#define PG8_XMMA() do { __builtin_amdgcn_s_setprio(1); if (wr == 0) { _Pragma("unroll") for (int n = 0; n < 2; ++n) _Pragma("unroll") for (int k = 0; k < 2; ++k) xacc[n] = __builtin_amdgcn_mfma_f32_16x16x32_bf16(B0[n][k], Xt[k], xacc[n], 0, 0, 0); } \
        else { _Pragma("unroll") for (int n = 0; n < 2; ++n) _Pragma("unroll") for (int k = 0; k < 2; ++k) xacc[n] = __builtin_amdgcn_mfma_f32_16x16x32_bf16(B1[n][k], Xt[k], xacc[n], 0, 0, 0); } __builtin_amdgcn_s_setprio(0); } while (0)
#define PG8_WAIT_VS() do { if constexpr (SLV) PG8_WAIT_V(9); else PG8_WAIT_V(8); } while (0)
#define PG8_SA(b, h) (((b) * 2 + (h)) * HTB)
#define PG8_SB(b, h) ((4 + (b) * 2 + (h)) * HTB)
#define PG8_STAGE(bufoff, gbase, voff) do { _Pragma("unroll") for (int _i = 0; _i < 2; ++_i) \
        __builtin_amdgcn_global_load_lds((const unsigned*)((const char*)(gbase) + (voff)[_i]), (PG8_LAS unsigned*)(lds + (bufoff) + ldsw + _i * 8192), 16, 0, 0); } while (0)
#define PG8_LDA(dst, b, h) do { _Pragma("unroll") for (int m = 0; m < 4; ++m) _Pragma("unroll") for (int k = 0; k < 2; ++k) dst[m][k] = *(const PG8_LAS bf16x8*)(lds + PG8_SA(b, h) + aoff + m * 2048 + k * 1024); } while (0)
#define PG8_LDB(dst, b, h) do { _Pragma("unroll") for (int n = 0; n < 2; ++n) _Pragma("unroll") for (int k = 0; k < 2; ++k) dst[n][k] = *(const PG8_LAS bf16x8*)(lds + PG8_SB(b, h) + boff + n * 2048 + k * 1024); } while (0)
#define PG8_MMA(ai, bj, At, Bt) do { __builtin_amdgcn_s_setprio(1); _Pragma("unroll") for (int m = 0; m < 4; ++m) _Pragma("unroll") for (int n = 0; n < 2; ++n) _Pragma("unroll") for (int k = 0; k < 2; ++k) \
        acc[ai][bj][m][n] = __builtin_amdgcn_mfma_f32_16x16x32_bf16(Bt[n][k], At[m][k], acc[ai][bj][m][n], 0, 0, 0); __builtin_amdgcn_s_setprio(0); } while (0)
#define PG8_WAIT_V(n) asm volatile("s_waitcnt vmcnt(" #n ")" ::: "memory")
#define PG8_WAIT_L(n) asm volatile("s_waitcnt lgkmcnt(" #n ")" ::: "memory")
#define PG8_BAR __builtin_amdgcn_s_barrier()
#define PG8_SCHED __builtin_amdgcn_sched_barrier(0)
    Unit cur, nxt; int ui = 0;
    S.begin();
    if (!S.next(0, cur)) return;
    f32x4 acc[2][2][4][2];
#pragma unroll
    for (int a = 0; a < 2; ++a)
#pragma unroll
        for (int b = 0; b < 2; ++b)
#pragma unroll
            for (int m = 0; m < 4; ++m)
#pragma unroll
                for (int n = 0; n < 2; ++n) acc[a][b][m][n] = (f32x4){0.f, 0.f, 0.f, 0.f};
    bf16x8 At[4][2], B0[2][2], B1[2][2];
    f32x4 xacc[2] = {(f32x4){0.f, 0.f, 0.f, 0.f}, (f32x4){0.f, 0.f, 0.f, 0.f}}; bf16x8 Xt[2];
    const char* cA = (const char*)g.A + (size_t)cur.pm * tstep; const char* cB = (const char*)g.Bt + (size_t)cur.pn * tstep;
    const char* cX = (const char*)g.A + ((size_t)g.M + 16 * cur.pm) * K * 2;
    S.a_ready(cur);
    if constexpr (SP2) {
        PG8_STAGE(PG8_SB(0, 0), cB, voffB); PG8_STAGE(PG8_SB(0, 1), cB + hstep, voffB); PG8_STAGE(PG8_SA(0, 0), cA, voffA); if constexpr (SLV) PG8_STAGE_X(0, cX); PG8_STAGE(PG8_SA(0, 1), cA + hstep, voffA);
        if (wr == 1) PG8_BAR;
        PG8_WAIT_V(2); PG8_BAR;
        PG8_STAGE(PG8_SB(1, 0), cB + kstep, voffB); PG8_STAGE(PG8_SA(1, 0), cA + kstep, voffA); PG8_STAGE(PG8_SB(1, 1), cB + hstep + kstep, voffB); if constexpr (SLV) PG8_STAGE_X(1, cX + kstep);
        if constexpr (SLV) PG8_WAIT_V(7); else PG8_WAIT_V(6);
        PG8_BAR;
    } else {
        PG8_STAGE(PG8_SB(0, 0), cB, voffB); PG8_STAGE(PG8_SA(0, 0), cA, voffA); PG8_STAGE(PG8_SB(0, 1), cB + hstep, voffB); PG8_STAGE(PG8_SA(0, 1), cA + hstep, voffA);
        if (wr == 1) PG8_BAR;
        PG8_WAIT_V(4); PG8_BAR;
        PG8_STAGE(PG8_SB(1, 0), cB + kstep, voffB); PG8_STAGE(PG8_SA(1, 0), cA + kstep, voffA); PG8_STAGE(PG8_SB(1, 1), cB + hstep + kstep, voffB);
        PG8_WAIT_V(6); PG8_BAR;
    }
    for (;;) {
        const bool has_next = S.next(ui + 1, nxt);
        S.issue(ui);
        const char* nA = has_next ? (const char*)g.A + (size_t)nxt.pm * tstep : cA; const char* nB = has_next ? (const char*)g.Bt + (size_t)nxt.pn * tstep : cB;
        const char* nX = has_next ? (const char*)g.A + ((size_t)g.M + 16 * nxt.pm) * K * 2 : cX;
        for (int th = 0; th < (Epi::MID ? 2 : 1); ++th) {
        if constexpr (Epi::MID) { if (th == 1) { const int le = lane_id_(), fr = le & 15, fq = le >> 4;
            if constexpr (SLV) { const auto xp = E.slv_mid_pre(cur, wr, wc, fr, fq); E.mid(acc, cur, wr, wc, fr, fq); E.slv_mid(xacc, xp); } else E.mid(acc, cur, wr, wc, fr, fq); } }
        const int t_lo = Epi::MID ? th * (nt >> 1) : 0, t_hi = Epi::MID ? (th + 1) * (nt >> 1) : nt;
#pragma unroll 1
        for (int t = t_lo; t < t_hi; t += 2) {
            const bool last = (t == nt - 2);
            const char* a1 = cA + (size_t)(t + 1) * kstep;
            const char* a2 = last ? nA : cA + (size_t)(t + 2) * kstep; const char* b2 = last ? nB : cB + (size_t)(t + 2) * kstep;
            const char* a3 = a2 + kstep; const char* b3 = b2 + kstep;
            const char* x2 = last ? nX : cX + (size_t)(t + 2) * kstep;
            if (last && has_next) S.a_ready(nxt);
            if constexpr (SP2) {
            PG8_LDB(B0, 0, 0); PG8_LDB(B1, 0, 1); PG8_SCHED; PG8_LDA(At, 0, 0); if constexpr (SLV) PG8_LDX(0); PG8_STAGE(PG8_SA(1, 1), a1 + hstep, voffA);
            PG8_WAIT_VS(); PG8_WAIT_L(0); PG8_BAR; PG8_MMA(0, 0, At, B0); PG8_MMA(0, 1, At, B1); if constexpr (SLV) PG8_XMMA(); PG8_BAR; PG8_SCHED;
            PG8_LDA(At, 0, 1); PG8_STAGE(PG8_SB(0, 0), b2, voffB); PG8_STAGE(PG8_SB(0, 1), b2 + hstep, voffB); PG8_STAGE(PG8_SA(0, 0), a2, voffA); if constexpr (SLV) PG8_STAGE_X(0, x2);
            PG8_WAIT_VS(); PG8_WAIT_L(0); PG8_BAR; PG8_MMA(1, 0, At, B0); PG8_MMA(1, 1, At, B1); PG8_BAR; PG8_SCHED;
            PG8_LDB(B0, 1, 0); PG8_LDB(B1, 1, 1); PG8_SCHED; PG8_LDA(At, 1, 0); if constexpr (SLV) PG8_LDX(1); PG8_STAGE(PG8_SA(0, 1), a2 + hstep, voffA);
            PG8_WAIT_VS(); PG8_WAIT_L(0); PG8_BAR; PG8_MMA(0, 0, At, B0); PG8_MMA(0, 1, At, B1); if constexpr (SLV) PG8_XMMA(); PG8_BAR; PG8_SCHED;
            PG8_LDA(At, 1, 1); PG8_STAGE(PG8_SB(1, 0), b3, voffB); PG8_STAGE(PG8_SB(1, 1), b3 + hstep, voffB); PG8_STAGE(PG8_SA(1, 0), a3, voffA); if constexpr (SLV) PG8_STAGE_X(1, x2 + kstep);
            PG8_WAIT_VS(); PG8_WAIT_L(0); PG8_BAR; PG8_MMA(1, 0, At, B0); PG8_MMA(1, 1, At, B1); PG8_BAR; PG8_SCHED;
            } else {
            PG8_LDB(B0, 0, 0); PG8_SCHED; PG8_LDA(At, 0, 0); PG8_STAGE(PG8_SA(1, 1), a1 + hstep, voffA);
            PG8_WAIT_L(8); PG8_BAR; PG8_WAIT_L(0); PG8_MMA(0, 0, At, B0); PG8_BAR; PG8_SCHED;
            PG8_LDB(B1, 0, 1); PG8_STAGE(PG8_SB(0, 0), b2, voffB);
            PG8_BAR; PG8_WAIT_L(0); PG8_MMA(0, 1, At, B1); PG8_BAR;
            PG8_LDA(At, 0, 1); PG8_STAGE(PG8_SA(0, 0), a2, voffA);
            PG8_BAR; PG8_WAIT_L(0); PG8_MMA(1, 0, At, B0); PG8_BAR; PG8_SCHED;
            PG8_STAGE(PG8_SB(0, 1), b2 + hstep, voffB);
            PG8_WAIT_V(6); PG8_BAR; PG8_MMA(1, 1, At, B1); PG8_BAR;
            PG8_LDB(B0, 1, 0); PG8_SCHED; PG8_LDA(At, 1, 0); PG8_STAGE(PG8_SA(0, 1), a2 + hstep, voffA);
            PG8_WAIT_L(8); PG8_BAR; PG8_WAIT_L(0); PG8_MMA(0, 0, At, B0); PG8_BAR; PG8_SCHED;
            PG8_LDB(B1, 1, 1); PG8_STAGE(PG8_SB(1, 0), b3, voffB);
            PG8_BAR; PG8_WAIT_L(0); PG8_MMA(0, 1, At, B1); PG8_BAR;
            PG8_LDA(At, 1, 1); PG8_STAGE(PG8_SA(1, 0), a3, voffA);
            PG8_BAR; PG8_WAIT_L(0); PG8_MMA(1, 0, At, B0); PG8_BAR; PG8_SCHED;
            PG8_STAGE(PG8_SB(1, 1), b3 + hstep, voffB);
            PG8_WAIT_V(6); PG8_BAR; PG8_MMA(1, 1, At, B1); PG8_BAR;
            }
        }
        }
        S.commit(ui);
        if constexpr (ALIGN_EPI) { if (wr == 0) PG8_BAR; }
        if constexpr (!Epi::AFTER_DRAIN) { const int le = lane_id_(), fr = le & 15, fq = le >> 4;
            if constexpr (SLV) { const auto xp = E.slv_pre(cur, wr, wc, fr, fq); E(acc, cur, wr, wc, fr, fq); E.slv(xacc, xp, cur, wr, wc, fr, fq); } else E(acc, cur, wr, wc, fr, fq);
            S.done(cur); }
        if (!has_next) break;
        xacc[0] = (f32x4){0.f, 0.f, 0.f, 0.f}; xacc[1] = (f32x4){0.f, 0.f, 0.f, 0.f};
#pragma unroll
        for (int a = 0; a < 2; ++a)
#pragma unroll
            for (int b = 0; b < 2; ++b)
#pragma unroll
                for (int m = 0; m < 4; ++m)
#pragma unroll
                    for (int n = 0; n < 2; ++n) acc[a][b][m][n] = (f32x4){0.f, 0.f, 0.f, 0.f};
        cur = nxt; cA = nA; cB = nB; cX = nX; ++ui;
        if constexpr (ALIGN_EPI) { if (wr == 1) PG8_BAR; }
    }
    PG8_WAIT_V(0);
    if constexpr (!ALIGN_EPI) { if (wr == 0) PG8_BAR; }
    PG8_BAR;
    if constexpr (Epi::AFTER_DRAIN) { const int le = lane_id_(); E.fused(acc, xacc, cur, wr, wc, le & 15, le >> 4, lds, wid, le); }
#undef PG8_STAGE_X
#undef PG8_LDX
#undef PG8_XMMA
#undef PG8_WAIT_VS
#undef PG8_SA
#undef PG8_SB
#undef PG8_STAGE
#undef PG8_LDA
#undef PG8_LDB
#undef PG8_MMA
#undef PG8_WAIT_V
#undef PG8_WAIT_L
#undef PG8_BAR
#undef PG8_SCHED
}

}

#ifndef PG8_SP2
#define PG8_SP2 true
#endif
#ifndef PG8_ALIGN
#define PG8_ALIGN true
#endif

constexpr int NWAVES = 8;
constexpr int DM = 1024, NP = 16384, NS = 1024, T = NP + NS, SEQ = 2048, DSEQ = 8, DIN = 9216, PLE = 256;
constexpr float EPS = 1e-6f, LN_EPS = 1e-5f;
constexpr size_t OFF_NAP = (size_t)T * DM, OFF_NBP = OFF_NAP + 8 * 2 * 1024, OFF_NAS = OFF_NBP + 8 * 30 * 1024, OFF_NBS = OFF_NAS + 128 * 2 * 1024;
constexpr size_t MiB = 1u << 20;
constexpr size_t WS_CTL = 0, CTL_ZERO_BYTES = 64 * 1024;
constexpr size_t WS_WIN = 2 * MiB, WS_WAB = 20 * MiB, WS_WO = 24 * MiB, WS_WPG = 26 * MiB, WS_WPE = 28 * MiB;
constexpr size_t WS_PB = 29 * MiB;
constexpr size_t WS_XB = 38 * MiB;
constexpr size_t WS_QZ = 72 * MiB;
constexpr size_t WS_S = 140 * MiB;
constexpr size_t WS_V = 174 * MiB;
constexpr size_t WS_PART = 208 * MiB;
constexpr size_t WS_PARTS = 211 * MiB + 512 * 1024;
static_assert(pg8::SLV_ROW0 == NP && pg8::XOFF + 4096 <= 147456, "sliver constants");
constexpr size_t WS_X2 = 210 * MiB, WS_X2S = 211 * MiB;
constexpr size_t WS_IRS = 212 * MiB;
constexpr size_t WS_PE = 214 * MiB;
constexpr size_t WS_END = 248 * MiB;
constexpr int CW_BAR = 4096, CW_GRP = 8192, CW_DYN = 14336, CW_XID = 15360, CW_OK = 15360 + 512, CW_CVT = 15360 + 576, CW_CVTDONE = 15360 + 640, CW_PB = 15360 + 704, CW_PBDONE = 15360 + 768, CW_TEAM = 13312;
constexpr int RING_BYTES = 131072, LDSCTL_OFF = RING_BYTES, MISC_OFF = LDSCTL_OFF + 320, LDS_BYTES = 147456;

#define GAS __attribute__((address_space(1)))
#define LAS __attribute__((address_space(3)))
typedef unsigned short bf16;
typedef unsigned v4u __attribute__((ext_vector_type(4)));
typedef unsigned v2u __attribute__((ext_vector_type(2)));
typedef float f32x4 __attribute__((ext_vector_type(4)));
typedef float f32x2 __attribute__((ext_vector_type(2)));
#define LDS_WAIT() asm volatile("s_waitcnt lgkmcnt(0)" ::: "memory")
using pg8::cvt_pk_bf16; using pg8::bf_lo; using pg8::bf_hi; using pg8::sigmoidf_;

#define XB_TMO      128
#define XB_XCNT(j)  (256  + 64 * (j))
#define XB_XSUB(j)  (1280 + 64 * (j))
#define XB_XGEN(j)  (2304 + 64 * (j))
#define XB_TOP      3328
#define XB_TOPGEN   3392
#define XCD_BAR_WORDS 3456
#define XB_SPIN_CAP (1u << 18)
__device__ __forceinline__ unsigned xb_ld(unsigned* p)              { return __hip_atomic_load(p, __ATOMIC_RELAXED, __HIP_MEMORY_SCOPE_AGENT); }
__device__ __forceinline__ unsigned xb_add(unsigned* p, unsigned v) { return __hip_atomic_fetch_add(p, v, __ATOMIC_RELAXED, __HIP_MEMORY_SCOPE_AGENT); }
__device__ __forceinline__ unsigned xb_xcc_id() { return (unsigned)__builtin_amdgcn_s_getreg((3 << 11) | 20) & 0xFu; }
#define XB_SPIN(cond, bar) do { unsigned _sp = 0; while (cond) { __builtin_amdgcn_s_sleep(1); \
    if ((++_sp & 255u) == 0u) { if (xb_ld(&(bar)[XB_TMO])) break; if (_sp > XB_SPIN_CAP) { atomicAdd(&(bar)[XB_TMO], 1u); break; } } } } while (0)
struct XcdBarrier { unsigned* bar; unsigned x; volatile LAS unsigned* st; int w; };
__device__ __forceinline__ XcdBarrier xcd_barrier_post(unsigned* bar, volatile LAS unsigned* st) {
    XcdBarrier b; b.bar = bar; b.x = xb_xcc_id(); b.st = st;
    if (threadIdx.x == 0) (void)xb_add(&bar[XB_XCNT(b.x)], 1u);
    return b;
}
__device__ __forceinline__ void xcd_barrier_complete(unsigned* bar, unsigned x, unsigned& nloc, unsigned& nx) {
    const unsigned G = gridDim.x * gridDim.y * gridDim.z;
    unsigned sum, cnt, mine, sp = 0u;
    for (;;) {
        sum = 0u; cnt = 0u; mine = 0u;
#pragma unroll
        for (unsigned j = 0; j < 16; ++j) { const unsigned c = xb_ld(&bar[XB_XCNT(j)]); sum += c; cnt += (c > 0u) ? 1u : 0u; mine = (j == x) ? c : mine; }
        if (sum == G) break;
        __builtin_amdgcn_s_sleep(1);
        if ((++sp & 255u) == 0u) { if (xb_ld(&bar[XB_TMO])) break; if (sp > XB_SPIN_CAP) { atomicAdd(&bar[XB_TMO], 1u); break; } }
    }
    nloc = mine > 0u ? mine : 1u; nx = cnt > 0u ? cnt : 1u;
}
struct BarWait { bool t0, spin; unsigned waitgen; };
__device__ __forceinline__ BarWait xcd_barrier_arrive(const XcdBarrier& b) {
    asm volatile("s_waitcnt vmcnt(0)" ::: "memory");
    __syncthreads();
    BarWait w; w.t0 = (b.w == 0 && pg8::lane_id_() == 0); w.spin = false; w.waitgen = 0u;
    unsigned* bar = b.bar;
    if (w.t0) {
        __builtin_amdgcn_s_waitcnt(0);
        unsigned nloc = b.st[0], nx = b.st[1];
        if (nloc == 0u) { xcd_barrier_complete(bar, b.x, nloc, nx); b.st[0] = nloc; b.st[1] = nx; }
        const unsigned old = xb_add(&bar[XB_XSUB(b.x)], 1u);
        const unsigned gen = old / nloc;
        if (old + 1u == (gen + 1u) * nloc) {
            __builtin_amdgcn_fence(__ATOMIC_RELEASE, "agent");
            asm volatile("s_waitcnt vmcnt(0)" ::: "memory");
            const unsigned og = xb_add(&bar[XB_TOP], 1u);
            const unsigned tg = og / nx;
            if (og + 1u == (tg + 1u) * nx) xb_add(&bar[XB_TOPGEN], 1u);
            else { w.spin = true; w.waitgen = tg; }
        } else { w.spin = true; w.waitgen = gen; }
        asm volatile("buffer_inv sc1" ::: "memory");
    }
    return w;
}
__device__ __forceinline__ void xcd_barrier_wait(const XcdBarrier& b, const BarWait w) {
    if (w.t0) {
        unsigned* bar = b.bar;
        if (w.spin) XB_SPIN(xb_ld(&bar[XB_TOPGEN]) == w.waitgen, bar);
        asm volatile("s_waitcnt vmcnt(0)" ::: "memory");
    }
    __syncthreads();
}
__device__ __forceinline__ void xcd_barrier(const XcdBarrier& b) { const BarWait w = xcd_barrier_arrive(b); xcd_barrier_wait(b, w); }

__device__ __forceinline__ void team_barrier(unsigned* cnt, unsigned target, unsigned* tmo, int wave, unsigned* gate = nullptr, unsigned gate_n = 0) {
    asm volatile("s_waitcnt vmcnt(0)" ::: "memory");
    __syncthreads();
    if (wave == 0 && pg8::lane_id_() == 0) {
        __builtin_amdgcn_s_waitcnt(0);
        (void)xb_add(cnt, 1u);
        asm volatile("buffer_inv sc1" ::: "memory");
        unsigned sp = 0;
        unsigned gv = gate_n; if (gate) gv = xb_ld(gate);
        unsigned cv = xb_ld(cnt);
        while (cv < target || gv < gate_n) { __builtin_amdgcn_s_sleep(1); if ((++sp & 255u) == 0u) { if (xb_ld(tmo)) break; if (sp > XB_SPIN_CAP) { atomicAdd(tmo, 1u); break; } }
            if (gate) gv = xb_ld(gate);
            cv = xb_ld(cnt); }
        asm volatile("s_waitcnt vmcnt(0)" ::: "memory");
    }
    __syncthreads();
}

__device__ __forceinline__ float wave_sum(float v) {
#pragma unroll
    for (int o = 1; o < 64; o <<= 1) v += __shfl_xor(v, o);
    return v;
}

template <class RowMap>
__device__ __forceinline__ void p0_transpose_item(const float* W, int N, bf16* WT, int ldk, int koff, const float* gk, RowMap rm, LAS float* scr, int item, int lane) {
    const int nblk = N / 32, kb = item / nblk, nb = item % nblk, k0 = 64 * kb, n0 = 32 * nb;
#pragma unroll
    for (int i = 0; i < 8; ++i) { const int kk = 8 * i + (lane >> 3), n4 = (lane & 7) * 4; f32x4 w = __builtin_nontemporal_load((const f32x4*)(W + (size_t)(k0 + kk) * N + n0 + n4));     if (gk) w = w * gk[k0 + kk];
        LAS float* d = scr + kk * 33 + n4; d[0] = w.x; d[1] = w.y; d[2] = w.z; d[3] = w.w; }
    LDS_WAIT(); asm volatile("" ::: "memory");
    const int c = lane & 7;
#pragma unroll
    for (int j = 0; j < 4; ++j) { const int n = (lane >> 3) + 8 * j; const LAS float* s = scr + (8 * c) * 33 + n;
        v4u o; o.x = cvt_pk_bf16(s[0 * 33], s[1 * 33]); o.y = cvt_pk_bf16(s[2 * 33], s[3 * 33]); o.z = cvt_pk_bf16(s[4 * 33], s[5 * 33]); o.w = cvt_pk_bf16(s[6 * 33], s[7 * 33]);
        *(GAS v4u*)(WT + (size_t)rm(n0 + n) * ldk + koff + k0 + 8 * c) = o; }
    LDS_WAIT(); asm volatile("" ::: "memory");
}
struct RowId { __device__ __forceinline__ int operator()(int n) const { return n; } };
struct RowInProj { __device__ __forceinline__ int operator()(int sc) const {
    const int g = sc >> 10, ch = sc & 1023;
    if (g == 6) return 256 * (24 + (ch >> 8)) + (ch & 255);
    int base, isY;
    switch (g) { case 0: base = 0; isY = 0; break; case 3: base = 0; isY = 1; break; case 1: base = 8; isY = 0; break; case 2: base = 8; isY = 1; break; case 4: base = 16; isY = 0; break; case 5: base = 16; isY = 1; break;
                 case 7: base = 28; isY = 0; break; default: base = 28; isY = 1; break; }
    const int cl = ch & 127, grp = cl >> 3, r8 = cl & 7, bj = r8 >> 2, j = r8 & 3;
    return 256 * (base + (ch >> 7)) + 128 * bj + 8 * grp + 4 * isY + j; } };

struct Ptrs {
    const float *x_p, *x_s, *st_a, *st_b, *p_p, *p_s, *g_mix, *w_in, *w_conv_a, *w_out_a, *w_conv_b, *b_conv_b, *ln_g, *ln_b, *w_out_b, *w_o, *w_pe, *g_ple, *w_pg, *g_final;
    float* out; unsigned char* ws;
};

typedef const __attribute__((address_space(4))) Ptrs* KPtrsT;
__device__ __forceinline__ Ptrs load_ptrs(KPtrsT k) {
    Ptrs P;
    P.x_p = k->x_p; P.x_s = k->x_s; P.st_a = k->st_a; P.st_b = k->st_b; P.p_p = k->p_p; P.p_s = k->p_s; P.g_mix = k->g_mix; P.w_in = k->w_in; P.w_conv_a = k->w_conv_a; P.w_out_a = k->w_out_a;
    P.w_conv_b = k->w_conv_b; P.b_conv_b = k->b_conv_b; P.ln_g = k->ln_g; P.ln_b = k->ln_b; P.w_out_b = k->w_out_b; P.w_o = k->w_o; P.w_pe = k->w_pe; P.g_ple = k->g_ple; P.w_pg = k->w_pg; P.g_final = k->g_final;
    P.out = k->out; P.ws = k->ws; return P;
}
struct P0Item { const float* W; bf16* WT; const float* gk; int N, ldk, koff, perm, r; };
template <bool WT_SC1 = false> __device__ __forceinline__ void p0_item_store_t(const P0Item& d, int lane, LAS float* scr, const f32x4 (&w)[8]);
__device__ __forceinline__ void p0_item_load(const P0Item& d, int lane, f32x4 (&w)[8]) {
    const int nblk = d.N / 32, kb = d.r / nblk, nb = d.r % nblk, k0 = 64 * kb, n0 = 32 * nb;
#pragma unroll
    for (int i = 0; i < 8; ++i) { const int kk = 8 * i + (lane >> 3), n4 = (lane & 7) * 4; w[i] = __builtin_nontemporal_load((const f32x4*)(d.W + (size_t)(k0 + kk) * d.N + n0 + n4)); if (d.gk) w[i] = w[i] * d.gk[k0 + kk]; }
}
template <bool WT_SC1> __device__ __forceinline__ void p0_item_store_t(const P0Item& d, int lane, LAS float* scr, const f32x4 (&w)[8]) {
    const int nblk = d.N / 32, kb = d.r / nblk, nb = d.r % nblk, k0 = 64 * kb, n0 = 32 * nb;
#pragma unroll
    for (int i = 0; i < 8; ++i) { const int kk = 8 * i + (lane >> 3), n4 = (lane & 7) * 4; LAS float* q = scr + kk * 33 + n4; q[0] = w[i].x; q[1] = w[i].y; q[2] = w[i].z; q[3] = w[i].w; }
    LDS_WAIT(); asm volatile("" ::: "memory");
    const int c = lane & 7;
#pragma unroll
    for (int j = 0; j < 4; ++j) { const int n = (lane >> 3) + 8 * j; const LAS float* t = scr + (8 * c) * 33 + n;
        v4u o; o.x = cvt_pk_bf16(t[0 * 33], t[1 * 33]); o.y = cvt_pk_bf16(t[2 * 33], t[3 * 33]); o.z = cvt_pk_bf16(t[4 * 33], t[5 * 33]); o.w = cvt_pk_bf16(t[6 * 33], t[7 * 33]);
        const int row = d.perm ? RowInProj()(n0 + n) : n0 + n;
        if constexpr (WT_SC1) __builtin_amdgcn_raw_buffer_store_b128(o, pg8::mkrsrc(d.WT), (int)(((unsigned)row * d.ldk + d.koff + k0 + 8 * c) * 2u), 0, 16);
        else *(GAS v4u*)(d.WT + (size_t)row * d.ldk + d.koff + k0 + 8 * c) = o; }
    LDS_WAIT(); asm volatile("" ::: "memory");
}
__device__ __forceinline__ void p0_item_store(const P0Item& d, int lane, LAS float* scr, const f32x4 (&w)[8]) { p0_item_store_t<false>(d, lane, scr, w); }
constexpr int CVT_CHUNKS = 4 * (DM / 64) * (DM / 32) / NWAVES;
__device__ __forceinline__ void gap_convert(const Ptrs& P, LAS unsigned char* lds, unsigned* tick, unsigned* done, volatile LAS unsigned* word, int tid, int lane, int wave) {
    constexpr int I_SQ = (DM / 64) * (DM / 32);
    for (;;) {
        __syncthreads();
        if (tid == 0) *word = xb_add(tick, 1u);
        __syncthreads();
        const unsigned c = (unsigned)__builtin_amdgcn_readfirstlane((int)*word);
        if (c >= (unsigned)CVT_CHUNKS) break;
        const int item = (int)c * NWAVES + wave;
        P0Item d; d.gk = nullptr; d.perm = 0; d.koff = 0; d.N = DM; d.ldk = DM; const int q = item / I_SQ; d.r = item - q * I_SQ;
        if (q == 0) { d.W = P.w_out_a; d.WT = (bf16*)(P.ws + WS_WAB); d.ldk = 2 * DM; }
        else if (q == 1) { d.W = P.w_out_b; d.WT = (bf16*)(P.ws + WS_WAB); d.ldk = 2 * DM; d.koff = DM; }
        else if (q == 2) { d.W = P.w_o; d.WT = (bf16*)(P.ws + WS_WO); }
        else { d.W = P.w_pg; d.WT = (bf16*)(P.ws + WS_WPG); d.gk = P.g_ple; }
        f32x4 w[8]; p0_item_load(d, lane, w); p0_item_store_t<true>(d, lane, (LAS float*)(lds + wave * 16384), w);
        asm volatile("s_waitcnt vmcnt(0)" ::: "memory");
        __syncthreads();
        if (tid == 0) (void)xb_add(done, 1u);
    }
}
struct P0Rows { f32x4 v[2][4]; };
__device__ __forceinline__ void p0_rows_load(const Ptrs& P, int m0, int lane, P0Rows& R) {
#pragma unroll
    for (int r = 0; r < 2; ++r) { const int m = m0 + r;
        const float* xrow = m < NP ? P.x_p + (size_t)m * DM : P.x_s + (size_t)(m - NP) * DM;
        const GAS f32x4* xr = (const GAS f32x4*)xrow + lane;
#pragma unroll
        for (int j = 0; j < 4; ++j) R.v[r][j] = __builtin_nontemporal_load(xr + 64 * j); }
}
__device__ __forceinline__ void p0_rows_store(const Ptrs& P, int m0, int lane, const P0Rows& R) {
    bf16* XB = (bf16*)(P.ws + WS_XB);
#pragma unroll
    for (int r = 0; r < 2; ++r) { const int m = m0 + r; float s = 0.f;
#pragma unroll
        for (int j = 0; j < 4; ++j) s += (R.v[r][j].x * R.v[r][j].x + R.v[r][j].y * R.v[r][j].y) + (R.v[r][j].z * R.v[r][j].z + R.v[r][j].w * R.v[r][j].w);
        const float ms = wave_sum(s) * (1.0f / DM) + EPS; const float rstd = 1.0f / sqrtf(ms);
        if (lane == 0) ((float*)(P.ws + WS_IRS))[m] = sqrtf(ms);
        GAS v2u* o8 = (GAS v2u*)(XB + (size_t)m * DM) + lane;
#pragma unroll
        for (int j = 0; j < 4; ++j) { v2u w; w.x = cvt_pk_bf16(R.v[r][j].x * rstd, R.v[r][j].y * rstd); w.y = cvt_pk_bf16(R.v[r][j].z * rstd, R.v[r][j].w * rstd); o8[64 * j] = w; } }
}
constexpr int PB_CHUNKS = T / 64;
__device__ __forceinline__ bool gap_pb(const Ptrs& P, unsigned* tick, unsigned* done, volatile LAS unsigned* word, unsigned* topgen, const BarWait w, const bool drainer, int tid, int lane, int wave) {
    const pg8::rsrc_t rpb = pg8::mkrsrc(P.ws + WS_PB);
    bool seen = false;
    for (;;) {
        __syncthreads();
        if (tid == 0) { unsigned tg = w.waitgen; if (w.spin) tg = xb_ld(topgen);
            const unsigned c_ = xb_add(tick, 1u);
            word[0] = c_; word[1] = (!w.spin || tg != w.waitgen) ? 1u : 0u; }
        __syncthreads();
        const unsigned c = (unsigned)__builtin_amdgcn_readfirstlane((int)word[0]);
        seen = __builtin_amdgcn_readfirstlane((int)word[1]) != 0;
        if (c >= (unsigned)PB_CHUNKS) break;
        const int m0 = (int)c * 64 + wave * 8;
        f32x4 pv[8];
#pragma unroll
        for (int r = 0; r < 8; ++r) { const int m = m0 + r; const float* prow = m < NP ? P.p_p + (size_t)m * PLE : P.p_s + (size_t)(m - NP) * PLE; pv[r] = __builtin_nontemporal_load((const GAS f32x4*)prow + lane); }
#pragma unroll
        for (int r = 0; r < 8; ++r) { v2u w2; w2.x = cvt_pk_bf16(pv[r].x, pv[r].y); w2.y = cvt_pk_bf16(pv[r].z, pv[r].w);
            __builtin_amdgcn_raw_buffer_store_b64(w2, rpb, (int)(((unsigned)(m0 + r) * PLE + 4 * lane) * 2u), 0, 16); }
        asm volatile("s_waitcnt vmcnt(0)" ::: "memory");
        __syncthreads();
        if (tid == 0) (void)xb_add(done, 1u);
        if (seen && !drainer) break;
    }
    return seen;
}
__device__ __forceinline__ void p0_prologue(const Ptrs& P, LAS unsigned char* lds, int gw, int NGW, int lane, int wave) {
    LAS float* scr = (LAS float*)(lds + wave * 16384);
    constexpr int I_IN = (DM / 64) * (DIN / 32), I_PE = (PLE / 64) * (DM / 32);
    constexpr int NITEMS = I_IN + I_PE;
    auto decode = [&](int it) { P0Item d; int r = it; d.gk = nullptr; d.perm = 0; d.koff = 0; d.N = DM; d.ldk = DM;
        if (r < I_IN) { d.W = P.w_in; d.N = DIN; d.WT = (bf16*)(P.ws + WS_WIN); d.gk = P.g_mix; d.perm = 1; d.r = r; return d; } r -= I_IN;
        d.W = P.w_pe; d.WT = (bf16*)(P.ws + WS_WPE); d.ldk = PLE; d.r = r; return d; };
    const int NTRIP = T / 2, sh = NITEMS % NGW; int trip = gw - sh; if (trip < 0) trip += NGW;
    {
        P0Item cur; f32x4 w0[8], w1[8]; int it = gw;
        if (it < NITEMS) { cur = decode(it); p0_item_load(cur, lane, w0); }
#pragma unroll 1
        for (; it < NITEMS; it += NGW) { const int nit = it + NGW; P0Item nxt = cur;
            if (nit < NITEMS) { nxt = decode(nit); p0_item_load(nxt, lane, w1); }
            p0_item_store(cur, lane, scr, w0); cur = nxt;
#pragma unroll
            for (int i = 0; i < 8; ++i) w0[i] = w1[i]; }
    }
    {
        P0Rows R0, R1;
        if (trip < NTRIP) p0_rows_load(P, 2 * trip, lane, R0);
#pragma unroll 1
        for (; trip < NTRIP; trip += NGW) { const int nt = trip + NGW;
            if (nt < NTRIP) p0_rows_load(P, 2 * nt, lane, R1);
            p0_rows_store(P, 2 * trip, lane, R0); R0 = R1; }
    }
}

using pg8::rsrc_t; using pg8::mkrsrc;
__device__ __forceinline__ unsigned bld4(rsrc_t r, unsigned voff, unsigned soff) { return __builtin_amdgcn_raw_buffer_load_b32(r, (int)voff, (int)soff, 0); }
__device__ __forceinline__ void bst4(rsrc_t r, unsigned voff, unsigned soff, unsigned v) { __builtin_amdgcn_raw_buffer_store_b32(v, r, (int)voff, (int)soff, 0); }
__device__ __forceinline__ f32x2 bld8f(rsrc_t r, unsigned voff, unsigned soff) { return __builtin_bit_cast(f32x2, __builtin_amdgcn_raw_buffer_load_b64(r, (int)voff, (int)soff, 0)); }
__device__ __forceinline__ void bst8f(rsrc_t r, unsigned voff, unsigned soff, f32x2 v) { __builtin_amdgcn_raw_buffer_store_b64(__builtin_bit_cast(v2u, v), r, (int)voff, (int)soff, 0); }
__device__ __forceinline__ f32x2 up2(unsigned u) { return (f32x2){bf_lo(u), bf_hi(u)}; }
using pg8::bld16; using pg8::bst16; using pg8::u32x4; using pg8::pack8; using pg8::unpack8; using pg8::as_f; using pg8::as_u;
__device__ __forceinline__ void p2_window_dma(const Ptrs& P, LAS unsigned char* lds, unsigned R0, bool first, int lane, int wave) {
    const unsigned char* Vb = P.ws + WS_V;
#pragma unroll 1
    for (int hr = wave; hr < 124; hr += 8) { const int row = hr >> 1, half = hr & 1;
        if (first && row < 30) { *(LAS u32x4*)(lds + row * 2048 + half * 1024 + lane * 16) = (u32x4){0u, 0u, 0u, 0u}; }
        else __builtin_amdgcn_global_load_lds((const unsigned*)(Vb + (size_t)(R0 - 30 + row) * 2048 + half * 1024 + lane * 16), (LAS unsigned*)(lds + row * 2048 + half * 1024), 16, 0, 0); }
}
__device__ __forceinline__ void p2_state_dma(const Ptrs& P, LAS unsigned char* lds, int n, int lane, int wave) {
    const unsigned char* Sb = (const unsigned char*)(P.st_b + (size_t)n * 30 * 1024);
#pragma unroll 1
    for (int q = wave; q < 120; q += 8) __builtin_amdgcn_global_load_lds((const unsigned*)(Sb + q * 1024 + lane * 16), (LAS unsigned*)(lds + q * 1024), 16, 0, 0);
}
template <int NTW, bool PF>
__device__ __forceinline__ void p2_ln_part(const Ptrs& P, LAS unsigned char* lds, rsrc_t rQZ, unsigned R0, int lane, int wave, int nkind, int nseq) {
    const LAS f32x4* cl4 = (const LAS f32x4*)lds;
    const unsigned vz = (unsigned)lane * 16u;
    u32x4 z[NTW][2];
#pragma unroll
    for (int t = 0; t < NTW; ++t)
#pragma unroll
        for (int h = 0; h < 2; ++h) z[t][h] = bld16(rQZ, vz, (R0 + wave * NTW + t) * 4096u + 2048u + h * 1024);
    f32x4 lg[4], lb[4];
#pragma unroll
    for (int h = 0; h < 2; ++h)
#pragma unroll
        for (int q = 0; q < 2; ++q) { lg[2 * h + q] = *(const f32x4*)(P.ln_g + h * 512 + lane * 8 + q * 4); lb[2 * h + q] = *(const f32x4*)(P.ln_b + h * 512 + lane * 8 + q * 4); }
    f32x4 x[NTW][4]; float s[NTW], qq[NTW];
#pragma unroll
    for (int t = 0; t < NTW; ++t) { const int i = wave * NTW + t; s[t] = 0.f;
#pragma unroll
        for (int h = 0; h < 2; ++h)
#pragma unroll
            for (int q = 0; q < 2; ++q) { x[t][2 * h + q] = cl4[i * 256 + h * 128 + lane * 2 + q]; s[t] += (x[t][2 * h + q].x + x[t][2 * h + q].y) + (x[t][2 * h + q].z + x[t][2 * h + q].w); } }
    if constexpr (PF) { LDS_WAIT(); __syncthreads();
        if (nkind == 1) p2_window_dma(P, lds, R0 + 32, false, lane, wave); else if (nkind == 2) p2_state_dma(P, lds, nseq, lane, wave); }
#pragma unroll
    for (int o = 1; o < 64; o <<= 1)
#pragma unroll
        for (int t = 0; t < NTW; ++t) s[t] += __shfl_xor(s[t], o);
#pragma unroll
    for (int t = 0; t < NTW; ++t) { const float mean = s[t] * (1.0f / 1024.0f); qq[t] = 0.f;
#pragma unroll
        for (int j = 0; j < 4; ++j) { x[t][j] = x[t][j] - mean; qq[t] += (x[t][j].x * x[t][j].x + x[t][j].y * x[t][j].y) + (x[t][j].z * x[t][j].z + x[t][j].w * x[t][j].w); } }
#pragma unroll
    for (int o = 1; o < 64; o <<= 1)
#pragma unroll
        for (int t = 0; t < NTW; ++t) qq[t] += __shfl_xor(qq[t], o);
#pragma unroll
    for (int t = 0; t < NTW; ++t) { const float rstd = 1.0f / sqrtf(qq[t] * (1.0f / 1024.0f) + LN_EPS); const unsigned so = (R0 + wave * NTW + t) * 4096u + 2048u;
#pragma unroll
        for (int h = 0; h < 2; ++h) { f32x4 z0, z1; unpack8(z[t][h], z0, z1);
            f32x4 y0 = x[t][2 * h] * rstd * lg[2 * h] + lb[2 * h], y1 = x[t][2 * h + 1] * rstd * lg[2 * h + 1] + lb[2 * h + 1];
#pragma unroll
            for (int j = 0; j < 4; ++j) { y0[j] = y0[j] * sigmoidf_(y0[j]) * z0[j]; y1[j] = y1[j] * sigmoidf_(y1[j]) * z1[j]; }
            bst16(rQZ, vz, so + h * 1024, pack8(y0, y1)); } }
}
template <bool PF>
__device__ __forceinline__ void p2_tile_prompt(const Ptrs& P, LAS unsigned char* lds, int tile, int tid, int lane, int wave, bool dma_at_start, int nkind, int nseq) {
    const rsrc_t rQZ = mkrsrc(P.ws + WS_QZ), rS = mkrsrc(P.ws + WS_S), rWb = mkrsrc(P.w_conv_b), rOut = mkrsrc(P.out);
    const unsigned b = tile >> 6, t0 = (tile & 63) * 32, R0 = b * SEQ + t0;
    const bool lastt = (t0 == SEQ - 32), first = (t0 == 0);
    const unsigned cg = tid & 127, tq = tid >> 7, vo = cg * 16u, r0 = R0 + tq * 8;
    u32x4 sr[10], qr[8];
#pragma unroll
    for (int i = 0; i < 10; ++i) { const bool neg = first && tq == 0 && i < 2; sr[i] = bld16(rS, vo, neg ? 0u : (r0 - 2 + i) * 2048u); if (neg) sr[i] = (u32x4){0u, 0u, 0u, 0u}; }
#pragma unroll
    for (int i = 0; i < 8; ++i) qr[i] = bld16(rQZ, vo, (r0 + i) * 4096u);
    if (dma_at_start) p2_window_dma(P, lds, R0, first, lane, wave);
    {
        f32x4 w0[2], w1[2], w2[2];
#pragma unroll
        for (int q = 0; q < 2; ++q) { w0[q] = *(const f32x4*)(P.w_conv_a + cg * 8 + q * 4); w1[q] = *(const f32x4*)(P.w_conv_a + 1024 + cg * 8 + q * 4); w2[q] = *(const f32x4*)(P.w_conv_a + 2048 + cg * 8 + q * 4); }
#pragma unroll
        for (int i = 0; i < 8; ++i) { f32x4 a0, a1, b0, b1, c0, c1, q0, q1; unpack8(sr[i], a0, a1); unpack8(sr[i + 1], b0, b1); unpack8(sr[i + 2], c0, c1); unpack8(qr[i], q0, q1);
            const f32x4 y0 = q0 * (w0[0] * a0 + w1[0] * b0 + w2[0] * c0), y1 = q1 * (w0[1] * a1 + w1[1] * b1 + w2[1] * c1);
            bst16(rQZ, vo, (r0 + i) * 4096u, pack8(y0, y1)); }
        if (lastt && tq == 3) {
#pragma unroll
            for (int j = 0; j < 2; ++j) { f32x4 a0, a1; unpack8(sr[8 + j], a0, a1);
                bst16(rOut, cg * 32u, (unsigned)(OFF_NAP + (size_t)(b * 2 + j) * 1024) * 4u, as_u(a0)); bst16(rOut, cg * 32u, (unsigned)(OFF_NAP + (size_t)(b * 2 + j) * 1024) * 4u + 16u, as_u(a1)); } }
    }
    asm volatile("s_waitcnt vmcnt(0)" ::: "memory");
    __syncthreads();
    {
        const unsigned v8 = (unsigned)tid * 8u;
        const f32x2 bias = *(const f32x2*)(P.b_conv_b + 2 * tid);
        f32x2 win[62];
#pragma unroll
        for (int i = 0; i < 62; ++i) win[i] = up2(*(const LAS unsigned*)(lds + i * 2048 + tid * 4));
        asm volatile("s_waitcnt lgkmcnt(0)" ::: "memory");
        __syncthreads();
        LAS f32x2* cl2 = (LAS f32x2*)lds;
#pragma unroll
        for (int hh = 0; hh < 2; ++hh) {
            f32x2 c[16];
#pragma unroll
            for (int i = 0; i < 16; ++i) c[i] = bias;
#pragma unroll
            for (int k = 0; k < 31; ++k) { const f32x2 w = bld8f(rWb, v8, k * 4096u);
#pragma unroll
                for (int i = 0; i < 16; ++i) c[i] += w * win[hh * 16 + i + k]; }
#pragma unroll
            for (int i = 0; i < 16; ++i) cl2[(hh * 16 + i) * 512 + tid] = c[i];
        }
        if (lastt) {
#pragma unroll
            for (int j = 0; j < 30; ++j) bst8f(rOut, v8, (unsigned)(OFF_NBP + (size_t)(b * 30 + j) * 1024) * 4u, win[32 + j]); }
    }
    __syncthreads();
    p2_ln_part<4, PF>(P, lds, rQZ, R0, lane, wave, nkind, nseq);
    __syncthreads();
}
template <bool PRE, bool PF = false>
__device__ __forceinline__ void p2_seq_sample(const Ptrs& P, LAS unsigned char* lds, int n, int tid, int lane, int wave, int wtile = 0) {
    const rsrc_t rQZ = mkrsrc(P.ws + WS_QZ), rS = mkrsrc(P.ws + WS_S), rV = mkrsrc(P.ws + WS_V), rWb = mkrsrc(P.w_conv_b), rOut = mkrsrc(P.out);
    const rsrc_t rSa = mkrsrc(P.st_a), rSb = mkrsrc(P.st_b);
    const unsigned v4 = (unsigned)tid * 4u, v8 = (unsigned)tid * 8u, r0 = NP + n * DSEQ;
    LAS f32x2* cl2 = (LAS f32x2*)lds;
    f32x2 sw[10], win[38]; unsigned qu[8];
#pragma unroll
    for (int i = 0; i < 2; ++i) sw[i] = bld8f(rSa, v8, (n * 2 + i) * 4096u);
    if constexpr (!PRE) {
#pragma unroll
        for (int i = 0; i < 30; ++i) win[i] = bld8f(rSb, v8, (n * 30 + i) * 4096u); }
    unsigned su[8], vu[8];
#pragma unroll
    for (int i = 0; i < 8; ++i) { su[i] = bld4(rS, v4, (r0 + i) * 2048u); vu[i] = bld4(rV, v4, (r0 + i) * 2048u); qu[i] = bld4(rQZ, v4, (r0 + i) * 4096u); }
    const u32x4 z0 = bld16(rQZ, (unsigned)lane * 16u, (r0 + wave) * 4096u + 2048u), z1 = bld16(rQZ, (unsigned)lane * 16u, (r0 + wave) * 4096u + 2048u + 1024u);
    const f32x2 wA0 = *(const f32x2*)(P.w_conv_a + 2 * tid), wA1 = *(const f32x2*)(P.w_conv_a + 1024 + 2 * tid), wA2 = *(const f32x2*)(P.w_conv_a + 2048 + 2 * tid);
    const f32x2 bias = *(const f32x2*)(P.b_conv_b + 2 * tid);
    if constexpr (PRE) { asm volatile("s_waitcnt vmcnt(0)" ::: "memory"); __syncthreads();
#pragma unroll
        for (int i = 0; i < 30; ++i) win[i] = *(const LAS f32x2*)(lds + i * 4096 + tid * 8);
        LDS_WAIT(); __syncthreads(); }
    f32x2 c[8];
#pragma unroll
    for (int i = 0; i < 8; ++i) { sw[2 + i] = up2(su[i]); win[30 + i] = up2(vu[i]); c[i] = bias; }
#pragma unroll
    for (int k = 0; k < 31; ++k) { const f32x2 w = bld8f(rWb, v8, k * 4096u);
#pragma unroll
        for (int i = 0; i < 8; ++i) c[i] += w * win[i + k]; }
#pragma unroll
    for (int i = 0; i < 8; ++i) cl2[i * 512 + tid] = c[i];
#pragma unroll
    for (int i = 0; i < 8; ++i) { const f32x2 q = up2(qu[i]); const f32x2 cv = wA0 * sw[i] + wA1 * sw[i + 1] + wA2 * sw[i + 2]; const f32x2 ya = q * cv; bst4(rQZ, v4, (r0 + i) * 4096u, cvt_pk_bf16(ya.x, ya.y)); }
#pragma unroll
    for (int j = 0; j < 2; ++j) bst8f(rOut, v8, (unsigned)(OFF_NAS + (size_t)(n * 2 + j) * 1024) * 4u, sw[8 + j]);
#pragma unroll
    for (int j = 0; j < 30; ++j) bst8f(rOut, v8, (unsigned)(OFF_NBS + (size_t)(n * 30 + j) * 1024) * 4u, win[8 + j]);
    __syncthreads();
    {
        const LAS f32x4* cl4 = (const LAS f32x4*)lds;
        f32x4 lg[4], lb[4], x[4]; float s = 0.f;
#pragma unroll
        for (int h = 0; h < 2; ++h)
#pragma unroll
            for (int q = 0; q < 2; ++q) { lg[2 * h + q] = *(const f32x4*)(P.ln_g + h * 512 + lane * 8 + q * 4); lb[2 * h + q] = *(const f32x4*)(P.ln_b + h * 512 + lane * 8 + q * 4);
                x[2 * h + q] = cl4[wave * 256 + h * 128 + lane * 2 + q]; s += (x[2 * h + q].x + x[2 * h + q].y) + (x[2 * h + q].z + x[2 * h + q].w); }
        if constexpr (PF) { LDS_WAIT(); __syncthreads(); const unsigned wb_ = wtile >> 6, wt0_ = (wtile & 63) * 32; p2_window_dma(P, lds, wb_ * SEQ + wt0_, wt0_ == 0, lane, wave); }
        const float mean = wave_sum(s) * (1.0f / 1024.0f); float qq = 0.f;
#pragma unroll
        for (int j = 0; j < 4; ++j) { x[j] = x[j] - mean; qq += (x[j].x * x[j].x + x[j].y * x[j].y) + (x[j].z * x[j].z + x[j].w * x[j].w); }
        const float rstd = 1.0f / sqrtf(wave_sum(qq) * (1.0f / 1024.0f) + LN_EPS);
#pragma unroll
        for (int h = 0; h < 2; ++h) { f32x4 a0, a1; unpack8(h ? z1 : z0, a0, a1);
            f32x4 y0 = x[2 * h] * rstd * lg[2 * h] + lb[2 * h], y1 = x[2 * h + 1] * rstd * lg[2 * h + 1] + lb[2 * h + 1];
#pragma unroll
            for (int j = 0; j < 4; ++j) { y0[j] = y0[j] * sigmoidf_(y0[j]) * a0[j]; y1[j] = y1[j] * sigmoidf_(y1[j]) * a1[j]; }
            bst16(rQZ, (unsigned)lane * 16u, (r0 + wave) * 4096u + 2048u + h * 1024, pack8(y0, y1)); }
    }
    __syncthreads();
}

struct SeqCarry { f32x2 c[8]; f32x2 w9[9]; f32x2 sw[2]; };
__device__ __forceinline__ void p2_seq_pre(const Ptrs& P, LAS unsigned char* lds, int n, int tid, int lane, int wave, SeqCarry& cy) {
    const rsrc_t rWb = mkrsrc(P.w_conv_b), rOut = mkrsrc(P.out), rSa = mkrsrc(P.st_a);
    const unsigned v8 = (unsigned)tid * 8u;
    p2_state_dma(P, lds, n, lane, wave);
    f32x2 w[31];
#pragma unroll
    for (int k = 0; k < 31; ++k) w[k] = bld8f(rWb, v8, k * 4096u);
#pragma unroll
    for (int i = 0; i < 2; ++i) cy.sw[i] = bld8f(rSa, v8, (n * 2 + i) * 4096u);
    const f32x2 bias = *(const f32x2*)(P.b_conv_b + 2 * tid);
    asm volatile("s_waitcnt vmcnt(0)" ::: "memory"); __syncthreads();
    f32x2 win[30];
#pragma unroll
    for (int i = 0; i < 30; ++i) win[i] = *(const LAS f32x2*)(lds + i * 4096 + tid * 8);
    LDS_WAIT(); __syncthreads();
#pragma unroll
    for (int i = 0; i < 8; ++i) { f32x2 c = bias;
#pragma unroll
        for (int k = 0; k < 30 - i; ++k) c += w[k] * win[i + k];
        cy.c[i] = c; }
#pragma unroll
    for (int j = 0; j < 9; ++j) cy.w9[j] = w[22 + j];
#pragma unroll
    for (int j = 0; j < 22; ++j) bst8f(rOut, v8, (unsigned)(OFF_NBS + (size_t)(n * 30 + j) * 1024) * 4u, win[8 + j]);
}
template <bool PF>
__device__ __forceinline__ void p2_seq_post(const Ptrs& P, LAS unsigned char* lds, int n, int tid, int lane, int wave, const SeqCarry& cy, int wtile) {
    const rsrc_t rQZ = mkrsrc(P.ws + WS_QZ), rS = mkrsrc(P.ws + WS_S), rV = mkrsrc(P.ws + WS_V), rOut = mkrsrc(P.out);
    const unsigned v4 = (unsigned)tid * 4u, v8 = (unsigned)tid * 8u, r0 = NP + n * DSEQ;
    LAS f32x2* cl2 = (LAS f32x2*)lds;
    unsigned su[8], vu[8], qu[8];
#pragma unroll
    for (int i = 0; i < 8; ++i) { su[i] = bld4(rS, v4, (r0 + i) * 2048u); vu[i] = bld4(rV, v4, (r0 + i) * 2048u); qu[i] = bld4(rQZ, v4, (r0 + i) * 4096u); }
    const u32x4 z0 = bld16(rQZ, (unsigned)lane * 16u, (r0 + wave) * 4096u + 2048u), z1 = bld16(rQZ, (unsigned)lane * 16u, (r0 + wave) * 4096u + 2048u + 1024u);
    const f32x2 wA0 = *(const f32x2*)(P.w_conv_a + 2 * tid), wA1 = *(const f32x2*)(P.w_conv_a + 1024 + 2 * tid), wA2 = *(const f32x2*)(P.w_conv_a + 2048 + 2 * tid);
    f32x2 sw[10], nw[8], c[8];
    sw[0] = cy.sw[0]; sw[1] = cy.sw[1];
#pragma unroll
    for (int i = 0; i < 8; ++i) { sw[2 + i] = up2(su[i]); nw[i] = up2(vu[i]); c[i] = cy.c[i]; }
#pragma unroll
    for (int i = 0; i < 8; ++i)
#pragma unroll
        for (int k = 30 - i; k < 31; ++k) c[i] += cy.w9[k - 22] * nw[i + k - 30];
#pragma unroll
    for (int i = 0; i < 8; ++i) cl2[i * 512 + tid] = c[i];
#pragma unroll
    for (int i = 0; i < 8; ++i) { const f32x2 q = up2(qu[i]); const f32x2 cv = wA0 * sw[i] + wA1 * sw[i + 1] + wA2 * sw[i + 2]; const f32x2 ya = q * cv; bst4(rQZ, v4, (r0 + i) * 4096u, cvt_pk_bf16(ya.x, ya.y)); }
#pragma unroll
    for (int j = 0; j < 2; ++j) bst8f(rOut, v8, (unsigned)(OFF_NAS + (size_t)(n * 2 + j) * 1024) * 4u, sw[8 + j]);
#pragma unroll
    for (int j = 22; j < 30; ++j) bst8f(rOut, v8, (unsigned)(OFF_NBS + (size_t)(n * 30 + j) * 1024) * 4u, nw[j - 22]);
    __syncthreads();
    {
        const LAS f32x4* cl4 = (const LAS f32x4*)lds;
        f32x4 lg[4], lb[4], x[4]; float s = 0.f;
#pragma unroll
        for (int h = 0; h < 2; ++h)
#pragma unroll
            for (int q = 0; q < 2; ++q) { lg[2 * h + q] = *(const f32x4*)(P.ln_g + h * 512 + lane * 8 + q * 4); lb[2 * h + q] = *(const f32x4*)(P.ln_b + h * 512 + lane * 8 + q * 4);
                x[2 * h + q] = cl4[wave * 256 + h * 128 + lane * 2 + q]; s += (x[2 * h + q].x + x[2 * h + q].y) + (x[2 * h + q].z + x[2 * h + q].w); }
        if constexpr (PF) { LDS_WAIT(); __syncthreads(); const unsigned wb_ = wtile >> 6, wt0_ = (wtile & 63) * 32; p2_window_dma(P, lds, wb_ * SEQ + wt0_, wt0_ == 0, lane, wave); }
        const float mean = wave_sum(s) * (1.0f / 1024.0f); float qq = 0.f;
#pragma unroll
        for (int j = 0; j < 4; ++j) { x[j] = x[j] - mean; qq += (x[j].x * x[j].x + x[j].y * x[j].y) + (x[j].z * x[j].z + x[j].w * x[j].w); }
        const float rstd = 1.0f / sqrtf(wave_sum(qq) * (1.0f / 1024.0f) + LN_EPS);
#pragma unroll
        for (int h = 0; h < 2; ++h) { f32x4 a0, a1; unpack8(h ? z1 : z0, a0, a1);
            f32x4 y0 = x[2 * h] * rstd * lg[2 * h] + lb[2 * h], y1 = x[2 * h + 1] * rstd * lg[2 * h + 1] + lb[2 * h + 1];
#pragma unroll
            for (int j = 0; j < 4; ++j) { y0[j] = y0[j] * sigmoidf_(y0[j]) * a0[j]; y1[j] = y1[j] * sigmoidf_(y1[j]) * a1[j]; }
            bst16(rQZ, (unsigned)lane * 16u, (r0 + wave) * 4096u + 2048u + h * 1024, pack8(y0, y1)); }
    }
    __syncthreads();
}

struct Args { Ptrs p; int ph_lo, ph_hi; };

__global__ void __launch_bounds__(NWAVES * 64, 2) fwd_megakernel(Args args) {
    extern __shared__ __attribute__((aligned(16))) unsigned char lds_raw[];
    LAS unsigned char* lds = (LAS unsigned char*)lds_raw;
    typedef const __attribute__((address_space(4))) Ptrs* KPtrs;
    const KPtrs Pk = (KPtrs)__builtin_amdgcn_kernarg_segment_ptr();
#define PHASE_PTRS() KPtrs Pq_ = Pk; asm volatile("" : "+s"(Pq_)); const Ptrs P = load_ptrs(Pq_); const int lane = pg8::lane_id_(), tid = wave * 64 + lane; (void)tid
    const int tid0 = threadIdx.x, wave = __builtin_amdgcn_readfirstlane(tid0 >> 6);
    const int G = gridDim.x, bx = blockIdx.x;
    const int gw = bx * NWAVES + wave, NGW = G * NWAVES;
    volatile LAS unsigned* MISC = (volatile LAS unsigned*)(lds + MISC_OFF);
    for (int u = tid0; u < (LDS_BYTES - LDSCTL_OFF) / 4; u += NWAVES * 64) ((LAS unsigned*)(lds + LDSCTL_OFF))[u] = 0u;
    __syncthreads();
    unsigned* ctl;
    { PHASE_PTRS(); ctl = (unsigned*)(P.ws + WS_CTL); }
    XcdBarrier bar; bar.bar = ctl + CW_BAR; bar.x = 0; bar.st = nullptr; bar.w = wave;
#if !MK_PER_PHASE
    bar = xcd_barrier_post(ctl + CW_BAR, MISC + 8); bar.w = wave;
    if (tid0 == 0) __hip_atomic_store(ctl + CW_XID + bx, bar.x + 1u, __ATOMIC_RELAXED, __HIP_MEMORY_SCOPE_AGENT);
#endif
    bool all_local = false; int team_pm = 0, team_pn = 0;
    const int lo = args.ph_lo, hi = args.ph_hi;
#define WSP(off) ((pg8::bf16_t*)(P.ws + (off)))

#define RUN0 { PHASE_PTRS(); p0_prologue(P, lds, gw, NGW, lane, wave); }
#define RUN1 { PHASE_PTRS(); \
            pg8::Gemm g{WSP(WS_XB), WSP(WS_WIN), T, DIN, DM}; pg8::DynOrder S; S.init(T, DIN, G, bx); S.NS = 8; S.NLAB = 8; S.x = bx & 7; S.cq = ctl + CW_DYN; S.tk = (volatile LAS int*)(MISC + 12); S.pend = 0; S.w = wave; \
            pg8::EpiInProj E{WSP(WS_QZ), WSP(WS_S), WSP(WS_V), (pg8::bf16_t*)P.out, (pg8::bf16_t*)P.out + (size_t)T * DM}; \
            pg8::gemm_phase<pg8::EpiInProj, pg8::DynOrder, PG8_ALIGN, PG8_SP2>(lds, g, S, E, wave); \
              \
            {   \
              pg8::Gemm g2{WSP(WS_PB), WSP(WS_WPE), T, DM, PLE}; pg8::DynOrderGate S2; S2.init(T, DM, G, bx); S2.NS = 0; S2.NLAB = 1; S2.x = 0; S2.cq = ctl + CW_DYN + 64 * 8; S2.tk = (volatile LAS int*)(MISC + 14); S2.pend = 0; S2.w = wave; S2.gate = ctl + CW_PBDONE; S2.gate_n = (unsigned)PB_CHUNKS; S2.peek = ctl + CW_OK; S2.peekw = (volatile LAS unsigned*)(MISC + 42); \
              pg8::EpiPlain E2{WSP(WS_PE), DM}; \
              pg8::gemm_phase<pg8::EpiPlain, pg8::DynOrderGate, PG8_ALIGN, PG8_SP2>(lds, g2, S2, E2, wave); } }
#define RUN2 { PHASE_PTRS(); \
            if (G == (NP / 256) * (DM / 256)) {     \
                  \
                  \
                const int sq_ = 2 * team_pm + team_pn, tl_ = 8 * team_pm + 2 * team_pn; const bool hs_ = team_pn < 2; \
                p2_tile_prompt<true>(P, lds, tl_, tid, lane, wave, !hs_, 1, 0); \
                p2_tile_prompt<true>(P, lds, tl_ + 1, tid, lane, wave, false, 0, 0); \
            } else { \
                for (int tile = bx; tile < 512; tile += G) p2_tile_prompt<false>(P, lds, 2 * (tile & 255) + (tile >> 8), tid, lane, wave, true, 0, 0); \
                for (int n = bx; n < 128; n += G) p2_seq_sample<false>(P, lds, n, tid, lane, wave); } }
#define RUN3 { PHASE_PTRS(); \
            pg8::Gemm g{WSP(WS_QZ), WSP(WS_WAB), NP, DM, 2 * DM}; pg8::StaticOrder S; S.init(NP, DM, G, bx); \
            pg8::EpiOutGate E{(const pg8::bf16_t*)P.out, (const pg8::bf16_t*)P.out + (size_t)T * DM, WSP(WS_S)}; \
            pg8::gemm_phase<pg8::EpiOutGate, pg8::StaticOrder, PG8_ALIGN, PG8_SP2, true>(lds, g, S, E, wave); }
#define RUN4 { \
            { PHASE_PTRS(); pg8::Gemm g{WSP(WS_S), WSP(WS_WO), NP, DM, DM}; pg8::StaticOrder S; S.init(NP, DM, G, bx); \
              pg8::EpiWo E{WSP(WS_XB), (const float*)(P.ws + WS_IRS), WSP(WS_V), (float*)(P.ws + WS_PART), (float*)(P.ws + WS_PARTS)}; \
              pg8::gemm_phase<pg8::EpiWo, pg8::StaticOrder, PG8_ALIGN, PG8_SP2, true>(lds, g, S, E, wave); } }
#define RUN5 { PHASE_PTRS(); \
            pg8::Gemm g{WSP(WS_V), WSP(WS_WPG), NP, DM, DM}; pg8::StaticOrder S; S.init(NP, DM, G, bx); \
            pg8::EpiPgFinal E{P.out, WSP(WS_V), WSP(WS_PE), (const float*)(P.ws + WS_PART), P.g_final, (float*)(P.ws + WS_X2), ctl + CW_GRP, (const float*)(P.ws + WS_PARTS), (float*)(P.ws + WS_X2S)}; \
            pg8::gemm_phase<pg8::EpiPgFinal, pg8::StaticOrder, PG8_ALIGN, PG8_SP2, true>(lds, g, S, E, wave); }
#define RUN6 { PHASE_PTRS(); \
            float* H = P.out; \
            f32x4 gf[4]; \
            _Pragma("unroll") for (int j = 0; j < 4; ++j) gf[j] = *(const f32x4*)(P.g_final + j * 256 + lane * 4); \
            for (int m = gw; m < T; m += NGW) { \
                GAS f32x4* hr = (GAS f32x4*)(H + (size_t)m * DM) + lane; \
                f32x4 v[4]; float sq = 0.f; \
                _Pragma("unroll") for (int j = 0; j < 4; ++j) { v[j] = hr[64 * j]; sq += (v[j].x * v[j].x + v[j].y * v[j].y) + (v[j].z * v[j].z + v[j].w * v[j].w); } \
                const float rstd = 1.0f / sqrtf(wave_sum(sq) * (1.0f / DM) + EPS); \
                _Pragma("unroll") for (int j = 0; j < 4; ++j) hr[64 * j] = v[j] * rstd * gf[j]; \
            } }
#define RUN7 { PHASE_PTRS(); \
            float* H = P.out; \
            for (int m = gw; m < T; m += NGW) { \
                GAS f32x4* hr = (GAS f32x4*)(H + (size_t)m * DM) + lane; \
                f32x4 v[4]; float sq = 0.f; \
                _Pragma("unroll") for (int j = 0; j < 4; ++j) { v[j] = hr[64 * j]; sq += (v[j].x * v[j].x + v[j].y * v[j].y) + (v[j].z * v[j].z + v[j].w * v[j].w); } \
                const float one = wave_sum(sq) >= 0.f ? 1.0f : 0.0f; \
                _Pragma("unroll") for (int j = 0; j < 4; ++j) hr[64 * j] = v[j] * one; \
            } }
#ifndef PROG_STEPS
#define PROG_STEPS X(0) X(1) X(2) X(3) X(4) X(5)
#endif
    enum { STEP_BASE = __COUNTER__ + 1 };
#if MK_PER_PHASE
#define X(k) { const int si_ = __COUNTER__ - STEP_BASE; if (lo == si_) RUN##k }
#else
#ifdef DBG_TIME_A
#define STAMP_(i) { if (bx == 0 && tid0 == 0) { const unsigned long long t_ = __builtin_amdgcn_s_memrealtime(); MISC[16 + 2 * (i)] = (unsigned)t_; MISC[17 + 2 * (i)] = (unsigned)(t_ >> 32); } }
#else
#define STAMP_(i)
#endif
#define X(k) { const int si_ = __COUNTER__ - STEP_BASE; \
        if (si_ > 0) { if ((k == 3 || k == 4 || k == 5) && all_local) team_barrier(ctl + CW_TEAM + 16 * team_pm, 4u * (k - 2), ctl + CW_BAR + XB_TMO, wave, k == 3 ? ctl + CW_CVTDONE : nullptr, (unsigned)CVT_CHUNKS); \
            else if (k == 1) { PHASE_PTRS(); const BarWait bw_ = xcd_barrier_arrive(bar); \
                  \
                if (G == (NP / 256) * (DM / 256)) {     \
                pg8::StaticOrder St_; pg8::Unit me_, ot_; St_.init(NP, DM, G, bx); St_.next(0, me_); team_pm = me_.pm; team_pn = me_.pn; \
                int ok_ = 1; if (tid < G) { pg8::StaticOrder So_; So_.init(NP, DM, G, tid); if (So_.next(0, ot_) && ot_.pm == me_.pm) ok_ = (xb_ld(ctl + CW_XID + tid) == bar.x + 1u) ? 1 : 0; } \
                if (__syncthreads_and(ok_) && tid == 0) (void)xb_add(ctl + CW_OK, 1u); } \
                const bool seen_ = gap_pb(P, ctl + CW_PB, ctl + CW_PBDONE, MISC + 44, &bar.bar[XB_TOPGEN], bw_, bx < 32, tid, lane, wave); \
                BarWait bw2_ = bw_; if (seen_) bw2_.spin = false; \
                xcd_barrier_wait(bar, bw2_); } \
            else if (k == 2) { PHASE_PTRS(); \
                if ((G == (NP / 256) * (DM / 256)) && team_pn < 2) {     \
                    SeqCarry cy_; const BarWait bw_ = xcd_barrier_arrive(bar); p2_seq_pre(P, lds, 2 * team_pm + team_pn, tid, lane, wave, cy_); xcd_barrier_wait(bar, bw_); \
                    p2_seq_post<true>(P, lds, 2 * team_pm + team_pn, tid, lane, wave, cy_, 8 * team_pm + 2 * team_pn); \
                } else { const BarWait bw_ = xcd_barrier_arrive(bar); gap_convert(P, lds, ctl + CW_CVT, ctl + CW_CVTDONE, MISC + 40, tid, lane, wave); xcd_barrier_wait(bar, bw_); } } \
            else xcd_barrier(bar); } \
        if (k == 2) { unsigned okc_ = MISC[42];     \
            if (okc_ != (unsigned)G) okc_ = xb_ld(ctl + CW_OK); \
            all_local = (okc_ == (unsigned)G); } \
        if (k == 3 && !all_local) { if (tid0 == 0) { XB_SPIN(xb_ld(ctl + CW_CVTDONE) < (unsigned)CVT_CHUNKS, ctl + CW_BAR); } __syncthreads(); }     \
        STAMP_(si_) RUN##k }
#endif
    PROG_STEPS
#undef X
#ifdef DBG_TIME_A
    xcd_barrier(bar); STAMP_(7)
    if (bx == 0) { __syncthreads();
        const unsigned long long ta = ((unsigned long long)MISC[17 + 2 * (DBG_TIME_A)] << 32) | MISC[16 + 2 * (DBG_TIME_A)], tb = ((unsigned long long)MISC[17 + 2 * (DBG_TIME_B)] << 32) | MISC[16 + 2 * (DBG_TIME_B)];
        const float sc = 1.0f + (float)(tb - ta) * 1e-5f;
        PHASE_PTRS(); for (int i = tid; i < 16384; i += NWAVES * 64) P.out[OFF_NAP + i] *= sc; }
#endif
#undef WSP
}

extern "C" void kernel_launch(void* const* d_in, const int* in_sizes, int n_in, void* d_out, int out_size, void* d_ws, size_t ws_size, hipStream_t stream) {
    static int grid = 0;
    if (grid == 0) {
        if (n_in != 20 || ws_size < WS_END) { fprintf(stderr, "kernel_launch: unexpected n_in %d / ws %zu\n", n_in, ws_size); grid = -1; return; }
        int dev = 0, cus = 0, per_cu = 0;
        if (hipGetDevice(&dev) != hipSuccess || hipDeviceGetAttribute(&cus, hipDeviceAttributeMultiprocessorCount, dev) != hipSuccess) { grid = -1; return; }
        if (hipFuncSetAttribute((const void*)fwd_megakernel, hipFuncAttributeMaxDynamicSharedMemorySize, LDS_BYTES) != hipSuccess) { fprintf(stderr, "kernel_launch: hipFuncSetAttribute failed\n"); grid = -1; return; }
        if (hipOccupancyMaxActiveBlocksPerMultiprocessor(&per_cu, (const void*)fwd_megakernel, NWAVES * 64, LDS_BYTES) != hipSuccess || per_cu < 1) { fprintf(stderr, "kernel_launch: occupancy query says %d\n", per_cu); (void)hipGetLastError(); per_cu = 1; }
        grid = cus;
    }
    if (grid < 0) return;
    (void)hipMemsetAsync((char*)d_ws + WS_CTL, 0, CTL_ZERO_BYTES, stream);
    Args a{};
    const float** pp = (const float**)&a.p;
    for (int i = 0; i < 20; ++i) pp[i] = (const float*)d_in[i];
    a.p.out = (float*)d_out; a.p.ws = (unsigned char*)d_ws;
#if MK_PER_PHASE
    for (int ph = 0; ph < 64; ++ph) { a.ph_lo = ph; a.ph_hi = ph + 1; hipLaunchKernelGGL(fwd_megakernel, dim3(grid), dim3(NWAVES * 64), LDS_BYTES, stream, a); }
#else
    a.ph_lo = 0; a.ph_hi = 64;
    void* kargs[] = {&a};
    hipError_t e = hipLaunchCooperativeKernel((const void*)fwd_megakernel, dim3(grid), dim3(NWAVES * 64), kargs, LDS_BYTES, stream);
    if (e != hipSuccess) fprintf(stderr, "kernel_launch: cooperative launch failed: %s (grid %d)\n", hipGetErrorString(e), grid);
#endif
}
```
